# Optimizing an MI355X kernel written in HIP

```python
import jax, jax.numpy as jnp
from jax import lax
import numpy as np

D_MODEL = 1024
BATCH = 2
SEQ = 8192
DEPTH = 2
DEC_BATCH = 16
DEC_SEQ = 16
PAST_LEN = 4096

CHUNK = 64
Q_BLOCK = 128
DH = 64
H_A = 8
A_WIDTH = H_A * DH
B_WIDTH = D_MODEL - A_WIDTH
POOL_WINDOWS = (2, 4, 8, 16)
N_POOL_GROUPS = len(POOL_WINDOWS)
POOL_GC = B_WIDTH // N_POOL_GROUPS
POOL_HIST = max(POOL_WINDOWS) - 1
H_C = D_MODEL // DH
D_FF = 4 * D_MODEL
N_AB = (DEPTH + 1) // 2
N_C = DEPTH // 2
AB_IN = 3 * A_WIDTH + H_A + B_WIDTH
EPS = 1e-6

kernel_name = "fox_pool_stickbreak_stream_step"


def _rmsnorm(x, g):
    xf = x.astype(jnp.float32)
    y = xf * lax.rsqrt(jnp.mean(xf * xf, axis=-1, keepdims=True) + EPS)
    return (y * g.astype(jnp.float32)).astype(x.dtype)


def _sq_relu_mlp(h, w_up, w_down):
    return jnp.square(jax.nn.relu(h @ w_up)) @ w_down


def _fox_attend(q, fq, q_pos, k, v, fk, k_pos):
    s = jnp.einsum("bqhd,bkhd->bhqk", q, k).astype(jnp.float32) * (DH ** -0.5)
    s = s + jnp.swapaxes(fq, 1, 2)[..., :, None] - jnp.swapaxes(fk, 1, 2)[..., None, :]
    mask = k_pos[None, :] <= q_pos[:, None]
    p = jax.nn.softmax(jnp.where(mask, s, -jnp.inf), axis=-1)
    return jnp.einsum("bhqk,bkhd->bqhd", p.astype(v.dtype), v)


def _sb_attend(q, q_pos, k, v, k_pos):
    z = jnp.einsum("bqhd,bkhd->bhqk", q, k).astype(jnp.float32) * (DH ** -0.5)
    valid = k_pos[None, :] < q_pos[:, None]
    log1m = jnp.where(valid, jax.nn.log_sigmoid(-z), 0.0)
    later = lax.cumsum(log1m, axis=3, reverse=True) - log1m
    a = jnp.where(valid, jnp.exp(jax.nn.log_sigmoid(z) + later), 0.0)
    return jnp.einsum("bhqk,bkhd->bqhd", a.astype(v.dtype), v)


def _query_blocks(attend, q_side, q_pos, kv_side):
    b, l = q_side[0].shape[:2]
    nb = l // Q_BLOCK
    qs = tuple(jnp.moveaxis(a.reshape((b, nb, Q_BLOCK) + a.shape[2:]), 1, 0) for a in q_side)
    ps = q_pos.reshape(nb, Q_BLOCK)
    out = lax.map(lambda blk: attend(*blk[0], blk[1], *kv_side), (qs, ps))
    return jnp.moveaxis(out, 0, 1).reshape((b, l) + out.shape[3:])


def _multiscale_pool(u, u_hist, p0):
    b, l, _ = u.shape
    u_ext = jnp.concatenate([u_hist.astype(u.dtype), u], axis=1)
    csum = jnp.cumsum(u_ext.astype(jnp.float32), axis=1)
    csum = jnp.concatenate([jnp.zeros((b, 1, B_WIDTH), jnp.float32), csum], axis=1)
    end = csum[:, POOL_HIST + 1:POOL_HIST + 1 + l]
    pos = p0 + jnp.arange(l)
    means = []
    for g, w in enumerate(POOL_WINDOWS):
        sl = slice(g * POOL_GC, (g + 1) * POOL_GC)
        start = csum[:, POOL_HIST + 1 - w:POOL_HIST + 1 - w + l, sl]
        cnt = jnp.minimum(pos + 1, w).astype(jnp.float32)[None, :, None]
        means.append((end[..., sl] - start) / cnt)
    pooled = jnp.concatenate(means, axis=-1) - u.astype(jnp.float32)
    return pooled.astype(u.dtype), u_ext[:, -POOL_HIST:]


def _ab_mixer(h, w_in, b_f, w_pool, pool_scale, w_out, past):
    b, l, _ = h.shape
    proj = h @ w_in
    q, k, v, f_logit, u = jnp.split(proj, [A_WIDTH, 2 * A_WIDTH, 3 * A_WIDTH, 3 * A_WIDTH + H_A], axis=-1)
    q = q.reshape(b, l, H_A, DH)
    k = k.reshape(b, l, H_A, DH)
    v = v.reshape(b, l, H_A, DH)
    logf = jax.nn.log_sigmoid((f_logit + b_f).astype(jnp.float32))
    if past is None:
        p0 = 0
        fcum = jnp.cumsum(logf, axis=1)
        pos = jnp.arange(l)
        a_out = _query_blocks(_fox_attend, (q, fcum), pos, (k, v, fcum, pos))
        u_hist = jnp.zeros((b, POOL_HIST, B_WIDTH), u.dtype)
    else:
        pk, pv, plogf, u_hist = past
        p0 = pk.shape[1]
        k_all = jnp.concatenate([pk.astype(k.dtype), k], axis=1)
        v_all = jnp.concatenate([pv.astype(v.dtype), v], axis=1)
        fcum = jnp.cumsum(jnp.concatenate([plogf.astype(jnp.float32), logf], axis=1), axis=1)
        k_pos = jnp.arange(p0 + l)
        q_pos = p0 + jnp.arange(l)
        a_out = _fox_attend(q, fcum[:, p0:], q_pos, k_all, v_all, fcum, k_pos)
    pooled, new_rows = _multiscale_pool(u, u_hist, p0)
    pooled = jnp.einsum("blgc,gce->blge", pooled.reshape(b, l, N_POOL_GROUPS, POOL_GC), w_pool)
    pooled = pooled.reshape(b, l, B_WIDTH) * pool_scale
    y = jnp.concatenate([a_out.reshape(b, l, A_WIDTH), pooled], axis=-1) @ w_out
    return y, (k, v, logf, new_rows)


def _sb_mixer(h, w_in, w_out, past):
    b, l, _ = h.shape
    q, k, v = jnp.split(h @ w_in, 3, axis=-1)
    q = q.reshape(b, l, H_C, DH)
    k = k.reshape(b, l, H_C, DH)
    v = v.reshape(b, l, H_C, DH)
    if past is None:
        pos = jnp.arange(l)
        out = _query_blocks(_sb_attend, (q,), pos, (k, v, pos))
    else:
        pk, pv = past
        p0 = pk.shape[1]
        k_all = jnp.concatenate([pk.astype(k.dtype), k], axis=1)
        v_all = jnp.concatenate([pv.astype(v.dtype), v], axis=1)
        out = _sb_attend(q, p0 + jnp.arange(l), k_all, v_all, jnp.arange(p0 + l))
    return out.reshape(b, l, D_MODEL) @ w_out, (k, v)


def _trunk(x, c, past, w_ada, b_ada, norm_g, w_in_ab, b_forget, w_pool, pool_scale,
           w_out_ab, w_in_sb, w_out_sb, w_up, w_down, final_g):
    fk_l, fv_l, fl_l, pool_l, sk_l, sv_l = [], [], [], [], [], []
    cond = jax.nn.silu(c)
    for i in range(DEPTH):
        j = i // 2
        mod = cond @ w_ada[i] + b_ada[i]
        sh1, sc1, g1, sh2, sc2, g2 = (m[:, None, :] for m in jnp.split(mod, 6, axis=-1))
        h = _rmsnorm(x, norm_g[i, 0]) * (1 + sc1) + sh1
        if i % 2 == 0:
            lp = None if past is None else (past[0][j], past[1][j], past[2][j], past[3][j])
            y, (k, v, lf, rows) = _ab_mixer(h, w_in_ab[j], b_forget[j], w_pool[j], pool_scale[j], w_out_ab[j], lp)
            fk_l.append(k)
            fv_l.append(v)
            fl_l.append(lf)
            pool_l.append(rows)
        else:
            lp = None if past is None else (past[4][j], past[5][j])
            y, (k, v) = _sb_mixer(h, w_in_sb[j], w_out_sb[j], lp)
            sk_l.append(k)
            sv_l.append(v)
        x = x + g1 * y
        h = _rmsnorm(x, norm_g[i, 1]) * (1 + sc2) + sh2
        x = x + g2 * _sq_relu_mlp(h, w_up[i], w_down[i])
    states = (jnp.stack(fk_l), jnp.stack(fv_l), jnp.stack(fl_l), jnp.stack(pool_l), jnp.stack(sk_l), jnp.stack(sv_l))
    return _rmsnorm(x, final_g), states


def setup_inputs(seed: int = 0) -> dict:
    key = jax.random.key(seed)
    ks = jax.random.split(key, 24)

    def nrm(k, shape, scale):
        return jax.random.normal(k, shape, jnp.float32) * scale

    return {
        "x_prompt": nrm(ks[0], (BATCH, SEQ, D_MODEL), 1.0),
        "x_sample": nrm(ks[1], (DEC_BATCH, DEC_SEQ, D_MODEL), 1.0),
        "c_prompt": nrm(ks[2], (BATCH, D_MODEL), 1.0),
        "c_sample": nrm(ks[3], (DEC_BATCH, D_MODEL), 1.0),
        "cache_fox_k": nrm(ks[4], (N_AB, DEC_BATCH, PAST_LEN, H_A, DH), 1.0),
        "cache_fox_v": nrm(ks[5], (N_AB, DEC_BATCH, PAST_LEN, H_A, DH), 1.0),
        "cache_fox_logf": jax.nn.log_sigmoid(2.0 + nrm(ks[6], (N_AB, DEC_BATCH, PAST_LEN, H_A), 1.0)),
        "state_pool": nrm(ks[7], (N_AB, DEC_BATCH, POOL_HIST, B_WIDTH), 1.0),
        "cache_sb_k": nrm(ks[8], (N_C, DEC_BATCH, PAST_LEN, H_C, DH), 1.0),
        "cache_sb_v": nrm(ks[9], (N_C, DEC_BATCH, PAST_LEN, H_C, DH), 1.0),
        "w_ada": nrm(ks[10], (DEPTH, D_MODEL, 6 * D_MODEL), 0.5 * D_MODEL ** -0.5),
        "b_ada": nrm(ks[11], (DEPTH, 6 * D_MODEL), 0.02),
        "norm_g": 1.0 + nrm(ks[12], (DEPTH, 2, D_MODEL), 0.1),
        "w_in_ab": nrm(ks[13], (N_AB, D_MODEL, AB_IN), D_MODEL ** -0.5),
        "b_forget": 2.0 + nrm(ks[14], (N_AB, H_A), 0.5),
        "w_pool": nrm(ks[15], (N_AB, N_POOL_GROUPS, POOL_GC, POOL_GC), POOL_GC ** -0.5),
        "pool_scale": 1.0 + nrm(ks[16], (N_AB, B_WIDTH), 0.1),
        "w_out_ab": nrm(ks[17], (N_AB, D_MODEL, D_MODEL), D_MODEL ** -0.5),
        "w_in_sb": nrm(ks[18], (N_C, D_MODEL, 3 * D_MODEL), D_MODEL ** -0.5),
        "w_out_sb": nrm(ks[19], (N_C, D_MODEL, D_MODEL), D_MODEL ** -0.5),
        "w_up": nrm(ks[20], (DEPTH, D_MODEL, D_FF), D_MODEL ** -0.5),
        "w_down": nrm(ks[21], (DEPTH, D_FF, D_MODEL), D_FF ** -0.5),
        "final_g": 1.0 + nrm(ks[22], (D_MODEL,), 0.1),
    }


def reference(x_prompt, x_sample, c_prompt, c_sample, cache_fox_k, cache_fox_v, cache_fox_logf,
              state_pool, cache_sb_k, cache_sb_v, w_ada, b_ada, norm_g, w_in_ab, b_forget, w_pool,
              pool_scale, w_out_ab, w_in_sb, w_out_sb, w_up, w_down, final_g):
    y_prompt, (fk_p, fv_p, fl_p, pool_p, sk_p, sv_p) = _trunk(
        x_prompt, c_prompt, None, w_ada, b_ada, norm_g, w_in_ab, b_forget, w_pool, pool_scale,
        w_out_ab, w_in_sb, w_out_sb, w_up, w_down, final_g)
    past = (cache_fox_k, cache_fox_v, cache_fox_logf, state_pool, cache_sb_k, cache_sb_v)
    y_sample, (fk_s, fv_s, fl_s, pool_s, sk_s, sv_s) = _trunk(
        x_sample, c_sample, past, w_ada, b_ada, norm_g, w_in_ab, b_forget, w_pool, pool_scale,
        w_out_ab, w_in_sb, w_out_sb, w_up, w_down, final_g)
    return (y_prompt, y_sample, fk_p, fv_p, fl_p, pool_p, sk_p, sv_p, fk_s, fv_s, fl_s, pool_s, sk_s, sv_s)
```

```cpp
#include <hip/hip_runtime.h>
#include <hip/hip_cooperative_groups.h>
#include <cstdio>
#include <cstdint>
namespace cg = cooperative_groups;
__device__ __forceinline__ int tid_l() { int t = threadIdx.x; asm volatile("" : "+v"(t)); return t; }
namespace pg8 {
#define PG8_LAS __attribute__((address_space(3)))
typedef unsigned short bf16_t;
typedef short bf16x8 __attribute__((ext_vector_type(8)));
typedef float f32x4 __attribute__((ext_vector_type(4)));
typedef unsigned u32x4 __attribute__((ext_vector_type(4)));
constexpr int BM = 256, BK = 64, HALF = 128, HTB = HALF * BK * 2  , STAGE_BYTES = 8 * HTB, NXCD = 8, WGM = 8;

__host__ __device__ __forceinline__ int lds_byte(int r, int c) { const int st = (r >> 4) * 2 + (c >> 5), rr = r & 15, cc = c & 31, ob = rr * 64 + cc * 2; return st * 1024 + (ob ^ (((ob >> 9) & 1) << 5)); }
__host__ __device__ __forceinline__ void stage_rc(int b, int& R, int& C) { const int st = b / 1024, sb = b % 1024, swz = sb ^ (((sb >> 9) & 1) << 5); R = (st >> 1) * 16 + swz / 64; C = (st & 1) * 32 + (swz % 64) / 2; }
__host__ __device__ __forceinline__ int perm32(int rho) { const int n = rho >> 4, i = rho & 15; return 8 * (i >> 2) + 4 * n + (i & 3); }

struct Unit { int pm, pn; };
struct Gemm { const bf16_t* A; const bf16_t* Bt; int M, N, K; };

struct StaticOrder {
    int nM, nN, nwg, G, c;
    __host__ __device__ void init(int M, int N, int G_, int c_) { nM = M / BM; nN = N / BM; nwg = nM * nN; G = G_; c = c_; }
    __host__ __device__ bool next(int i, Unit& u) const {
        const long L = (long)i * G + c; if (L >= nwg) return false;
        int wgid = (int)L; { const int q = nwg / NXCD, r = nwg % NXCD, xcd = wgid % NXCD, off = wgid / NXCD; wgid = (xcd < r ? xcd * (q + 1) : r * (q + 1) + (xcd - r) * q) + off; }
        const int nig = WGM * nN, gid = wgid / nig, fm = gid * WGM, gsz = (nM - fm) < WGM ? (nM - fm) : WGM;
        u.pm = fm + ((wgid % nig) % gsz); u.pn = (wgid % nig) / gsz; return true;
    }
    __device__ __forceinline__ void a_ready(const Unit&) const {}
    __device__ __forceinline__ void done(const Unit&) const {}
};

__device__ __forceinline__ unsigned cvt_pk_bf16(float lo, float hi) { unsigned r; asm volatile("v_cvt_pk_bf16_f32 %0, %1, %2" : "=v"(r) : "v"(lo), "v"(hi)); return r; }
template <class Epi, class Sched, bool ALIGN_EPI = false, bool SP2 = false>
__device__ __forceinline__ void gemm_phase(PG8_LAS unsigned char* lds, const Gemm g, const Sched& S, const Epi& E) {
    const int tid = tid_l(), wid = __builtin_amdgcn_readfirstlane(tid >> 6), lane = tid & 63, wr = wid >> 2, wc = wid & 3, fr = lane & 15, fq = lane >> 4;
    const int K = g.K, nt = K / BK;
    unsigned voffA[2], voffB[2];
#pragma unroll
    for (int i = 0; i < 2; ++i) { int R, C; stage_rc(tid * 16 + i * 8192, R, C); const int Rb = Epi::PERM ? ((R & ~31) + perm32(R & 31)) : R;
        voffA[i] = (unsigned)(R * K + C) * 2u; voffB[i] = (unsigned)(Rb * K + C) * 2u; }
    const size_t kstep = (size_t)(BK * 2);
    const size_t hstep = (size_t)HALF * K * 2;
    const size_t tstep = 2 * hstep;
    const unsigned ldsw = (unsigned)wid * 1024u;
    const int aoff = lds_byte(wr * 64 + fr, fq * 8), boff = lds_byte(wc * 32 + fr, fq * 8);
#define PG8_SA(b, h) (((b) * 2 + (h)) * HTB)
#define PG8_SB(b, h) ((4 + (b) * 2 + (h)) * HTB)
#define PG8_STAGE(bufoff, gbase, voff) do { _Pragma("unroll") for (int _i = 0; _i < 2; ++_i) \
        __builtin_amdgcn_global_load_lds((const unsigned*)((const char*)(gbase) + (voff)[_i]), (PG8_LAS unsigned*)(lds + (bufoff) + ldsw + _i * 8192), 16, 0, 0); } while (0)
#define PG8_LDA(dst, b, h) do { _Pragma("unroll") for (int m = 0; m < 4; ++m) _Pragma("unroll") for (int k = 0; k < 2; ++k) dst[m][k] = *(const PG8_LAS bf16x8*)(lds + PG8_SA(b, h) + aoff + m * 2048 + k * 1024); } while (0)
#define PG8_LDB(dst, b, h) do { _Pragma("unroll") for (int n = 0; n < 2; ++n) _Pragma("unroll") for (int k = 0; k < 2; ++k) dst[n][k] = *(const PG8_LAS bf16x8*)(lds + PG8_SB(b, h) + boff + n * 2048 + k * 1024); } while (0)
#define PG8_MMA(ai, bj, At, Bt) do { __builtin_amdgcn_s_setprio(1); _Pragma("unroll") for (int m = 0; m < 4; ++m) _Pragma("unroll") for (int n = 0; n < 2; ++n) _Pragma("unroll") for (int k = 0; k < 2; ++k) \
        acc[ai][bj][m][n] = __builtin_amdgcn_mfma_f32_16x16x32_bf16(Bt[n][k], At[m][k], acc[ai][bj][m][n], 0, 0, 0); __builtin_amdgcn_s_setprio(0); } while (0)
#define PG8_WAIT_V(n) asm volatile("s_waitcnt vmcnt(" #n ")" ::: "memory")
#define PG8_WAIT_L(n) asm volatile("s_waitcnt lgkmcnt(" #n ")" ::: "memory")
#define PG8_BAR __builtin_amdgcn_s_barrier()
#define PG8_SCHED __builtin_amdgcn_sched_barrier(0)
    Unit cur, nxt; int ui = 0;
    if (!S.next(0, cur)) return;
    f32x4 acc[2][2][4][2];
#pragma unroll
    for (int a = 0; a < 2; ++a)
#pragma unroll
        for (int b = 0; b < 2; ++b)
#pragma unroll
            for (int m = 0; m < 4; ++m)
#pragma unroll
                for (int n = 0; n < 2; ++n) acc[a][b][m][n] = (f32x4){0.f, 0.f, 0.f, 0.f};
    bf16x8 At[4][2], B0[2][2], B1[2][2];
    const char* cA = (const char*)g.A + (size_t)cur.pm * tstep; const char* cB = (const char*)g.Bt + (size_t)cur.pn * tstep;
    S.a_ready(cur);
    if constexpr (SP2) {
        PG8_STAGE(PG8_SB(0, 0), cB, voffB); PG8_STAGE(PG8_SB(0, 1), cB + hstep, voffB); PG8_STAGE(PG8_SA(0, 0), cA, voffA); PG8_STAGE(PG8_SA(0, 1), cA + hstep, voffA);
        if (wr == 1) PG8_BAR;
        PG8_WAIT_V(2); PG8_BAR;
        PG8_STAGE(PG8_SB(1, 0), cB + kstep, voffB); PG8_STAGE(PG8_SA(1, 0), cA + kstep, voffA); PG8_STAGE(PG8_SB(1, 1), cB + hstep + kstep, voffB);
        PG8_WAIT_V(6); PG8_BAR;
    } else {
        PG8_STAGE(PG8_SB(0, 0), cB, voffB); PG8_STAGE(PG8_SA(0, 0), cA, voffA); PG8_STAGE(PG8_SB(0, 1), cB + hstep, voffB); PG8_STAGE(PG8_SA(0, 1), cA + hstep, voffA);
        if (wr == 1) PG8_BAR;
        PG8_WAIT_V(4); PG8_BAR;
        PG8_STAGE(PG8_SB(1, 0), cB + kstep, voffB); PG8_STAGE(PG8_SA(1, 0), cA + kstep, voffA); PG8_STAGE(PG8_SB(1, 1), cB + hstep + kstep, voffB);
        PG8_WAIT_V(6); PG8_BAR;
    }
    for (;;) {
        const bool has_next = S.next(ui + 1, nxt);
        const char* nA = has_next ? (const char*)g.A + (size_t)nxt.pm * tstep : cA; const char* nB = has_next ? (const char*)g.Bt + (size_t)nxt.pn * tstep : cB;
        for (int t = 0; t < nt; t += 2) {
            const bool last = (t == nt - 2);
            const char* a1 = cA + (size_t)(t + 1) * kstep;
            const char* a2 = last ? nA : cA + (size_t)(t + 2) * kstep; const char* b2 = last ? nB : cB + (size_t)(t + 2) * kstep;
            const char* a3 = a2 + kstep; const char* b3 = b2 + kstep;
            if (last && has_next) S.a_ready(nxt);
            if constexpr (SP2) {
            PG8_LDB(B0, 0, 0); PG8_LDB(B1, 0, 1); PG8_SCHED; PG8_LDA(At, 0, 0); PG8_STAGE(PG8_SA(1, 1), a1 + hstep, voffA);
            PG8_WAIT_V(8); PG8_WAIT_L(0); PG8_BAR; PG8_MMA(0, 0, At, B0); PG8_MMA(0, 1, At, B1); PG8_BAR; PG8_SCHED;
            PG8_LDA(At, 0, 1); PG8_STAGE(PG8_SB(0, 0), b2, voffB); PG8_STAGE(PG8_SB(0, 1), b2 + hstep, voffB); PG8_STAGE(PG8_SA(0, 0), a2, voffA);
            PG8_WAIT_V(8); PG8_WAIT_L(0); PG8_BAR; PG8_MMA(1, 0, At, B0); PG8_MMA(1, 1, At, B1); PG8_BAR; PG8_SCHED;
            PG8_LDB(B0, 1, 0); PG8_LDB(B1, 1, 1); PG8_SCHED; PG8_LDA(At, 1, 0); PG8_STAGE(PG8_SA(0, 1), a2 + hstep, voffA);
            PG8_WAIT_V(8); PG8_WAIT_L(0); PG8_BAR; PG8_MMA(0, 0, At, B0); PG8_MMA(0, 1, At, B1); PG8_BAR; PG8_SCHED;
            PG8_LDA(At, 1, 1); PG8_STAGE(PG8_SB(1, 0), b3, voffB); PG8_STAGE(PG8_SB(1, 1), b3 + hstep, voffB); PG8_STAGE(PG8_SA(1, 0), a3, voffA);
            PG8_WAIT_V(8); PG8_WAIT_L(0); PG8_BAR; PG8_MMA(1, 0, At, B0); PG8_MMA(1, 1, At, B1); PG8_BAR; PG8_SCHED;
            } else {
            PG8_LDB(B0, 0, 0); PG8_SCHED; PG8_LDA(At, 0, 0); PG8_STAGE(PG8_SA(1, 1), a1 + hstep, voffA);
            PG8_WAIT_L(8); PG8_BAR; PG8_WAIT_L(0); PG8_MMA(0, 0, At, B0); PG8_BAR; PG8_SCHED;
            PG8_LDB(B1, 0, 1); PG8_STAGE(PG8_SB(0, 0), b2, voffB);
            PG8_BAR; PG8_WAIT_L(0); PG8_MMA(0, 1, At, B1); PG8_BAR;
            PG8_LDA(At, 0, 1); PG8_STAGE(PG8_SA(0, 0), a2, voffA);
            PG8_BAR; PG8_WAIT_L(0); PG8_MMA(1, 0, At, B0); PG8_BAR; PG8_SCHED;
            PG8_STAGE(PG8_SB(0, 1), b2 + hstep, voffB);
            PG8_WAIT_V(6); PG8_BAR; PG8_MMA(1, 1, At, B1); PG8_BAR;
            PG8_LDB(B0, 1, 0); PG8_SCHED; PG8_LDA(At, 1, 0); PG8_STAGE(PG8_SA(0, 1), a2 + hstep, voffA);
            PG8_WAIT_L(8); PG8_BAR; PG8_WAIT_L(0); PG8_MMA(0, 0, At, B0); PG8_BAR; PG8_SCHED;
            PG8_LDB(B1, 1, 1); PG8_STAGE(PG8_SB(1, 0), b3, voffB);
            PG8_BAR; PG8_WAIT_L(0); PG8_MMA(0, 1, At, B1); PG8_BAR;
            PG8_LDA(At, 1, 1); PG8_STAGE(PG8_SA(1, 0), a3, voffA);
            PG8_BAR; PG8_WAIT_L(0); PG8_MMA(1, 0, At, B0); PG8_BAR; PG8_SCHED;
            PG8_STAGE(PG8_SB(1, 1), b3 + hstep, voffB);
            PG8_WAIT_V(6); PG8_BAR; PG8_MMA(1, 1, At, B1); PG8_BAR;
            }
        }
        if constexpr (ALIGN_EPI) { if (wr == 0) PG8_BAR; }
        if constexpr (!Epi::AFTER_DRAIN) { E(acc, cur, wr, wc, fr, fq); S.done(cur); }
        if (!has_next) break;
#pragma unroll
        for (int a = 0; a < 2; ++a)
#pragma unroll
            for (int b = 0; b < 2; ++b)
#pragma unroll
                for (int m = 0; m < 4; ++m)
#pragma unroll
                    for (int n = 0; n < 2; ++n) acc[a][b][m][n] = (f32x4){0.f, 0.f, 0.f, 0.f};
        cur = nxt; cA = nA; cB = nB; ++ui;
        if constexpr (ALIGN_EPI) { if (wr == 1) PG8_BAR; }
    }
    PG8_WAIT_V(0);
    if constexpr (!ALIGN_EPI) { if (wr == 0) PG8_BAR; }
    PG8_BAR;
    if constexpr (Epi::AFTER_DRAIN) { E.fused(acc, cur, wr, wc, fr, fq, lds, wid, lane); S.done(cur); }
#undef PG8_SA
#undef PG8_SB
#undef PG8_STAGE
#undef PG8_LDA
#undef PG8_LDB
#undef PG8_MMA
#undef PG8_WAIT_V
#undef PG8_WAIT_L
#undef PG8_BAR
#undef PG8_SCHED
}
}

#define LAS __attribute__((address_space(3)))
typedef unsigned short bf16_t;
typedef short bf16x8 __attribute__((ext_vector_type(8)));
typedef short s16x4 __attribute__((ext_vector_type(4)));
typedef float f32x4 __attribute__((ext_vector_type(4)));
typedef float f32x16 __attribute__((ext_vector_type(16)));
typedef unsigned u32x4 __attribute__((ext_vector_type(4)));
typedef unsigned u32x2 __attribute__((ext_vector_type(2)));
typedef float f32x2_t __attribute__((ext_vector_type(2)));
typedef __bf16 bf16x2_t __attribute__((ext_vector_type(2)));

constexpr int TP = 16384, TS = 256, TT = TP + TS, DM = 1024, DFF = 4096;
constexpr int SEQ = 8192, PAST = 4096, LPAD = 4160, NSEQ = 18;
constexpr float LOG2E = 1.4426950408889634f;
constexpr int NTHR = 512, NWV = 8;
constexpr int LDS_RING = 131072, LDS_BYTES = LDS_RING + 1024;

struct Params {
    const float *x_prompt, *x_sample, *c_prompt, *c_sample, *cfk, *cfv, *cfl, *spool, *csk, *csv;
    const float *w_ada, *b_ada, *norm_g, *w_in_ab, *b_forget, *w_pool, *pool_scale, *w_out_ab, *w_in_sb, *w_out_sb, *w_up, *w_down, *final_g;
    float *y_p, *y_s, *fk_p, *fv_p, *fl_p, *pool_p, *sk_p, *sv_p, *fk_s, *fv_s, *fl_s, *pool_s, *sk_s, *sv_s;
    unsigned* ctl; float *mod, *Wf, *Fp, *Fs;
    bf16_t *Wab, *Woab, *Wsb, *Wosb, *Wup, *Wdn, *XN;
    float* X; bf16_t *Q, *Kp, *Vp; float* U; bf16_t *CAT, *H;
};

#define DI __device__ __forceinline__
DI unsigned cvtpk(float lo, float hi) { f32x2_t v = {lo, hi}; bf16x2_t b = __builtin_convertvector(v, bf16x2_t); return __builtin_bit_cast(unsigned, b); }
DI int seq_of(int t) { return t < TP ? (t >> 13) : 2 + ((t - TP) >> 4); }
DI float wave_sum(float v) {
#pragma unroll
    for (int o = 1; o < 64; o <<= 1) v += __shfl_xor(v, o);
    return v;
}
DI void st_bf4(bf16_t* p, f32x4 v) { u32x2 w; w.x = cvtpk(v[0], v[1]); w.y = cvtpk(v[2], v[3]); *(u32x2*)p = w; }
#define LDS_WAIT() asm volatile("s_waitcnt lgkmcnt(0)" ::: "memory")

DI void tr_item(const float* W, int ldw, int k0, int c0, bf16_t* WT, int ldt, int r0, int kd0, LAS float* scr, int lane) {
#pragma unroll 8
    for (int i = 0; i < 32; ++i) { const int kk = 2 * i + (lane >> 5); scr[kk * 33 + (lane & 31)] = W[(size_t)(k0 + kk) * ldw + c0 + (lane & 31)]; }
    LDS_WAIT();
    const int c = lane & 7;
#pragma unroll
    for (int j = 0; j < 4; ++j) { const int n = (lane >> 3) + 8 * j; const LAS float* s = scr + (8 * c) * 33 + n;
        u32x4 o; o.x = cvtpk(s[0 * 33], s[1 * 33]); o.y = cvtpk(s[2 * 33], s[3 * 33]); o.z = cvtpk(s[4 * 33], s[5 * 33]); o.w = cvtpk(s[6 * 33], s[7 * 33]);
        *(u32x4*)(WT + (size_t)(r0 + n) * ldt + kd0 + 8 * c) = o; }
    LDS_WAIT();
}

DI void phase0(const Params& p, LAS unsigned char* lds) {
    const int tid = tid_l(), lane = tid & 63, wave = tid >> 6;
    if ((int)blockIdx.x < 192) {
        LAS float* cond = (LAS float*)lds;
        LAS float* red = (LAS float*)(lds + 73728);
        for (int i = tid; i < NSEQ * 1024; i += NTHR) { const int s = i >> 10, k = i & 1023; const float c = s < 2 ? p.c_prompt[s * 1024 + k] : p.c_sample[(s - 2) * 1024 + k]; cond[i] = c / (1.0f + expf(-c)); }
        __syncthreads();
        for (int item = blockIdx.x; item < 192; item += gridDim.x) {
            const int layer = item / 96, col0 = (item % 96) * 64, quad = tid & 15, kc = tid >> 4;
            float acc[NSEQ][4];
#pragma unroll
            for (int s = 0; s < NSEQ; ++s) { acc[s][0] = 0.f; acc[s][1] = 0.f; acc[s][2] = 0.f; acc[s][3] = 0.f; }
            const float* wp = p.w_ada + ((size_t)layer * 1024 + kc * 32) * 6144 + col0 + 4 * quad;
#pragma unroll 4
            for (int kk = 0; kk < 32; ++kk) { const f32x4 w = *(const f32x4*)(wp + (size_t)kk * 6144);
#pragma unroll
                for (int s = 0; s < NSEQ; ++s) { const float cs = cond[s * 1024 + kc * 32 + kk]; acc[s][0] += cs * w[0]; acc[s][1] += cs * w[1]; acc[s][2] += cs * w[2]; acc[s][3] += cs * w[3]; } }
#pragma unroll
            for (int s = 0; s < NSEQ; ++s)
#pragma unroll
                for (int j = 0; j < 4; ++j) { float v = acc[s][j]; v += __shfl_xor(v, 16); v += __shfl_xor(v, 32); if (lane < 16) red[((wave * 16 + quad) * NSEQ + s) * 4 + j] = v; }
            __syncthreads();
            for (int o = tid; o < 16 * NSEQ * 4; o += NTHR) { const int qd = o / (NSEQ * 4), rem = o % (NSEQ * 4), s = rem >> 2, j = rem & 3; float sum = 0.f;
#pragma unroll
                for (int w = 0; w < 8; ++w) sum += red[((w * 16 + qd) * NSEQ + s) * 4 + j];
                const int col = col0 + 4 * qd + j; p.mod[((size_t)layer * NSEQ + s) * 6144 + col] = sum + p.b_ada[layer * 6144 + col]; }
            __syncthreads();
        }
    }
    for (int it = (int)gridDim.x - 1 - (int)blockIdx.x; it < 128; it += gridDim.x) {
        const int g = it >> 5, rem = it & 31, cblk = rem >> 1, n = (rem & 1) * 512 + tid;
        float acc[8];
#pragma unroll
        for (int j = 0; j < 8; ++j) acc[j] = 0.f;
        for (int e = 0; e < 128; ++e) { const float wv = p.w_out_ab[(size_t)(512 + 128 * g + e) * 1024 + n] * p.pool_scale[128 * g + e];
#pragma unroll
            for (int j = 0; j < 8; ++j) acc[j] += p.w_pool[((g * 128) + cblk * 8 + j) * 128 + e] * wv; }
        u32x4 o; o.x = cvtpk(acc[0], acc[1]); o.y = cvtpk(acc[2], acc[3]); o.z = cvtpk(acc[4], acc[5]); o.w = cvtpk(acc[6], acc[7]);
        *(u32x4*)(p.Woab + (size_t)n * 1024 + 512 + 128 * g + cblk * 8) = o;
    }
    for (int i = blockIdx.x * NTHR + tid; i < 8192; i += gridDim.x * NTHR) { const int h = i >> 10, k = i & 1023; p.Wf[i] = p.w_in_ab[(size_t)k * 2056 + 1536 + h]; }
    __syncthreads();
    LAS float* scr = (LAS float*)(lds + wave * 16384);
    const int gw = blockIdx.x * NWV + wave, NGW = gridDim.x * NWV;
    constexpr int NITEMS = 1024 + 256 + 1536 + 512 + 4096 + 4096;
    for (int it = gw; it < NITEMS; it += NGW) {
        int r = it;
        if (r < 1024) { const int kb = r >> 6, n0 = (r & 63) * 32, c0 = n0 < 1536 ? n0 : n0 + 8; tr_item(p.w_in_ab, 2056, kb * 64, c0, p.Wab, 1024, n0, kb * 64, scr, lane); continue; } r -= 1024;
        if (r < 256) { const int kb = r >> 5, n0 = (r & 31) * 32; tr_item(p.w_out_ab, 1024, kb * 64, n0, p.Woab, 1024, n0, kb * 64, scr, lane); continue; } r -= 256;
        if (r < 1536) { const int kb = r / 96, n0 = (r % 96) * 32; tr_item(p.w_in_sb, 3072, kb * 64, n0, p.Wsb, 1024, n0, kb * 64, scr, lane); continue; } r -= 1536;
        if (r < 512) { const int kb = r >> 5, n0 = (r & 31) * 32; tr_item(p.w_out_sb, 1024, kb * 64, n0, p.Wosb, 1024, n0, kb * 64, scr, lane); continue; } r -= 512;
        if (r < 4096) { const int layer = r >> 11, r2 = r & 2047, kb = r2 >> 7, n0 = (r2 & 127) * 32;
            tr_item(p.w_up + (size_t)layer * 1024 * 4096, 4096, kb * 64, n0, p.Wup + (size_t)layer * 4096 * 1024, 1024, n0, kb * 64, scr, lane); continue; } r -= 4096;
        { const int layer = r >> 11, r2 = r & 2047, kb = r2 >> 5, n0 = (r2 & 31) * 32;
            tr_item(p.w_down + (size_t)layer * 4096 * 1024, 1024, kb * 64, n0, p.Wdn + (size_t)layer * 1024 * 4096, 4096, n0, kb * 64, scr, lane); }
    }
}

template <bool FLOGIT>
DI void norm_phase(const Params& p, int layer, int which, const float* xin_p, const float* xin_s) {
    const int tid = tid_l(), lane = tid & 63, wave = tid >> 6;
    const int gw = blockIdx.x * NWV + wave, NGW = gridDim.x * NWV;
    const float* gptr = p.norm_g + (layer * 2 + which) * 1024;
    for (int t = gw; t < TT; t += NGW) {
        const float* xr = t < TP ? xin_p + (size_t)t * 1024 : xin_s + (size_t)(t - TP) * 1024;
        const float* md = p.mod + ((size_t)layer * NSEQ + seq_of(t)) * 6144 + (which ? 3072 : 0);
        f32x4 v[4]; float ss = 0.f;
#pragma unroll
        for (int j = 0; j < 4; ++j) { v[j] = *(const f32x4*)(xr + 4 * lane + 256 * j); ss += (v[j][0] * v[j][0] + v[j][1] * v[j][1]) + (v[j][2] * v[j][2] + v[j][3] * v[j][3]); }
        const float rstd = 1.0f / sqrtf(wave_sum(ss) * (1.0f / 1024.0f) + 1e-6f);
        float fd[8];
#pragma unroll
        for (int h = 0; h < 8; ++h) fd[h] = 0.f;
#pragma unroll
        for (int j = 0; j < 4; ++j) { const int col = 4 * lane + 256 * j;
            const f32x4 g = *(const f32x4*)(gptr + col), sh = *(const f32x4*)(md + col), sc = *(const f32x4*)(md + 1024 + col);
            f32x4 y;
#pragma unroll
            for (int e = 0; e < 4; ++e) y[e] = (v[j][e] * rstd * g[e]) * (1.0f + sc[e]) + sh[e];
            st_bf4(p.XN + (size_t)t * 1024 + col, y);
            if (FLOGIT) {
#pragma unroll
                for (int h = 0; h < 8; ++h) { const f32x4 w = *(const f32x4*)(p.Wf + h * 1024 + col); fd[h] += (y[0] * w[0] + y[1] * w[1]) + (y[2] * w[2] + y[3] * w[3]); } }
        }
        if (FLOGIT) {
            float mine = 0.f;
#pragma unroll
            for (int h = 0; h < 8; ++h) { const float s = wave_sum(fd[h]); if (lane == h) mine = s; }
            if (lane < 8) { const float z = mine + p.b_forget[lane]; const float lf = fminf(z, 0.f) - log1pf(expf(-fabsf(z)));
                if (t < TP) p.fl_p[(size_t)t * 8 + lane] = lf; else p.fl_s[(size_t)(t - TP) * 8 + lane] = lf; }
        }
    }
}
DI void final_norm_phase(const Params& p) {
    const int tid = tid_l(), lane = tid & 63, wave = tid >> 6;
    const int gw = blockIdx.x * NWV + wave, NGW = gridDim.x * NWV;
    for (int t = gw; t < TT; t += NGW) {
        const float* xr = p.X + (size_t)t * 1024; float* yr = t < TP ? p.y_p + (size_t)t * 1024 : p.y_s + (size_t)(t - TP) * 1024;
        f32x4 v[4]; float ss = 0.f;
#pragma unroll
        for (int j = 0; j < 4; ++j) { v[j] = *(const f32x4*)(xr + 4 * lane + 256 * j); ss += (v[j][0] * v[j][0] + v[j][1] * v[j][1]) + (v[j][2] * v[j][2] + v[j][3] * v[j][3]); }
        const float rstd = 1.0f / sqrtf(wave_sum(ss) * (1.0f / 1024.0f) + 1e-6f);
#pragma unroll
        for (int j = 0; j < 4; ++j) { const int col = 4 * lane + 256 * j; const f32x4 g = *(const f32x4*)(p.final_g + col); f32x4 y;
#pragma unroll
            for (int e = 0; e < 4; ++e) y[e] = v[j][e] * rstd * g[e];
            *(f32x4*)(yr + col) = y; }
    }
}

struct EmitQkvAB { bf16_t *Q, *Kp, *Vp; float *U, *fk_p, *fv_p, *fk_s, *fv_s;
    DI void emit(int t, int c, f32x4 v) const {
        if (c < 512) { st_bf4(Q + (size_t)t * 512 + c, v); }
        else if (c < 1024) { const int cc = c - 512; if (t < TP) { st_bf4(Kp + (size_t)t * 512 + cc, v); *(f32x4*)(fk_p + (size_t)t * 512 + cc) = v; } else *(f32x4*)(fk_s + (size_t)(t - TP) * 512 + cc) = v; }
        else if (c < 1536) { const int cc = c - 1024; if (t < TP) { st_bf4(Vp + (size_t)t * 512 + cc, v); *(f32x4*)(fv_p + (size_t)t * 512 + cc) = v; } else *(f32x4*)(fv_s + (size_t)(t - TP) * 512 + cc) = v; }
        else { *(f32x4*)(U + (size_t)t * 512 + (c - 1536)) = v; }
    } };
struct EmitQkvSB { bf16_t *Q, *Kp, *Vp; float *sk_p, *sv_p, *sk_s, *sv_s;
    DI void emit(int t, int c, f32x4 v) const {
        if (c < 1024) { st_bf4(Q + (size_t)t * 1024 + c, v); }
        else if (c < 2048) { const int cc = c - 1024; if (t < TP) { st_bf4(Kp + (size_t)t * 1024 + cc, v); *(f32x4*)(sk_p + (size_t)t * 1024 + cc) = v; } else *(f32x4*)(sk_s + (size_t)(t - TP) * 1024 + cc) = v; }
        else { const int cc = c - 2048; if (t < TP) { st_bf4(Vp + (size_t)t * 1024 + cc, v); *(f32x4*)(sv_p + (size_t)t * 1024 + cc) = v; } else *(f32x4*)(sv_s + (size_t)(t - TP) * 1024 + cc) = v; }
    } };
struct EmitRes { const float* xin_p; const float* xin_s; const float* modg; float* X;
    DI void emit(int t, int c, f32x4 v) const {
        const float* xr = t < TP ? xin_p + (size_t)t * 1024 : xin_s + (size_t)(t - TP) * 1024;
        const f32x4 x = *(const f32x4*)(xr + c), g = *(const f32x4*)(modg + (size_t)seq_of(t) * 6144 + c);
        *(f32x4*)(X + (size_t)t * 1024 + c) = x + g * v;
    } };
struct EmitUp { bf16_t* H;
    DI void emit(int t, int c, f32x4 v) const { f32x4 r;
#pragma unroll
        for (int e = 0; e < 4; ++e) { const float a = fmaxf(v[e], 0.f); r[e] = a * a; }
        st_bf4(H + (size_t)t * 4096 + c, r); } };

template <class F> struct EpiEmit {
    static constexpr bool PERM = false, AFTER_DRAIN = false;
    F f;
    DI void operator()(const pg8::f32x4 (&acc)[2][2][4][2], const pg8::Unit& u, int wr, int wc, int fr, int fq) const {
        const int row0 = u.pm * 256 + wr * 64 + fr, col0 = u.pn * 256 + wc * 32 + 4 * fq;
#pragma unroll
        for (int ai = 0; ai < 2; ++ai)
#pragma unroll
            for (int m = 0; m < 4; ++m)
#pragma unroll
                for (int bj = 0; bj < 2; ++bj)
#pragma unroll
                    for (int n = 0; n < 2; ++n) f.emit(row0 + ai * 128 + m * 16, col0 + bj * 128 + n * 16, acc[ai][bj][m][n]);
    }
};

template <class F>
DI void skinny_gemm(LAS unsigned char* lds, const bf16_t* A, const bf16_t* Bt, int N, int K, const F& f) {
    const int tid = tid_l(), lane = tid & 63, wave = tid >> 6, rsub = wave & 3, kh = wave >> 2, fr = lane & 15, fq = lane >> 4;
    const int nitems = 4 * (N >> 4), Kh = K >> 1;
    LAS f32x4* red = (LAS f32x4*)lds;
    for (int item = blockIdx.x; item < nitems; item += gridDim.x) {
        const int rb = item & 3, cb = item >> 2;
        const bf16_t* ap = A + (size_t)(rb * 64 + rsub * 16 + fr) * K + kh * Kh + 8 * fq;
        const bf16_t* bp = Bt + (size_t)(cb * 16 + fr) * K + kh * Kh + 8 * fq;
        f32x4 acc = {0.f, 0.f, 0.f, 0.f};
        for (int ks = 0; ks < Kh; ks += 256) {
            bf16x8 a[8], b[8];
#pragma unroll
            for (int i = 0; i < 8; ++i) { a[i] = *(const bf16x8*)(ap + ks + 32 * i); b[i] = *(const bf16x8*)(bp + ks + 32 * i); }
#pragma unroll
            for (int i = 0; i < 8; ++i) acc = __builtin_amdgcn_mfma_f32_16x16x32_bf16(b[i], a[i], acc, 0, 0, 0);
        }
        if (kh == 1) red[rsub * 64 + lane] = acc;
        __syncthreads();
        if (kh == 0) { acc = acc + red[rsub * 64 + lane]; f.emit(TP + rb * 64 + rsub * 16 + fr, cb * 16 + 4 * fq, acc); }
        __syncthreads();
    }
}

template <class F>
DI void gemm_all(LAS unsigned char* lds, const bf16_t* A, const bf16_t* Bt, int N, int K, const F& f) {
    { pg8::Gemm g{A, Bt, TP, N, K}; pg8::StaticOrder S; S.init(TP, N, (int)gridDim.x, (int)blockIdx.x);
      EpiEmit<F> E{f};
      pg8::gemm_phase<EpiEmit<F>, pg8::StaticOrder, true, true>(lds, g, S, E); }
    __syncthreads();
    skinny_gemm<F>(lds, A + (size_t)TP * K, Bt, N, K, f);
}

template <int PER>
DI void scan_item(LAS unsigned char* lds, const float* src_a, int na, const float* src_b, int ntot, int stride, float* dst, int ndst) {
    const int tid = tid_l(), lane = tid & 63, wave = tid >> 6;
    LAS float* wt = (LAS float*)lds;
    float v[PER]; float tot = 0.f;
#pragma unroll
    for (int i = 0; i < PER; ++i) { const int pos = tid * PER + i; float x = 0.f; if (pos < na) x = src_a[(size_t)pos * stride]; else if (pos < ntot) x = src_b[(size_t)(pos - na) * stride]; tot += x; v[i] = tot; }
    float inc = tot;
#pragma unroll
    for (int o = 1; o < 64; o <<= 1) { const float t = __shfl_up(inc, o); if (lane >= o) inc += t; }
    __syncthreads();
    if (lane == 63) wt[wave] = inc;
    __syncthreads();
    float base = 0.f;
#pragma unroll
    for (int w = 0; w < 8; ++w) if (w < wave) base += wt[w];
    const float ex = base + inc - tot;
#pragma unroll
    for (int i = 0; i < PER; ++i) { const int pos = tid * PER + i; if (pos < ntot) dst[pos] = ex + v[i]; else if (pos < ndst) dst[pos] = 0.f; }
}
DI void phase3(const Params& p, LAS unsigned char* lds) {
    const int tid = tid_l();
    for (int it = blockIdx.x; it < 144; it += gridDim.x) {
        if (it < 16) { scan_item<16>(lds, p.fl_p + (size_t)(it >> 3) * SEQ * 8 + (it & 7), SEQ, nullptr, SEQ, 8, p.Fp + (size_t)it * SEQ, SEQ); }
        else { const int bh = it - 16, b = bh >> 3, h = bh & 7;
            scan_item<9>(lds, p.cfl + (size_t)b * PAST * 8 + h, PAST, p.fl_s + (size_t)b * 16 * 8 + h, PAST + 16, 8, p.Fs + (size_t)bh * LPAD, LPAD); }
    }
    for (int i = blockIdx.x * NTHR + tid; i < TT * 128; i += gridDim.x * NTHR) {
        const int t = i >> 7, c = (i & 127) * 4, g = c >> 7, w = 2 << g;
        const f32x4 u = *(const f32x4*)(p.U + (size_t)t * 512 + c);
        f32x4 sum = u; float cnt;
        if (t < TP) { const int pos = t & (SEQ - 1); const int nw = pos + 1 < w ? pos + 1 : w; cnt = (float)nw;
            for (int k = 1; k < nw; ++k) sum += *(const f32x4*)(p.U + (size_t)(t - k) * 512 + c);
            if (pos >= SEQ - 15) *(f32x4*)(p.pool_p + ((size_t)(t >> 13) * 15 + (pos - (SEQ - 15))) * 512 + c) = u;
        } else { const int b = (t - TP) >> 4, loc = (t - TP) & 15; cnt = (float)w;
            for (int k = 1; k < w; ++k) { const int li = loc - k; sum += li >= 0 ? *(const f32x4*)(p.U + (size_t)(t - k) * 512 + c) : *(const f32x4*)(p.spool + ((size_t)b * 15 + 15 + li) * 512 + c); }
            if (loc >= 1) *(f32x4*)(p.pool_s + ((size_t)b * 15 + loc - 1) * 512 + c) = u;
        }
        f32x4 r;
#pragma unroll
        for (int e = 0; e < 4; ++e) r[e] = sum[e] / cnt - u[e];
        st_bf4(p.CAT + (size_t)t * 1024 + 512 + c, r);
    }
}

constexpr int AKS = 9216, A_VOFF = 4 * AKS, A_FOFF = 8 * AKS;
#define MFMA32(a, b, c) __builtin_amdgcn_mfma_f32_32x32x16_bf16((a), (b), (c), 0, 0, 0)
#define TRQ(l0, l1, h0, h1, addr, O0, O1, O2, O3) asm volatile("ds_read_b64_tr_b16 %0, %4 offset:" #O0 "\n\tds_read_b64_tr_b16 %1, %4 offset:" #O1 "\n\tds_read_b64_tr_b16 %2, %4 offset:" #O2 "\n\tds_read_b64_tr_b16 %3, %4 offset:" #O3 "\n\ts_waitcnt lgkmcnt(0)" \
    : "=&v"(l0), "=&v"(l1), "=&v"(h0), "=&v"(h1) : "v"(addr) : "memory")
DI bf16x8 pack8(const f32x16& s, int base) { u32x4 w; w.x = cvtpk(s[base], s[base + 1]); w.y = cvtpk(s[base + 2], s[base + 3]); w.z = cvtpk(s[base + 4], s[base + 5]); w.w = cvtpk(s[base + 6], s[base + 7]); return __builtin_bit_cast(bf16x8, w); }

template <int MODE, bool SAMPLE, int H>
DI void attn_unit(const Params& p, LAS unsigned char* lds, int b, int ub, int qb) {
    constexpr int PITCH = H * 64;
    constexpr float C1 = 0.125f * LOG2E;
    const int tid = tid_l(), lane = tid & 63, wave = tid >> 6, l31 = lane & 31, hh = lane >> 5;
    const int row = tid >> 3, ch = tid & 7;
    int head, slot, jt_top, jt_w, qpos, qrow; bool active;
    if (!SAMPLE) { head = ub; slot = 0; jt_top = 4 * qb + 3; jt_w = 4 * qb + (wave >> 1); qpos = 256 * qb + 32 * wave + l31; qrow = b * SEQ + qpos; active = true; }
    else { head = 4 * ub + (wave & 3); slot = wave & 3; jt_top = 64; jt_w = 64; qpos = PAST + (lane & 15); qrow = TP + 16 * b + (lane & 15); active = wave < 4; }
    const float* cK = MODE == 0 ? p.cfk : p.csk; const float* cV = MODE == 0 ? p.cfv : p.csv;
    const float* nK = MODE == 0 ? p.fk_s : p.sk_s; const float* nV = MODE == 0 ? p.fv_s : p.sv_s;
    bf16x8 qf[4];
    { const bf16_t* qp = p.Q + (size_t)qrow * PITCH + head * 64 + 8 * hh;
#pragma unroll
      for (int s = 0; s < 4; ++s) qf[s] = *(const bf16x8*)(qp + 16 * s); }
    float ft2 = 0.f;
    if (MODE == 0) ft2 = (SAMPLE ? p.Fs[(size_t)(b * 8 + head) * LPAD + qpos] : p.Fp[(size_t)(b * 8 + head) * SEQ + qpos]) * LOG2E;
    f32x16 o0, o1;
#pragma unroll
    for (int i = 0; i < 16; ++i) { o0[i] = 0.f; o1[i] = 0.f; }
    float m_run = -INFINITY, l_run = 0.f, R = 1.0f;
    u32x4 kreg = {0, 0, 0, 0}, vreg = {0, 0, 0, 0}; float freg = 0.f;
    f32x4 kr[4][2], vr[4][2];
#define LOAD_TILE(JT) do { const int jt_ = (JT); \
    if (!SAMPLE) { \
        kreg = *(const u32x4*)(p.Kp + (size_t)(b * SEQ + 64 * jt_ + row) * PITCH + head * 64 + ch * 8); \
        vreg = *(const u32x4*)(p.Vp + (size_t)(b * SEQ + 64 * jt_ + row) * PITCH + head * 64 + ch * 8); \
        if (MODE == 0 && tid < 64) freg = p.Fp[(size_t)(b * 8 + head) * SEQ + 64 * jt_ + tid] * LOG2E; \
    } else { \
        _Pragma("unroll") for (int i = 0; i < 4; ++i) { const int hd = 4 * ub + i; \
            if (jt_ < 64) { const size_t off = ((size_t)(b * PAST + 64 * jt_ + row) * H + hd) * 64 + 8 * ch; \
                kr[i][0] = *(const f32x4*)(cK + off); kr[i][1] = *(const f32x4*)(cK + off + 4); vr[i][0] = *(const f32x4*)(cV + off); vr[i][1] = *(const f32x4*)(cV + off + 4); } \
            else if (row < 16) { const size_t off = ((size_t)(b * 16 + row) * H + hd) * 64 + 8 * ch; \
                kr[i][0] = *(const f32x4*)(nK + off); kr[i][1] = *(const f32x4*)(nK + off + 4); vr[i][0] = *(const f32x4*)(nV + off); vr[i][1] = *(const f32x4*)(nV + off + 4); } \
            else { kr[i][0] = (f32x4){0.f, 0.f, 0.f, 0.f}; kr[i][1] = kr[i][0]; vr[i][0] = kr[i][0]; vr[i][1] = kr[i][0]; } } \
        if (MODE == 0 && tid < 256) freg = p.Fs[(size_t)(b * 8 + 4 * ub + (tid >> 6)) * LPAD + 64 * jt_ + (tid & 63)] * LOG2E; \
    } } while (0)
#define STORE_TILE() do { \
    if (!SAMPLE) { *(LAS u32x4*)(lds + row * 144 + ch * 16) = kreg; *(LAS u32x4*)(lds + A_VOFF + row * 144 + ch * 16) = vreg; if (MODE == 0 && tid < 64) *(LAS float*)(lds + A_FOFF + tid * 4) = freg; } \
    else { _Pragma("unroll") for (int i = 0; i < 4; ++i) { u32x4 kk, vv; \
            kk.x = cvtpk(kr[i][0][0], kr[i][0][1]); kk.y = cvtpk(kr[i][0][2], kr[i][0][3]); kk.z = cvtpk(kr[i][1][0], kr[i][1][1]); kk.w = cvtpk(kr[i][1][2], kr[i][1][3]); \
            vv.x = cvtpk(vr[i][0][0], vr[i][0][1]); vv.y = cvtpk(vr[i][0][2], vr[i][0][3]); vv.z = cvtpk(vr[i][1][0], vr[i][1][1]); vv.w = cvtpk(vr[i][1][2], vr[i][1][3]); \
            *(LAS u32x4*)(lds + i * AKS + row * 144 + ch * 16) = kk; *(LAS u32x4*)(lds + A_VOFF + i * AKS + row * 144 + ch * 16) = vv; } \
        if (MODE == 0 && tid < 256) *(LAS float*)(lds + A_FOFF + tid * 4) = freg; } } while (0)

    const unsigned ldsb = (unsigned)(uintptr_t)lds;
    const unsigned kb = slot * AKS + l31 * 144 + hh * 16;
    const unsigned vaddr = ldsb + A_VOFF + slot * AKS + (4 * hh + ((lane & 15) >> 2)) * 144 + 32 * ((lane >> 4) & 1) + 8 * (lane & 3);
    LOAD_TILE(jt_top);
    for (int jt = jt_top; jt >= 0; --jt) {
        __syncthreads();
        STORE_TILE();
        __syncthreads();
        if (jt > 0) LOAD_TILE(jt - 1);
        if (active && jt <= jt_w) {
            f32x16 s0, s1;
#pragma unroll
            for (int i = 0; i < 16; ++i) { s0[i] = 0.f; s1[i] = 0.f; }
#pragma unroll
            for (int s = 0; s < 4; ++s) { const bf16x8 k0 = *(const LAS bf16x8*)(lds + kb + s * 32); const bf16x8 k1 = *(const LAS bf16x8*)(lds + kb + 32 * 144 + s * 32);
                s0 = MFMA32(k0, qf[s], s0); s1 = MFMA32(k1, qf[s], s1); }
            const bool domask = (jt == jt_w);
            const int kbase = 64 * jt + 4 * hh;
            if (MODE == 0) {
                float tmax = -INFINITY;
#pragma unroll
                for (int g = 0; g < 4; ++g) {
                    const f32x4 f0 = *(const LAS f32x4*)(lds + A_FOFF + slot * 256 + (8 * g + 4 * hh) * 4), f1 = *(const LAS f32x4*)(lds + A_FOFF + slot * 256 + (32 + 8 * g + 4 * hh) * 4);
#pragma unroll
                    for (int r = 0; r < 4; ++r) { const int i = 4 * g + r;
                        float v0 = s0[i] * C1 + (ft2 - f0[r]), v1 = s1[i] * C1 + (ft2 - f1[r]);
                        if (domask) { if (kbase + 8 * g + r > qpos) v0 = -INFINITY; if (kbase + 32 + 8 * g + r > qpos) v1 = -INFINITY; }
                        s0[i] = v0; s1[i] = v1; tmax = fmaxf(tmax, fmaxf(v0, v1)); }
                }
                tmax = fmaxf(tmax, __shfl_xor(tmax, 32));
                const float m_new = fmaxf(m_run, tmax);
                const float alpha = __builtin_amdgcn_exp2f(m_run - m_new);
                m_run = m_new; l_run *= alpha;
#pragma unroll
                for (int i = 0; i < 16; ++i) { o0[i] *= alpha; o1[i] *= alpha; }
                float ls = 0.f;
#pragma unroll
                for (int i = 0; i < 16; ++i) { const float p0 = __builtin_amdgcn_exp2f(s0[i] - m_new), p1 = __builtin_amdgcn_exp2f(s1[i] - m_new); s0[i] = p0; s1[i] = p1; ls += p0 + p1; }
                l_run += ls;
            } else {
                f32x16 q0, q1;
#pragma unroll
                for (int i = 0; i < 16; ++i) {
                    const float e0 = __builtin_amdgcn_exp2f(fminf(s0[i] * C1, 100.f)), e1 = __builtin_amdgcn_exp2f(fminf(s1[i] * C1, 100.f));
                    float om0 = __builtin_amdgcn_rcpf(1.0f + e0), om1 = __builtin_amdgcn_rcpf(1.0f + e1);
                    float sg0 = e0 * om0, sg1 = e1 * om1;
                    if (domask) { const int kp = kbase + 8 * (i >> 2) + (i & 3); if (kp >= qpos) { om0 = 1.0f; sg0 = 0.f; } if (kp + 32 >= qpos) { om1 = 1.0f; sg1 = 0.f; } }
                    s0[i] = sg0; s1[i] = sg1; q0[i] = om0; q1[i] = om1;
                }
                float G[8], Gp[8];
#pragma unroll
                for (int g = 0; g < 4; ++g) { G[g] = (q0[4 * g] * q0[4 * g + 1]) * (q0[4 * g + 2] * q0[4 * g + 3]); G[4 + g] = (q1[4 * g] * q1[4 * g + 1]) * (q1[4 * g + 2] * q1[4 * g + 3]); }
#pragma unroll
                for (int g = 0; g < 8; ++g) Gp[g] = __shfl_xor(G[g], 32);
                float C = R;
#pragma unroll
                for (int g = 7; g >= 4; --g) { const int b4 = 4 * (g - 4); float suf = hh == 0 ? C * Gp[g] : C;
                    s1[b4 + 3] *= suf; suf *= q1[b4 + 3]; s1[b4 + 2] *= suf; suf *= q1[b4 + 2]; s1[b4 + 1] *= suf; suf *= q1[b4 + 1]; s1[b4] *= suf;
                    C = C * (G[g] * Gp[g]); }
#pragma unroll
                for (int g = 3; g >= 0; --g) { const int b4 = 4 * g; float suf = hh == 0 ? C * Gp[g] : C;
                    s0[b4 + 3] *= suf; suf *= q0[b4 + 3]; s0[b4 + 2] *= suf; suf *= q0[b4 + 2]; s0[b4 + 1] *= suf; suf *= q0[b4 + 1]; s0[b4] *= suf;
                    C = C * (G[g] * Gp[g]); }
                R = C;
            }
            s16x4 l0, l1, h0, h1; bf16x8 pf;
            TRQ(l0, l1, h0, h1, vaddr, 0, 64, 1152, 1216);
            pf = pack8(s0, 0); o0 = MFMA32(__builtin_shufflevector(l0, h0, 0, 1, 2, 3, 4, 5, 6, 7), pf, o0); o1 = MFMA32(__builtin_shufflevector(l1, h1, 0, 1, 2, 3, 4, 5, 6, 7), pf, o1);
            TRQ(l0, l1, h0, h1, vaddr, 2304, 2368, 3456, 3520);
            pf = pack8(s0, 8); o0 = MFMA32(__builtin_shufflevector(l0, h0, 0, 1, 2, 3, 4, 5, 6, 7), pf, o0); o1 = MFMA32(__builtin_shufflevector(l1, h1, 0, 1, 2, 3, 4, 5, 6, 7), pf, o1);
            TRQ(l0, l1, h0, h1, vaddr, 4608, 4672, 5760, 5824);
            pf = pack8(s1, 0); o0 = MFMA32(__builtin_shufflevector(l0, h0, 0, 1, 2, 3, 4, 5, 6, 7), pf, o0); o1 = MFMA32(__builtin_shufflevector(l1, h1, 0, 1, 2, 3, 4, 5, 6, 7), pf, o1);
            TRQ(l0, l1, h0, h1, vaddr, 6912, 6976, 8064, 8128);
            pf = pack8(s1, 8); o0 = MFMA32(__builtin_shufflevector(l0, h0, 0, 1, 2, 3, 4, 5, 6, 7), pf, o0); o1 = MFMA32(__builtin_shufflevector(l1, h1, 0, 1, 2, 3, 4, 5, 6, 7), pf, o1);
        }
    }
#undef LOAD_TILE
#undef STORE_TILE
    if (MODE == 0) { const float lt = l_run + __shfl_xor(l_run, 32); const float inv = 1.0f / lt;
#pragma unroll
        for (int i = 0; i < 16; ++i) { o0[i] *= inv; o1[i] *= inv; } }
    if (active && (!SAMPLE || l31 < 16)) {
        bf16_t* op = p.CAT + (size_t)qrow * 1024 + head * 64 + 4 * hh;
#pragma unroll
        for (int g = 0; g < 4; ++g) { u32x2 w0, w1; w0.x = cvtpk(o0[4 * g], o0[4 * g + 1]); w0.y = cvtpk(o0[4 * g + 2], o0[4 * g + 3]); w1.x = cvtpk(o1[4 * g], o1[4 * g + 1]); w1.y = cvtpk(o1[4 * g + 2], o1[4 * g + 3]);
            *(u32x2*)(op + 8 * g) = w0; *(u32x2*)(op + 32 + 8 * g) = w1; }
    }
}

template <int MODE, int H>
DI void attn_phase(const Params& p, LAS unsigned char* lds, unsigned* ctr) {
    constexpr int NS = 16 * (H / 4), NPB = 2 * H, TOTAL = NS + NPB * 32;
    volatile LAS int* slotw = (volatile LAS int*)(lds + LDS_RING);
    for (;;) {
        __syncthreads();
        if (threadIdx.x == 0) *slotw = (int)atomicAdd(ctr, 1u);
        __syncthreads();
        int u = *slotw;
        if (u >= TOTAL) break;
        if (u < NS) attn_unit<MODE, true, H>(p, lds, u / (H / 4), u % (H / 4), 0);
        else { u -= NS; const int qb = 31 - u / NPB, bh = u % NPB; attn_unit<MODE, false, H>(p, lds, bh / H, bh % H, qb); }
    }
}

__global__ void __launch_bounds__(NTHR, 2) mega(Params p) {
    extern __shared__ __attribute__((aligned(16))) unsigned char lds_raw[];
    LAS unsigned char* lds = (LAS unsigned char*)lds_raw;
    cg::grid_group grid = cg::this_grid();
#define GSYNC() grid.sync()
    float* Xs = p.X + (size_t)TP * 1024;
    phase0(p, lds); GSYNC();
    norm_phase<true>(p, 0, 0, p.x_prompt, p.x_sample); GSYNC();
    { EmitQkvAB e{p.Q, p.Kp, p.Vp, p.U, p.fk_p, p.fv_p, p.fk_s, p.fv_s}; gemm_all(lds, p.XN, p.Wab, 2048, 1024, e); } GSYNC();
    phase3(p, lds); GSYNC();
    attn_phase<0, 8>(p, lds, p.ctl); GSYNC();
    { EmitRes e{p.x_prompt, p.x_sample, p.mod + 2048, p.X}; gemm_all(lds, p.CAT, p.Woab, 1024, 1024, e); } GSYNC();
    norm_phase<false>(p, 0, 1, p.X, Xs); GSYNC();
    { EmitUp e{p.H}; gemm_all(lds, p.XN, p.Wup, 4096, 1024, e); } GSYNC();
    { EmitRes e{p.X, Xs, p.mod + 5120, p.X}; gemm_all(lds, p.H, p.Wdn, 1024, 4096, e); } GSYNC();
    norm_phase<false>(p, 1, 0, p.X, Xs); GSYNC();
    { EmitQkvSB e{p.Q, p.Kp, p.Vp, p.sk_p, p.sv_p, p.sk_s, p.sv_s}; gemm_all(lds, p.XN, p.Wsb, 3072, 1024, e); } GSYNC();
    attn_phase<1, 16>(p, lds, p.ctl + 64); GSYNC();
    { EmitRes e{p.X, Xs, p.mod + (size_t)NSEQ * 6144 + 2048, p.X}; gemm_all(lds, p.CAT, p.Wosb, 1024, 1024, e); } GSYNC();
    norm_phase<false>(p, 1, 1, p.X, Xs); GSYNC();
    { EmitUp e{p.H}; gemm_all(lds, p.XN, p.Wup + (size_t)4096 * 1024, 4096, 1024, e); } GSYNC();
    { EmitRes e{p.X, Xs, p.mod + (size_t)NSEQ * 6144 + 5120, p.X}; gemm_all(lds, p.H, p.Wdn + (size_t)1024 * 4096, 1024, 4096, e); } GSYNC();
    final_norm_phase(p);
}

extern "C" void kernel_launch(void* const* d_in, const int* in_sizes, int n_in, void* d_out, int out_size, void* d_ws, size_t ws_size, hipStream_t stream) {
    static int grid = 0;
    if (grid == 0) {
        int dev = 0, cus = 0, per_cu = 0;
        hipGetDevice(&dev);
        hipDeviceGetAttribute(&cus, hipDeviceAttributeMultiprocessorCount, dev);
        if (hipFuncSetAttribute((const void*)mega, hipFuncAttributeMaxDynamicSharedMemorySize, LDS_BYTES) != hipSuccess) fprintf(stderr, "kernel_launch: hipFuncSetAttribute failed\n");
        if (hipOccupancyMaxActiveBlocksPerMultiprocessor(&per_cu, (const void*)mega, NTHR, LDS_BYTES) != hipSuccess || per_cu < 1) { fprintf(stderr, "kernel_launch: occupancy query says %d\n", per_cu); per_cu = 1; }
        (void)hipGetLastError();
        if (per_cu > 1) per_cu = 1;
        grid = cus * per_cu;
        if (n_in != 23 || out_size != 68428800 || ws_size < ((size_t)446 << 20)) fprintf(stderr, "kernel_launch: unexpected sizes n_in %d out %d ws %zu\n", n_in, out_size, ws_size);
    }
    const float* const* in = (const float* const*)d_in;
    Params p{};
    p.x_prompt = in[0]; p.x_sample = in[1]; p.c_prompt = in[2]; p.c_sample = in[3]; p.cfk = in[4]; p.cfv = in[5]; p.cfl = in[6]; p.spool = in[7]; p.csk = in[8]; p.csv = in[9];
    p.w_ada = in[10]; p.b_ada = in[11]; p.norm_g = in[12]; p.w_in_ab = in[13]; p.b_forget = in[14]; p.w_pool = in[15]; p.pool_scale = in[16]; p.w_out_ab = in[17];
    p.w_in_sb = in[18]; p.w_out_sb = in[19]; p.w_up = in[20]; p.w_down = in[21]; p.final_g = in[22];
    float* o = (float*)d_out;
    p.y_p = o; p.y_s = o + 16777216; p.fk_p = o + 17039360; p.fv_p = o + 25427968; p.fl_p = o + 33816576; p.pool_p = o + 33947648; p.sk_p = o + 33963008; p.sv_p = o + 50740224;
    p.fk_s = o + 67517440; p.fv_s = o + 67648512; p.fl_s = o + 67779584; p.pool_s = o + 67781632; p.sk_s = o + 67904512; p.sv_s = o + 68166656;
    unsigned char* ws = (unsigned char*)d_ws; const size_t MB = (size_t)1 << 20;
    p.ctl = (unsigned*)ws; p.mod = (float*)(ws + 1 * MB); p.Wf = (float*)(ws + 2 * MB); p.Fp = (float*)(ws + 3 * MB); p.Fs = (float*)(ws + 4 * MB);
    p.Wab = (bf16_t*)(ws + 8 * MB); p.Woab = (bf16_t*)(ws + 12 * MB); p.Wsb = (bf16_t*)(ws + 14 * MB); p.Wosb = (bf16_t*)(ws + 20 * MB); p.Wup = (bf16_t*)(ws + 22 * MB); p.Wdn = (bf16_t*)(ws + 38 * MB);
    p.XN = (bf16_t*)(ws + 54 * MB); p.X = (float*)(ws + 87 * MB); p.Q = (bf16_t*)(ws + 152 * MB); p.Kp = (bf16_t*)(ws + 185 * MB); p.Vp = (bf16_t*)(ws + 217 * MB);
    p.U = (float*)(ws + 249 * MB); p.CAT = (bf16_t*)(ws + 282 * MB); p.H = (bf16_t*)(ws + 315 * MB);
    (void)hipMemsetAsync(ws, 0, 4096, stream);
    void* args[] = {&p};
    hipError_t e = hipLaunchCooperativeKernel((const void*)mega, dim3(grid), dim3(NTHR), args, LDS_BYTES, stream);
    if (e != hipSuccess) fprintf(stderr, "kernel_launch: cooperative launch failed: %s (grid %d)\n", hipGetErrorString(e), grid);
}
```

```cpp
#include <hip/hip_runtime.h>
#include <hip/hip_cooperative_groups.h>
#include <cstdio>
#include <cstdint>
namespace cg = cooperative_groups;
__device__ __forceinline__ int tid_l() { int t = threadIdx.x; asm volatile("" : "+v"(t)); return t; }
namespace pg8 {
#define PG8_LAS __attribute__((address_space(3)))
typedef unsigned short bf16_t;
typedef short bf16x8 __attribute__((ext_vector_type(8)));
typedef float f32x4 __attribute__((ext_vector_type(4)));
typedef unsigned u32x4 __attribute__((ext_vector_type(4)));
constexpr int BM = 256, BK = 64, HALF = 128, HTB = HALF * BK * 2  , STAGE_BYTES = 8 * HTB, NXCD = 8, WGM = 8;

__host__ __device__ __forceinline__ int lds_byte(int r, int c) { const int st = (r >> 4) * 2 + (c >> 5), rr = r & 15, cc = c & 31, ob = rr * 64 + cc * 2; return st * 1024 + (ob ^ (((ob >> 9) & 1) << 5)); }
__host__ __device__ __forceinline__ void stage_rc(int b, int& R, int& C) { const int st = b / 1024, sb = b % 1024, swz = sb ^ (((sb >> 9) & 1) << 5); R = (st >> 1) * 16 + swz / 64; C = (st & 1) * 32 + (swz % 64) / 2; }
__host__ __device__ __forceinline__ int perm32(int rho) { const int n = rho >> 4, i = rho & 15; return 8 * (i >> 2) + 4 * n + (i & 3); }

struct Unit { int pm, pn; };
struct Gemm { const bf16_t* A; const bf16_t* Bt; int M, N, K; };

struct StaticOrder {
    int nM, nN, nwg, G, c;
    __host__ __device__ void init(int M, int N, int G_, int c_) { nM = M / BM; nN = N / BM; nwg = nM * nN; G = G_; c = c_; }
    __host__ __device__ bool next(int i, Unit& u) const {
        const long L = (long)i * G + c; if (L >= nwg) return false;
        int wgid = (int)L; { const int q = nwg / NXCD, r = nwg % NXCD, xcd = wgid % NXCD, off = wgid / NXCD; wgid = (xcd < r ? xcd * (q + 1) : r * (q + 1) + (xcd - r) * q) + off; }
        const int nig = WGM * nN, gid = wgid / nig, fm = gid * WGM, gsz = (nM - fm) < WGM ? (nM - fm) : WGM;
        u.pm = fm + ((wgid % nig) % gsz); u.pn = (wgid % nig) / gsz; return true;
    }
    __device__ __forceinline__ void a_ready(const Unit&) const {}
    __device__ __forceinline__ void done(const Unit&) const {}
};

__device__ __forceinline__ unsigned cvt_pk_bf16(float lo, float hi) { unsigned r; asm volatile("v_cvt_pk_bf16_f32 %0, %1, %2" : "=v"(r) : "v"(lo), "v"(hi)); return r; }
template <class Epi, class Sched, bool ALIGN_EPI = false, bool SP2 = false>
__device__ __forceinline__ void gemm_phase(PG8_LAS unsigned char* lds, const Gemm g, const Sched& S, const Epi& E) {
    const int tid = tid_l(), wid = __builtin_amdgcn_readfirstlane(tid >> 6), lane = tid & 63, wr = wid >> 2, wc = wid & 3, fr = lane & 15, fq = lane >> 4;
    const int K = g.K, nt = K / BK;
    unsigned voffA[2], voffB[2];
#pragma unroll
    for (int i = 0; i < 2; ++i) { int R, C; stage_rc(tid * 16 + i * 8192, R, C); const int Rb = Epi::PERM ? ((R & ~31) + perm32(R & 31)) : R;
        voffA[i] = (unsigned)(R * K + C) * 2u; voffB[i] = (unsigned)(Rb * K + C) * 2u; }
    const size_t kstep = (size_t)(BK * 2);
    const size_t hstep = (size_t)HALF * K * 2;
    const size_t tstep = 2 * hstep;
    const unsigned ldsw = (unsigned)wid * 1024u;
    const int aoff = lds_byte(wr * 64 + fr, fq * 8), boff = lds_byte(wc * 32 + fr, fq * 8);
#define PG8_SA(b, h) (((b) * 2 + (h)) * HTB)
#define PG8_SB(b, h) ((4 + (b) * 2 + (h)) * HTB)
#define PG8_STAGE(bufoff, gbase, voff) do { _Pragma("unroll") for (int _i = 0; _i < 2; ++_i) \
        __builtin_amdgcn_global_load_lds((const unsigned*)((const char*)(gbase) + (voff)[_i]), (PG8_LAS unsigned*)(lds + (bufoff) + ldsw + _i * 8192), 16, 0, 0); } while (0)
#define PG8_LDA(dst, b, h) do { _Pragma("unroll") for (int m = 0; m < 4; ++m) _Pragma("unroll") for (int k = 0; k < 2; ++k) dst[m][k] = *(const PG8_LAS bf16x8*)(lds + PG8_SA(b, h) + aoff + m * 2048 + k * 1024); } while (0)
#define PG8_LDB(dst, b, h) do { _Pragma("unroll") for (int n = 0; n < 2; ++n) _Pragma("unroll") for (int k = 0; k < 2; ++k) dst[n][k] = *(const PG8_LAS bf16x8*)(lds + PG8_SB(b, h) + boff + n * 2048 + k * 1024); } while (0)
#define PG8_MMA(ai, bj, At, Bt) do { __builtin_amdgcn_s_setprio(1); _Pragma("unroll") for (int m = 0; m < 4; ++m) _Pragma("unroll") for (int n = 0; n < 2; ++n) _Pragma("unroll") for (int k = 0; k < 2; ++k) \
        acc[ai][bj][m][n] = __builtin_amdgcn_mfma_f32_16x16x32_bf16(Bt[n][k], At[m][k], acc[ai][bj][m][n], 0, 0, 0); __builtin_amdgcn_s_setprio(0); } while (0)
#define PG8_WAIT_V(n) asm volatile("s_waitcnt vmcnt(" #n ")" ::: "memory")
#define PG8_WAIT_L(n) asm volatile("s_waitcnt lgkmcnt(" #n ")" ::: "memory")
#define PG8_BAR __builtin_amdgcn_s_barrier()
#define PG8_SCHED __builtin_amdgcn_sched_barrier(0)
    Unit cur, nxt; int ui = 0;
    if (!S.next(0, cur)) return;
    f32x4 acc[2][2][4][2];
#pragma unroll
    for (int a = 0; a < 2; ++a)
#pragma unroll
        for (int b = 0; b < 2; ++b)
#pragma unroll
            for (int m = 0; m < 4; ++m)
#pragma unroll
                for (int n = 0; n < 2; ++n) acc[a][b][m][n] = (f32x4){0.f, 0.f, 0.f, 0.f};
    bf16x8 At[4][2], B0[2][2], B1[2][2];
    const char* cA = (const char*)g.A + (size_t)cur.pm * tstep; const char* cB = (const char*)g.Bt + (size_t)cur.pn * tstep;
    S.a_ready(cur);
    if constexpr (SP2) {
        PG8_STAGE(PG8_SB(0, 0), cB, voffB); PG8_STAGE(PG8_SB(0, 1), cB + hstep, voffB); PG8_STAGE(PG8_SA(0, 0), cA, voffA); PG8_STAGE(PG8_SA(0, 1), cA + hstep, voffA);
        if (wr == 1) PG8_BAR;
        PG8_WAIT_V(2); PG8_BAR;
        PG8_STAGE(PG8_SB(1, 0), cB + kstep, voffB); PG8_STAGE(PG8_SA(1, 0), cA + kstep, voffA); PG8_STAGE(PG8_SB(1, 1), cB + hstep + kstep, voffB);
        PG8_WAIT_V(6); PG8_BAR;
    } else {
        PG8_STAGE(PG8_SB(0, 0), cB, voffB); PG8_STAGE(PG8_SA(0, 0), cA, voffA); PG8_STAGE(PG8_SB(0, 1), cB + hstep, voffB); PG8_STAGE(PG8_SA(0, 1), cA + hstep, voffA);
        if (wr == 1) PG8_BAR;
        PG8_WAIT_V(4); PG8_BAR;
        PG8_STAGE(PG8_SB(1, 0), cB + kstep, voffB); PG8_STAGE(PG8_SA(1, 0), cA + kstep, voffA); PG8_STAGE(PG8_SB(1, 1), cB + hstep + kstep, voffB);
        PG8_WAIT_V(6); PG8_BAR;
    }
    for (;;) {
        const bool has_next = S.next(ui + 1, nxt);
        const char* nA = has_next ? (const char*)g.A + (size_t)nxt.pm * tstep : cA; const char* nB = has_next ? (const char*)g.Bt + (size_t)nxt.pn * tstep : cB;
        for (int t = 0; t < nt; t += 2) {
            const bool last = (t == nt - 2);
            const char* a1 = cA + (size_t)(t + 1) * kstep;
            const char* a2 = last ? nA : cA + (size_t)(t + 2) * kstep; const char* b2 = last ? nB : cB + (size_t)(t + 2) * kstep;
            const char* a3 = a2 + kstep; const char* b3 = b2 + kstep;
            if (last && has_next) S.a_ready(nxt);
            if constexpr (SP2) {
            PG8_LDB(B0, 0, 0); PG8_LDB(B1, 0, 1); PG8_SCHED; PG8_LDA(At, 0, 0); PG8_STAGE(PG8_SA(1, 1), a1 + hstep, voffA);
            PG8_WAIT_V(8); PG8_WAIT_L(0); PG8_BAR; PG8_MMA(0, 0, At, B0); PG8_MMA(0, 1, At, B1); PG8_BAR; PG8_SCHED;
            PG8_LDA(At, 0, 1); PG8_STAGE(PG8_SB(0, 0), b2, voffB); PG8_STAGE(PG8_SB(0, 1), b2 + hstep, voffB); PG8_STAGE(PG8_SA(0, 0), a2, voffA);
            PG8_WAIT_V(8); PG8_WAIT_L(0); PG8_BAR; PG8_MMA(1, 0, At, B0); PG8_MMA(1, 1, At, B1); PG8_BAR; PG8_SCHED;
            PG8_LDB(B0, 1, 0); PG8_LDB(B1, 1, 1); PG8_SCHED; PG8_LDA(At, 1, 0); PG8_STAGE(PG8_SA(0, 1), a2 + hstep, voffA);
            PG8_WAIT_V(8); PG8_WAIT_L(0); PG8_BAR; PG8_MMA(0, 0, At, B0); PG8_MMA(0, 1, At, B1); PG8_BAR; PG8_SCHED;
            PG8_LDA(At, 1, 1); PG8_STAGE(PG8_SB(1, 0), b3, voffB); PG8_STAGE(PG8_SB(1, 1), b3 + hstep, voffB); PG8_STAGE(PG8_SA(1, 0), a3, voffA);
            PG8_WAIT_V(8); PG8_WAIT_L(0); PG8_BAR; PG8_MMA(1, 0, At, B0); PG8_MMA(1, 1, At, B1); PG8_BAR; PG8_SCHED;
            } else {
            PG8_LDB(B0, 0, 0); PG8_SCHED; PG8_LDA(At, 0, 0); PG8_STAGE(PG8_SA(1, 1), a1 + hstep, voffA);
            PG8_WAIT_L(8); PG8_BAR; PG8_WAIT_L(0); PG8_MMA(0, 0, At, B0); PG8_BAR; PG8_SCHED;
            PG8_LDB(B1, 0, 1); PG8_STAGE(PG8_SB(0, 0), b2, voffB);
            PG8_BAR; PG8_WAIT_L(0); PG8_MMA(0, 1, At, B1); PG8_BAR;
            PG8_LDA(At, 0, 1); PG8_STAGE(PG8_SA(0, 0), a2, voffA);
            PG8_BAR; PG8_WAIT_L(0); PG8_MMA(1, 0, At, B0); PG8_BAR; PG8_SCHED;
            PG8_STAGE(PG8_SB(0, 1), b2 + hstep, voffB);
            PG8_WAIT_V(6); PG8_BAR; PG8_MMA(1, 1, At, B1); PG8_BAR;
            PG8_LDB(B0, 1, 0); PG8_SCHED; PG8_LDA(At, 1, 0); PG8_STAGE(PG8_SA(0, 1), a2 + hstep, voffA);
            PG8_WAIT_L(8); PG8_BAR; PG8_WAIT_L(0); PG8_MMA(0, 0, At, B0); PG8_BAR; PG8_SCHED;
            PG8_LDB(B1, 1, 1); PG8_STAGE(PG8_SB(1, 0), b3, voffB);
            PG8_BAR; PG8_WAIT_L(0); PG8_MMA(0, 1, At, B1); PG8_BAR;
            PG8_LDA(At, 1, 1); PG8_STAGE(PG8_SA(1, 0), a3, voffA);
            PG8_BAR; PG8_WAIT_L(0); PG8_MMA(1, 0, At, B0); PG8_BAR; PG8_SCHED;
            PG8_STAGE(PG8_SB(1, 1), b3 + hstep, voffB);
            PG8_WAIT_V(6); PG8_BAR; PG8_MMA(1, 1, At, B1); PG8_BAR;
            }
        }
        if constexpr (ALIGN_EPI) { if (wr == 0) PG8_BAR; }
        if constexpr (!Epi::AFTER_DRAIN) { E(acc, cur, wr, wc, fr, fq); S.done(cur); }
        if (!has_next) break;
#pragma unroll
        for (int a = 0; a < 2; ++a)
#pragma unroll
            for (int b = 0; b < 2; ++b)
#pragma unroll
                for (int m = 0; m < 4; ++m)
#pragma unroll
                    for (int n = 0; n < 2; ++n) acc[a][b][m][n] = (f32x4){0.f, 0.f, 0.f, 0.f};
        cur = nxt; cA = nA; cB = nB; ++ui;
        if constexpr (ALIGN_EPI) { if (wr == 1) PG8_BAR; }
    }
    PG8_WAIT_V(0);
    if constexpr (!ALIGN_EPI) { if (wr == 0) PG8_BAR; }
    PG8_BAR;
    if constexpr (Epi::AFTER_DRAIN) { E.fused(acc, cur, wr, wc, fr, fq, lds, wid, lane); S.done(cur); }
#undef PG8_SA
#undef PG8_SB
#undef PG8_STAGE
#undef PG8_LDA
#undef PG8_LDB
#undef PG8_MMA
#undef PG8_WAIT_V
#undef PG8_WAIT_L
#undef PG8_BAR
#undef PG8_SCHED
}
}

#define LAS __attribute__((address_space(3)))
typedef unsigned short bf16_t;
typedef short bf16x8 __attribute__((ext_vector_type(8)));
typedef short s16x4 __attribute__((ext_vector_type(4)));
typedef float f32x4 __attribute__((ext_vector_type(4)));
typedef float f32x16 __attribute__((ext_vector_type(16)));
typedef unsigned u32x4 __attribute__((ext_vector_type(4)));
typedef unsigned u32x2 __attribute__((ext_vector_type(2)));
typedef float f32x2_t __attribute__((ext_vector_type(2)));
typedef __bf16 bf16x2_t __attribute__((ext_vector_type(2)));

constexpr int TP = 16384, TS = 256, TT = TP + TS, DM = 1024, DFF = 4096;
constexpr int SEQ = 8192, PAST = 4096, LPAD = 4160, NSEQ = 18;
constexpr float LOG2E = 1.4426950408889634f;
constexpr int NTHR = 512, NWV = 8;
constexpr int LDS_RING = 131072, LDS_BYTES = LDS_RING + 1024;

struct Params {
    const float *x_prompt, *x_sample, *c_prompt, *c_sample, *cfk, *cfv, *cfl, *spool, *csk, *csv;
    const float *w_ada, *b_ada, *norm_g, *w_in_ab, *b_forget, *w_pool, *pool_scale, *w_out_ab, *w_in_sb, *w_out_sb, *w_up, *w_down, *final_g;
    float *y_p, *y_s, *fk_p, *fv_p, *fl_p, *pool_p, *sk_p, *sv_p, *fk_s, *fv_s, *fl_s, *pool_s, *sk_s, *sv_s;
    unsigned* ctl; float *mod, *Wf, *Fp, *Fs;
    bf16_t *Wab, *Woab, *Wsb, *Wosb, *Wup, *Wdn, *XN;
    float* X; bf16_t *Q, *Kp, *Vp; float* U; bf16_t *CAT, *H;
};

#define DI __device__ __forceinline__
DI unsigned cvtpk(float lo, float hi) { f32x2_t v = {lo, hi}; bf16x2_t b = __builtin_convertvector(v, bf16x2_t); return __builtin_bit_cast(unsigned, b); }
DI int seq_of(int t) { return t < TP ? (t >> 13) : 2 + ((t - TP) >> 4); }
DI float wave_sum(float v) {
#pragma unroll
    for (int o = 1; o < 64; o <<= 1) v += __shfl_xor(v, o);
    return v;
}
DI void st_bf4(bf16_t* p, f32x4 v) { u32x2 w; w.x = cvtpk(v[0], v[1]); w.y = cvtpk(v[2], v[3]); *(u32x2*)p = w; }
#define LDS_WAIT() asm volatile("s_waitcnt lgkmcnt(0)" ::: "memory")

DI void tr_item(const float* W, int ldw, int k0, int c0, bf16_t* WT, int ldt, int r0, int kd0, LAS float* scr, int lane) {
#pragma unroll 8
    for (int i = 0; i < 32; ++i) { const int kk = 2 * i + (lane >> 5); scr[kk * 33 + (lane & 31)] = W[(size_t)(k0 + kk) * ldw + c0 + (lane & 31)]; }
    LDS_WAIT();
    const int c = lane & 7;
#pragma unroll
    for (int j = 0; j < 4; ++j) { const int n = (lane >> 3) + 8 * j; const LAS float* s = scr + (8 * c) * 33 + n;
        u32x4 o; o.x = cvtpk(s[0 * 33], s[1 * 33]); o.y = cvtpk(s[2 * 33], s[3 * 33]); o.z = cvtpk(s[4 * 33], s[5 * 33]); o.w = cvtpk(s[6 * 33], s[7 * 33]);
        *(u32x4*)(WT + (size_t)(r0 + n) * ldt + kd0 + 8 * c) = o; }
    LDS_WAIT();
}

DI void phase0(const Params& p, LAS unsigned char* lds) {
    const int tid = tid_l(), lane = tid & 63, wave = tid >> 6;
    if ((int)blockIdx.x < 192) {
        LAS float* cond = (LAS float*)lds;
        LAS float* red = (LAS float*)(lds + 73728);
        for (int i = tid; i < NSEQ * 1024; i += NTHR) { const int s = i >> 10, k = i & 1023; const float c = s < 2 ? p.c_prompt[s * 1024 + k] : p.c_sample[(s - 2) * 1024 + k]; cond[i] = c / (1.0f + expf(-c)); }
        __syncthreads();
        for (int item = blockIdx.x; item < 192; item += gridDim.x) {
            const int layer = item / 96, col0 = (item % 96) * 64, quad = tid & 15, kc = tid >> 4;
            float acc[NSEQ][4];
#pragma unroll
            for (int s = 0; s < NSEQ; ++s) { acc[s][0] = 0.f; acc[s][1] = 0.f; acc[s][2] = 0.f; acc[s][3] = 0.f; }
            const float* wp = p.w_ada + ((size_t)layer * 1024 + kc * 32) * 6144 + col0 + 4 * quad;
#pragma unroll 4
            for (int kk = 0; kk < 32; ++kk) { const f32x4 w = *(const f32x4*)(wp + (size_t)kk * 6144);
#pragma unroll
                for (int s = 0; s < NSEQ; ++s) { const float cs = cond[s * 1024 + kc * 32 + kk]; acc[s][0] += cs * w[0]; acc[s][1] += cs * w[1]; acc[s][2] += cs * w[2]; acc[s][3] += cs * w[3]; } }
#pragma unroll
            for (int s = 0; s < NSEQ; ++s)
#pragma unroll
                for (int j = 0; j < 4; ++j) { float v = acc[s][j]; v += __shfl_xor(v, 16); v += __shfl_xor(v, 32); if (lane < 16) red[((wave * 16 + quad) * NSEQ + s) * 4 + j] = v; }
            __syncthreads();
            for (int o = tid; o < 16 * NSEQ * 4; o += NTHR) { const int qd = o / (NSEQ * 4), rem = o % (NSEQ * 4), s = rem >> 2, j = rem & 3; float sum = 0.f;
#pragma unroll
                for (int w = 0; w < 8; ++w) sum += red[((w * 16 + qd) * NSEQ + s) * 4 + j];
                const int col = col0 + 4 * qd + j; p.mod[((size_t)layer * NSEQ + s) * 6144 + col] = sum + p.b_ada[layer * 6144 + col]; }
            __syncthreads();
        }
    }
    for (int it = (int)gridDim.x - 1 - (int)blockIdx.x; it < 128; it += gridDim.x) {
        const int g = it >> 5, rem = it & 31, cblk = rem >> 1, n = (rem & 1) * 512 + tid;
        float acc[8];
#pragma unroll
        for (int j = 0; j < 8; ++j) acc[j] = 0.f;
        for (int e = 0; e < 128; ++e) { const float wv = p.w_out_ab[(size_t)(512 + 128 * g + e) * 1024 + n] * p.pool_scale[128 * g + e];
#pragma unroll
            for (int j = 0; j < 8; ++j) acc[j] += p.w_pool[((g * 128) + cblk * 8 + j) * 128 + e] * wv; }
        u32x4 o; o.x = cvtpk(acc[0], acc[1]); o.y = cvtpk(acc[2], acc[3]); o.z = cvtpk(acc[4], acc[5]); o.w = cvtpk(acc[6], acc[7]);
        *(u32x4*)(p.Woab + (size_t)n * 1024 + 512 + 128 * g + cblk * 8) = o;
    }
    for (int i = blockIdx.x * NTHR + tid; i < 8192; i += gridDim.x * NTHR) { const int h = i >> 10, k = i & 1023; p.Wf[i] = p.w_in_ab[(size_t)k * 2056 + 1536 + h]; }
    __syncthreads();
    LAS float* scr = (LAS float*)(lds + wave * 16384);
    const int gw = blockIdx.x * NWV + wave, NGW = gridDim.x * NWV;
    constexpr int NITEMS = 1024 + 256 + 1536 + 512 + 4096 + 4096;
    for (int it = gw; it < NITEMS; it += NGW) {
        int r = it;
        if (r < 1024) { const int kb = r >> 6, n0 = (r & 63) * 32, c0 = n0 < 1536 ? n0 : n0 + 8; tr_item(p.w_in_ab, 2056, kb * 64, c0, p.Wab, 1024, n0, kb * 64, scr, lane); continue; } r -= 1024;
        if (r < 256) { const int kb = r >> 5, n0 = (r & 31) * 32; tr_item(p.w_out_ab, 1024, kb * 64, n0, p.Woab, 1024, n0, kb * 64, scr, lane); continue; } r -= 256;
        if (r < 1536) { const int kb = r / 96, n0 = (r % 96) * 32; tr_item(p.w_in_sb, 3072, kb * 64, n0, p.Wsb, 1024, n0, kb * 64, scr, lane); continue; } r -= 1536;
        if (r < 512) { const int kb = r >> 5, n0 = (r & 31) * 32; tr_item(p.w_out_sb, 1024, kb * 64, n0, p.Wosb, 1024, n0, kb * 64, scr, lane); continue; } r -= 512;
        if (r < 4096) { const int layer = r >> 11, r2 = r & 2047, kb = r2 >> 7, n0 = (r2 & 127) * 32;
            tr_item(p.w_up + (size_t)layer * 1024 * 4096, 4096, kb * 64, n0, p.Wup + (size_t)layer * 4096 * 1024, 1024, n0, kb * 64, scr, lane); continue; } r -= 4096;
        { const int layer = r >> 11, r2 = r & 2047, kb = r2 >> 5, n0 = (r2 & 31) * 32;
            tr_item(p.w_down + (size_t)layer * 4096 * 1024, 1024, kb * 64, n0, p.Wdn + (size_t)layer * 1024 * 4096, 4096, n0, kb * 64, scr, lane); }
    }
}

template <bool FLOGIT>
DI void norm_phase(const Params& p, int layer, int which, const float* xin_p, const float* xin_s) {
    const int tid = tid_l(), lane = tid & 63, wave = tid >> 6;
    const int gw = blockIdx.x * NWV + wave, NGW = gridDim.x * NWV;
    const float* gptr = p.norm_g + (layer * 2 + which) * 1024;
    for (int t = gw; t < TT; t += NGW) {
        const float* xr = t < TP ? xin_p + (size_t)t * 1024 : xin_s + (size_t)(t - TP) * 1024;
        const float* md = p.mod + ((size_t)layer * NSEQ + seq_of(t)) * 6144 + (which ? 3072 : 0);
        f32x4 v[4]; float ss = 0.f;
#pragma unroll
        for (int j = 0; j < 4; ++j) { v[j] = *(const f32x4*)(xr + 4 * lane + 256 * j); ss += (v[j][0] * v[j][0] + v[j][1] * v[j][1]) + (v[j][2] * v[j][2] + v[j][3] * v[j][3]); }
        const float rstd = 1.0f / sqrtf(wave_sum(ss) * (1.0f / 1024.0f) + 1e-6f);
        float fd[8];
#pragma unroll
        for (int h = 0; h < 8; ++h) fd[h] = 0.f;
#pragma unroll
        for (int j = 0; j < 4; ++j) { const int col = 4 * lane + 256 * j;
            const f32x4 g = *(const f32x4*)(gptr + col), sh = *(const f32x4*)(md + col), sc = *(const f32x4*)(md + 1024 + col);
            f32x4 y;
#pragma unroll
            for (int e = 0; e < 4; ++e) y[e] = (v[j][e] * rstd * g[e]) * (1.0f + sc[e]) + sh[e];
            st_bf4(p.XN + (size_t)t * 1024 + col, y);
            if (FLOGIT) {
#pragma unroll
                for (int h = 0; h < 8; ++h) { const f32x4 w = *(const f32x4*)(p.Wf + h * 1024 + col); fd[h] += (y[0] * w[0] + y[1] * w[1]) + (y[2] * w[2] + y[3] * w[3]); } }
        }
        if (FLOGIT) {
            float mine = 0.f;
#pragma unroll
            for (int h = 0; h < 8; ++h) { const float s = wave_sum(fd[h]); if (lane == h) mine = s; }
            if (lane < 8) { const float z = mine + p.b_forget[lane]; const float lf = fminf(z, 0.f) - log1pf(expf(-fabsf(z)));
                if (t < TP) p.fl_p[(size_t)t * 8 + lane] = lf; else p.fl_s[(size_t)(t - TP) * 8 + lane] = lf; }
        }
    }
}
DI void final_norm_phase(const Params& p) {
    const int tid = tid_l(), lane = tid & 63, wave = tid >> 6;
    const int gw = blockIdx.x * NWV + wave, NGW = gridDim.x * NWV;
    for (int t = gw; t < TT; t += NGW) {
        const float* xr = p.X + (size_t)t * 1024; float* yr = t < TP ? p.y_p + (size_t)t * 1024 : p.y_s + (size_t)(t - TP) * 1024;
        f32x4 v[4]; float ss = 0.f;
#pragma unroll
        for (int j = 0; j < 4; ++j) { v[j] = *(const f32x4*)(xr + 4 * lane + 256 * j); ss += (v[j][0] * v[j][0] + v[j][1] * v[j][1]) + (v[j][2] * v[j][2] + v[j][3] * v[j][3]); }
        const float rstd = 1.0f / sqrtf(wave_sum(ss) * (1.0f / 1024.0f) + 1e-6f);
#pragma unroll
        for (int j = 0; j < 4; ++j) { const int col = 4 * lane + 256 * j; const f32x4 g = *(const f32x4*)(p.final_g + col); f32x4 y;
#pragma unroll
            for (int e = 0; e < 4; ++e) y[e] = v[j][e] * rstd * g[e];
            *(f32x4*)(yr + col) = y; }
    }
}

struct EmitQkvAB { bf16_t *Q, *Kp, *Vp; float *U, *fk_p, *fv_p, *fk_s, *fv_s;
    DI void emit(int t, int c, f32x4 v) const {
        if (c < 512) { st_bf4(Q + (size_t)t * 512 + c, v); }
        else if (c < 1024) { const int cc = c - 512; if (t < TP) { st_bf4(Kp + (size_t)t * 512 + cc, v); *(f32x4*)(fk_p + (size_t)t * 512 + cc) = v; } else *(f32x4*)(fk_s + (size_t)(t - TP) * 512 + cc) = v; }
        else if (c < 1536) { const int cc = c - 1024; if (t < TP) { st_bf4(Vp + (size_t)t * 512 + cc, v); *(f32x4*)(fv_p + (size_t)t * 512 + cc) = v; } else *(f32x4*)(fv_s + (size_t)(t - TP) * 512 + cc) = v; }
        else { *(f32x4*)(U + (size_t)t * 512 + (c - 1536)) = v; }
    } };
struct EmitQkvSB { bf16_t *Q, *Kp, *Vp; float *sk_p, *sv_p, *sk_s, *sv_s;
    DI void emit(int t, int c, f32x4 v) const {
        if (c < 1024) { st_bf4(Q + (size_t)t * 1024 + c, v); }
        else if (c < 2048) { const int cc = c - 1024; if (t < TP) { st_bf4(Kp + (size_t)t * 1024 + cc, v); *(f32x4*)(sk_p + (size_t)t * 1024 + cc) = v; } else *(f32x4*)(sk_s + (size_t)(t - TP) * 1024 + cc) = v; }
        else { const int cc = c - 2048; if (t < TP) { st_bf4(Vp + (size_t)t * 1024 + cc, v); *(f32x4*)(sv_p + (size_t)t * 1024 + cc) = v; } else *(f32x4*)(sv_s + (size_t)(t - TP) * 1024 + cc) = v; }
    } };
struct EmitRes { const float* xin_p; const float* xin_s; const float* modg; float* X;
    DI void emit(int t, int c, f32x4 v) const {
        const float* xr = t < TP ? xin_p + (size_t)t * 1024 : xin_s + (size_t)(t - TP) * 1024;
        const f32x4 x = *(const f32x4*)(xr + c), g = *(const f32x4*)(modg + (size_t)seq_of(t) * 6144 + c);
        *(f32x4*)(X + (size_t)t * 1024 + c) = x + g * v;
    } };
struct EmitUp { bf16_t* H;
    DI void emit(int t, int c, f32x4 v) const { f32x4 r;
#pragma unroll
        for (int e = 0; e < 4; ++e) { const float a = fmaxf(v[e], 0.f); r[e] = a * a; }
        st_bf4(H + (size_t)t * 4096 + c, r); } };

template <class F> struct EpiEmit {
    static constexpr bool PERM = false, AFTER_DRAIN = false;
    F f;
    DI void operator()(const pg8::f32x4 (&acc)[2][2][4][2], const pg8::Unit& u, int wr, int wc, int fr, int fq) const {
        const int row0 = u.pm * 256 + wr * 64 + fr, col0 = u.pn * 256 + wc * 32 + 4 * fq;
#pragma unroll
        for (int ai = 0; ai < 2; ++ai)
#pragma unroll
            for (int m = 0; m < 4; ++m)
#pragma unroll
                for (int bj = 0; bj < 2; ++bj)
#pragma unroll
                    for (int n = 0; n < 2; ++n) f.emit(row0 + ai * 128 + m * 16, col0 + bj * 128 + n * 16, acc[ai][bj][m][n]);
    }
};

template <class F>
DI void skinny_gemm(LAS unsigned char* lds, const bf16_t* A, const bf16_t* Bt, int N, int K, const F& f) {
    const int tid = tid_l(), lane = tid & 63, wave = tid >> 6, rsub = wave & 3, kh = wave >> 2, fr = lane & 15, fq = lane >> 4;
    const int nitems = 4 * (N >> 4), Kh = K >> 1;
    LAS f32x4* red = (LAS f32x4*)lds;
    for (int item = blockIdx.x; item < nitems; item += gridDim.x) {
        const int rb = item & 3, cb = item >> 2;
        const bf16_t* ap = A + (size_t)(rb * 64 + rsub * 16 + fr) * K + kh * Kh + 8 * fq;
        const bf16_t* bp = Bt + (size_t)(cb * 16 + fr) * K + kh * Kh + 8 * fq;
        f32x4 acc = {0.f, 0.f, 0.f, 0.f};
        for (int ks = 0; ks < Kh; ks += 256) {
            bf16x8 a[8], b[8];
#pragma unroll
            for (int i = 0; i < 8; ++i) { a[i] = *(const bf16x8*)(ap + ks + 32 * i); b[i] = *(const bf16x8*)(bp + ks + 32 * i); }
#pragma unroll
            for (int i = 0; i < 8; ++i) acc = __builtin_amdgcn_mfma_f32_16x16x32_bf16(b[i], a[i], acc, 0, 0, 0);
        }
        if (kh == 1) red[rsub * 64 + lane] = acc;
        __syncthreads();
        if (kh == 0) { acc = acc + red[rsub * 64 + lane]; f.emit(TP + rb * 64 + rsub * 16 + fr, cb * 16 + 4 * fq, acc); }
        __syncthreads();
    }
}

template <class F>
DI void gemm_all(LAS unsigned char* lds, const bf16_t* A, const bf16_t* Bt, int N, int K, const F& f) {
    { pg8::Gemm g{A, Bt, TP, N, K}; pg8::StaticOrder S; S.init(TP, N, (int)gridDim.x, (int)blockIdx.x);
      EpiEmit<F> E{f};
      pg8::gemm_phase<EpiEmit<F>, pg8::StaticOrder, true, true>(lds, g, S, E); }
    __syncthreads();
    skinny_gemm<F>(lds, A + (size_t)TP * K, Bt, N, K, f);
}

template <int PER>
DI void scan_item(LAS unsigned char* lds, const float* src_a, int na, const float* src_b, int ntot, int stride, float* dst, int ndst) {
    const int tid = tid_l(), lane = tid & 63, wave = tid >> 6;
    LAS float* wt = (LAS float*)lds;
    float v[PER]; float tot = 0.f;
#pragma unroll
    for (int i = 0; i < PER; ++i) { const int pos = tid * PER + i; float x = 0.f; if (pos < na) x = src_a[(size_t)pos * stride]; else if (pos < ntot) x = src_b[(size_t)(pos - na) * stride]; tot += x; v[i] = tot; }
    float inc = tot;
#pragma unroll
    for (int o = 1; o < 64; o <<= 1) { const float t = __shfl_up(inc, o); if (lane >= o) inc += t; }
    __syncthreads();
    if (lane == 63) wt[wave] = inc;
    __syncthreads();
    float base = 0.f;
#pragma unroll
    for (int w = 0; w < 8; ++w) if (w < wave) base += wt[w];
    const float ex = base + inc - tot;
#pragma unroll
    for (int i = 0; i < PER; ++i) { const int pos = tid * PER + i; if (pos < ntot) dst[pos] = ex + v[i]; else if (pos < ndst) dst[pos] = 0.f; }
}
DI void phase3(const Params& p, LAS unsigned char* lds) {
    const int tid = tid_l();
    for (int it = blockIdx.x; it < 144; it += gridDim.x) {
        if (it < 16) { scan_item<16>(lds, p.fl_p + (size_t)(it >> 3) * SEQ * 8 + (it & 7), SEQ, nullptr, SEQ, 8, p.Fp + (size_t)it * SEQ, SEQ); }
        else { const int bh = it - 16, b = bh >> 3, h = bh & 7;
            scan_item<9>(lds, p.cfl + (size_t)b * PAST * 8 + h, PAST, p.fl_s + (size_t)b * 16 * 8 + h, PAST + 16, 8, p.Fs + (size_t)bh * LPAD, LPAD); }
    }
    for (int i = blockIdx.x * NTHR + tid; i < TT * 128; i += gridDim.x * NTHR) {
        const int t = i >> 7, c = (i & 127) * 4, g = c >> 7, w = 2 << g;
        const f32x4 u = *(const f32x4*)(p.U + (size_t)t * 512 + c);
        f32x4 sum = u; float cnt;
        if (t < TP) { const int pos = t & (SEQ - 1); const int nw = pos + 1 < w ? pos + 1 : w; cnt = (float)nw;
            for (int k = 1; k < nw; ++k) sum += *(const f32x4*)(p.U + (size_t)(t - k) * 512 + c);
            if (pos >= SEQ - 15) *(f32x4*)(p.pool_p + ((size_t)(t >> 13) * 15 + (pos - (SEQ - 15))) * 512 + c) = u;
        } else { const int b = (t - TP) >> 4, loc = (t - TP) & 15; cnt = (float)w;
            for (int k = 1; k < w; ++k) { const int li = loc - k; sum += li >= 0 ? *(const f32x4*)(p.U + (size_t)(t - k) * 512 + c) : *(const f32x4*)(p.spool + ((size_t)b * 15 + 15 + li) * 512 + c); }
            if (loc >= 1) *(f32x4*)(p.pool_s + ((size_t)b * 15 + loc - 1) * 512 + c) = u;
        }
        f32x4 r;
#pragma unroll
        for (int e = 0; e < 4; ++e) r[e] = sum[e] / cnt - u[e];
        st_bf4(p.CAT + (size_t)t * 1024 + 512 + c, r);
    }
}

constexpr int AKS = 9216, A_VOFF = 4 * AKS, A_FOFF = 8 * AKS;
#define MFMA32(a, b, c) __builtin_amdgcn_mfma_f32_32x32x16_bf16((a), (b), (c), 0, 0, 0)
#define TRQ(l0, l1, h0, h1, addr, O0, O1, O2, O3) asm volatile("ds_read_b64_tr_b16 %0, %4 offset:" #O0 "\n\tds_read_b64_tr_b16 %1, %4 offset:" #O1 "\n\tds_read_b64_tr_b16 %2, %4 offset:" #O2 "\n\tds_read_b64_tr_b16 %3, %4 offset:" #O3 "\n\ts_waitcnt lgkmcnt(0)" \
    : "=&v"(l0), "=&v"(l1), "=&v"(h0), "=&v"(h1) : "v"(addr) : "memory")
DI bf16x8 pack8(const f32x16& s, int base) { u32x4 w; w.x = cvtpk(s[base], s[base + 1]); w.y = cvtpk(s[base + 2], s[base + 3]); w.z = cvtpk(s[base + 4], s[base + 5]); w.w = cvtpk(s[base + 6], s[base + 7]); return __builtin_bit_cast(bf16x8, w); }

template <int MODE, bool SAMPLE, int H>
DI void attn_unit(const Params& p, LAS unsigned char* lds, int b, int ub, int qb) {
    constexpr int PITCH = H * 64;
    constexpr float C1 = 0.125f * LOG2E;
    const int tid = tid_l(), lane = tid & 63, wave = tid >> 6, l31 = lane & 31, hh = lane >> 5;
    const int row = tid >> 3, ch = tid & 7;
    int head, slot, jt_top, jt_w, qpos, qrow; bool active;
    if (!SAMPLE) { head = ub; slot = 0; jt_top = 4 * qb + 3; jt_w = 4 * qb + (wave >> 1); qpos = 256 * qb + 32 * wave + l31; qrow = b * SEQ + qpos; active = true; }
    else { head = 4 * ub + (wave & 3); slot = wave & 3; jt_top = 64; jt_w = 64; qpos = PAST + (lane & 15); qrow = TP + 16 * b + (lane & 15); active = wave < 4; }
    const float* cK = MODE == 0 ? p.cfk : p.csk; const float* cV = MODE == 0 ? p.cfv : p.csv;
    const float* nK = MODE == 0 ? p.fk_s : p.sk_s; const float* nV = MODE == 0 ? p.fv_s : p.sv_s;
    bf16x8 qf[4];
    { const bf16_t* qp = p.Q + (size_t)qrow * PITCH + head * 64 + 8 * hh;
#pragma unroll
      for (int s = 0; s < 4; ++s) qf[s] = *(const bf16x8*)(qp + 16 * s); }
    float ft2 = 0.f;
    if (MODE == 0) ft2 = (SAMPLE ? p.Fs[(size_t)(b * 8 + head) * LPAD + qpos] : p.Fp[(size_t)(b * 8 + head) * SEQ + qpos]) * LOG2E;
    f32x16 o0, o1;
#pragma unroll
    for (int i = 0; i < 16; ++i) { o0[i] = 0.f; o1[i] = 0.f; }
    float m_run = -INFINITY, l_run = 0.f, R = 1.0f;
    u32x4 kreg = {0, 0, 0, 0}, vreg = {0, 0, 0, 0}; float freg = 0.f;
    f32x4 kr[4][2], vr[4][2];
#define LOAD_TILE(JT) do { const int jt_ = (JT); \
    if (!SAMPLE) { \
        kreg = *(const u32x4*)(p.Kp + (size_t)(b * SEQ + 64 * jt_ + row) * PITCH + head * 64 + ch * 8); \
        vreg = *(const u32x4*)(p.Vp + (size_t)(b * SEQ + 64 * jt_ + row) * PITCH + head * 64 + ch * 8); \
        if (MODE == 0 && tid < 64) freg = p.Fp[(size_t)(b * 8 + head) * SEQ + 64 * jt_ + tid] * LOG2E; \
    } else { \
        _Pragma("unroll") for (int i = 0; i < 4; ++i) { const int hd = 4 * ub + i; \
            if (jt_ < 64) { const size_t off = ((size_t)(b * PAST + 64 * jt_ + row) * H + hd) * 64 + 8 * ch; \
                kr[i][0] = *(const f32x4*)(cK + off); kr[i][1] = *(const f32x4*)(cK + off + 4); vr[i][0] = *(const f32x4*)(cV + off); vr[i][1] = *(const f32x4*)(cV + off + 4); } \
            else if (row < 16) { const size_t off = ((size_t)(b * 16 + row) * H + hd) * 64 + 8 * ch; \
                kr[i][0] = *(const f32x4*)(nK + off); kr[i][1] = *(const f32x4*)(nK + off + 4); vr[i][0] = *(const f32x4*)(nV + off); vr[i][1] = *(const f32x4*)(nV + off + 4); } \
            else { kr[i][0] = (f32x4){0.f, 0.f, 0.f, 0.f}; kr[i][1] = kr[i][0]; vr[i][0] = kr[i][0]; vr[i][1] = kr[i][0]; } } \
        if (MODE == 0 && tid < 256) freg = p.Fs[(size_t)(b * 8 + 4 * ub + (tid >> 6)) * LPAD + 64 * jt_ + (tid & 63)] * LOG2E; \
    } } while (0)
#define STORE_TILE() do { \
    if (!SAMPLE) { *(LAS u32x4*)(lds + row * 144 + ch * 16) = kreg; *(LAS u32x4*)(lds + A_VOFF + row * 144 + ch * 16) = vreg; if (MODE == 0 && tid < 64) *(LAS float*)(lds + A_FOFF + tid * 4) = freg; } \
    else { _Pragma("unroll") for (int i = 0; i < 4; ++i) { u32x4 kk, vv; \
            kk.x = cvtpk(kr[i][0][0], kr[i][0][1]); kk.y = cvtpk(kr[i][0][2], kr[i][0][3]); kk.z = cvtpk(kr[i][1][0], kr[i][1][1]); kk.w = cvtpk(kr[i][1][2], kr[i][1][3]); \
            vv.x = cvtpk(vr[i][0][0], vr[i][0][1]); vv.y = cvtpk(vr[i][0][2], vr[i][0][3]); vv.z = cvtpk(vr[i][1][0], vr[i][1][1]); vv.w = cvtpk(vr[i][1][2], vr[i][1][3]); \
            *(LAS u32x4*)(lds + i * AKS + row * 144 + ch * 16) = kk; *(LAS u32x4*)(lds + A_VOFF + i * AKS + row * 144 + ch * 16) = vv; } \
        if (MODE == 0 && tid < 256) *(LAS float*)(lds + A_FOFF + tid * 4) = freg; } } while (0)

    const unsigned ldsb = (unsigned)(uintptr_t)lds;
    const unsigned kb = slot * AKS + l31 * 144 + hh * 16;
    const unsigned vaddr = ldsb + A_VOFF + slot * AKS + (4 * hh + ((lane & 15) >> 2)) * 144 + 32 * ((lane >> 4) & 1) + 8 * (lane & 3);
    LOAD_TILE(jt_top);
    for (int jt = jt_top; jt >= 0; --jt) {
        __syncthreads();
        STORE_TILE();
        __syncthreads();
        if (jt > 0) LOAD_TILE(jt - 1);
        if (active && jt <= jt_w) {
            f32x16 s0, s1;
#pragma unroll
            for (int i = 0; i < 16; ++i) { s0[i] = 0.f; s1[i] = 0.f; }
#pragma unroll
            for (int s = 0; s < 4; ++s) { const bf16x8 k0 = *(const LAS bf16x8*)(lds + kb + s * 32); const bf16x8 k1 = *(const LAS bf16x8*)(lds + kb + 32 * 144 + s * 32);
                s0 = MFMA32(k0, qf[s], s0); s1 = MFMA32(k1, qf[s], s1); }
            const bool domask = (jt == jt_w);
            const int kbase = 64 * jt + 4 * hh;
            if (MODE == 0) {
                float tmax = -INFINITY;
#pragma unroll
                for (int g = 0; g < 4; ++g) {
                    const f32x4 f0 = *(const LAS f32x4*)(lds + A_FOFF + slot * 256 + (8 * g + 4 * hh) * 4), f1 = *(const LAS f32x4*)(lds + A_FOFF + slot * 256 + (32 + 8 * g + 4 * hh) * 4);
#pragma unroll
                    for (int r = 0; r < 4; ++r) { const int i = 4 * g + r;
                        float v0 = s0[i] * C1 + (ft2 - f0[r]), v1 = s1[i] * C1 + (ft2 - f1[r]);
                        if (domask) { if (kbase + 8 * g + r > qpos) v0 = -INFINITY; if (kbase + 32 + 8 * g + r > qpos) v1 = -INFINITY; }
                        s0[i] = v0; s1[i] = v1; tmax = fmaxf(tmax, fmaxf(v0, v1)); }
                }
                tmax = fmaxf(tmax, __shfl_xor(tmax, 32));
                const float m_new = fmaxf(m_run, tmax);
                const float alpha = __builtin_amdgcn_exp2f(m_run - m_new);
                m_run = m_new; l_run *= alpha;
#pragma unroll
                for (int i = 0; i < 16; ++i) { o0[i] *= alpha; o1[i] *= alpha; }
                float ls = 0.f;
#pragma unroll
                for (int i = 0; i < 16; ++i) { const float p0 = __builtin_amdgcn_exp2f(s0[i] - m_new), p1 = __builtin_amdgcn_exp2f(s1[i] - m_new); s0[i] = p0; s1[i] = p1; ls += p0 + p1; }
                l_run += ls;
            } else {
                f32x16 q0, q1;
#pragma unroll
                for (int i = 0; i < 16; ++i) {
                    const float e0 = __builtin_amdgcn_exp2f(fminf(s0[i] * C1, 100.f)), e1 = __builtin_amdgcn_exp2f(fminf(s1[i] * C1, 100.f));
                    float om0 = __builtin_amdgcn_rcpf(1.0f + e0), om1 = __builtin_amdgcn_rcpf(1.0f + e1);
                    float sg0 = e0 * om0, sg1 = e1 * om1;
                    if (domask) { const int kp = kbase + 8 * (i >> 2) + (i & 3); if (kp >= qpos) { om0 = 1.0f; sg0 = 0.f; } if (kp + 32 >= qpos) { om1 = 1.0f; sg1 = 0.f; } }
                    s0[i] = sg0; s1[i] = sg1; q0[i] = om0; q1[i] = om1;
                }
                float G[8], Gp[8];
#pragma unroll
                for (int g = 0; g < 4; ++g) { G[g] = (q0[4 * g] * q0[4 * g + 1]) * (q0[4 * g + 2] * q0[4 * g + 3]); G[4 + g] = (q1[4 * g] * q1[4 * g + 1]) * (q1[4 * g + 2] * q1[4 * g + 3]); }
#pragma unroll
                for (int g = 0; g < 8; ++g) Gp[g] = __shfl_xor(G[g], 32);
                float C = R;
#pragma unroll
                for (int g = 7; g >= 4; --g) { const int b4 = 4 * (g - 4); float suf = hh == 0 ? C * Gp[g] : C;
                    s1[b4 + 3] *= suf; suf *= q1[b4 + 3]; s1[b4 + 2] *= suf; suf *= q1[b4 + 2]; s1[b4 + 1] *= suf; suf *= q1[b4 + 1]; s1[b4] *= suf;
                    C = C * (G[g] * Gp[g]); }
#pragma unroll
                for (int g = 3; g >= 0; --g) { const int b4 = 4 * g; float suf = hh == 0 ? C * Gp[g] : C;
                    s0[b4 + 3] *= suf; suf *= q0[b4 + 3]; s0[b4 + 2] *= suf; suf *= q0[b4 + 2]; s0[b4 + 1] *= suf; suf *= q0[b4 + 1]; s0[b4] *= suf;
                    C = C * (G[g] * Gp[g]); }
                R = C;
            }
            s16x4 l0, l1, h0, h1; bf16x8 pf;
            TRQ(l0, l1, h0, h1, vaddr, 0, 64, 1152, 1216);
            pf = pack8(s0, 0); o0 = MFMA32(__builtin_shufflevector(l0, h0, 0, 1, 2, 3, 4, 5, 6, 7), pf, o0); o1 = MFMA32(__builtin_shufflevector(l1, h1, 0, 1, 2, 3, 4, 5, 6, 7), pf, o1);
            TRQ(l0, l1, h0, h1, vaddr, 2304, 2368, 3456, 3520);
            pf = pack8(s0, 8); o0 = MFMA32(__builtin_shufflevector(l0, h0, 0, 1, 2, 3, 4, 5, 6, 7), pf, o0); o1 = MFMA32(__builtin_shufflevector(l1, h1, 0, 1, 2, 3, 4, 5, 6, 7), pf, o1);
            TRQ(l0, l1, h0, h1, vaddr, 4608, 4672, 5760, 5824);
            pf = pack8(s1, 0); o0 = MFMA32(__builtin_shufflevector(l0, h0, 0, 1, 2, 3, 4, 5, 6, 7), pf, o0); o1 = MFMA32(__builtin_shufflevector(l1, h1, 0, 1, 2, 3, 4, 5, 6, 7), pf, o1);
            TRQ(l0, l1, h0, h1, vaddr, 6912, 6976, 8064, 8128);
            pf = pack8(s1, 8); o0 = MFMA32(__builtin_shufflevector(l0, h0, 0, 1, 2, 3, 4, 5, 6, 7), pf, o0); o1 = MFMA32(__builtin_shufflevector(l1, h1, 0, 1, 2, 3, 4, 5, 6, 7), pf, o1);
        }
    }
#undef LOAD_TILE
#undef STORE_TILE
    if (MODE == 0) { const float lt = l_run + __shfl_xor(l_run, 32); const float inv = 1.0f / lt;
#pragma unroll
        for (int i = 0; i < 16; ++i) { o0[i] *= inv; o1[i] *= inv; } }
    if (active && (!SAMPLE || l31 < 16)) {
        bf16_t* op = p.CAT + (size_t)qrow * 1024 + head * 64 + 4 * hh;
#pragma unroll
        for (int g = 0; g < 4; ++g) { u32x2 w0, w1; w0.x = cvtpk(o0[4 * g], o0[4 * g + 1]); w0.y = cvtpk(o0[4 * g + 2], o0[4 * g + 3]); w1.x = cvtpk(o1[4 * g], o1[4 * g + 1]); w1.y = cvtpk(o1[4 * g + 2], o1[4 * g + 3]);
            *(u32x2*)(op + 8 * g) = w0; *(u32x2*)(op + 32 + 8 * g) = w1; }
    }
}

template <int MODE, int H>
DI void attn_phase(const Params& p, LAS unsigned char* lds, unsigned* ctr) {
    constexpr int NS = 16 * (H / 4), NPB = 2 * H, TOTAL = NS + NPB * 32;
    volatile LAS int* slotw = (volatile LAS int*)(lds + LDS_RING);
    for (;;) {
        __syncthreads();
        if (threadIdx.x == 0) *slotw = (int)atomicAdd(ctr, 1u);
        __syncthreads();
        int u = *slotw;
        if (u >= TOTAL) break;
        if (u < NS) attn_unit<MODE, true, H>(p, lds, u / (H / 4), u % (H / 4), 0);
        else { u -= NS; const int qb = 31 - u / NPB, bh = u % NPB; attn_unit<MODE, false, H>(p, lds, bh / H, bh % H, qb); }
    }
}

#define XB_TMO      128
#define XB_XCNT(j)  (256  + 64 * (j))
#define XB_XSUB(j)  (1280 + 64 * (j))
#define XB_XGEN(j)  (2304 + 64 * (j))
#define XB_TOP      3328
#define XB_TOPGEN   3392
#define XCD_BAR_WORDS 3456
#define XB_SPIN_CAP (1u << 18)

__device__ __forceinline__ unsigned xb_ld(unsigned* p)              { return __hip_atomic_load(p, __ATOMIC_RELAXED, __HIP_MEMORY_SCOPE_AGENT); }
__device__ __forceinline__ unsigned xb_add(unsigned* p, unsigned v) { return __hip_atomic_fetch_add(p, v, __ATOMIC_RELAXED, __HIP_MEMORY_SCOPE_AGENT); }
__device__ __forceinline__ unsigned xb_xcc_id() { return (unsigned)__builtin_amdgcn_s_getreg((3 << 11) | 20) & 0xFu; }
#define XB_SPIN(cond, bar) do { unsigned _sp = 0; while (cond) { __builtin_amdgcn_s_sleep(1); \
    if ((++_sp & 255u) == 0u) { if (xb_ld(&(bar)[XB_TMO])) break; if (_sp > XB_SPIN_CAP) { atomicAdd(&(bar)[XB_TMO], 1u); break; } } } } while (0)

struct XcdBarrier {
    unsigned* bar; unsigned x;
    volatile LAS unsigned* st;
};

__device__ __forceinline__ XcdBarrier xcd_barrier_post(unsigned* bar, volatile LAS unsigned* st) {
    XcdBarrier b; b.bar = bar; b.x = xb_xcc_id(); b.st = st;
    if (threadIdx.x == 0) (void)xb_add(&bar[XB_XCNT(b.x)], 1u);
    return b;
}
__device__ __forceinline__ void xcd_barrier_complete(unsigned* bar, unsigned x, unsigned& nloc, unsigned& nx) {
    const unsigned G = gridDim.x * gridDim.y * gridDim.z;
    unsigned sum, cnt, mine, sp = 0u;
    for (;;) {
        sum = 0u; cnt = 0u; mine = 0u;
#pragma unroll
        for (unsigned j = 0; j < 16; ++j) { const unsigned c = xb_ld(&bar[XB_XCNT(j)]); sum += c; cnt += (c > 0u) ? 1u : 0u; mine = (j == x) ? c : mine; }
        if (sum == G) break;
        __builtin_amdgcn_s_sleep(1);
        if ((++sp & 255u) == 0u) { if (xb_ld(&bar[XB_TMO])) break; if (sp > XB_SPIN_CAP) { atomicAdd(&bar[XB_TMO], 1u); break; } }
    }
    nloc = mine > 0u ? mine : 1u; nx = cnt > 0u ? cnt : 1u;
}

__device__ __forceinline__ void xcd_barrier(const XcdBarrier& b) {
    asm volatile("s_waitcnt vmcnt(0)" ::: "memory");
    __syncthreads();
    if (threadIdx.x == 0) {
        unsigned* bar = b.bar;
        __builtin_amdgcn_s_waitcnt(0);
        unsigned nloc = b.st[0], nx = b.st[1];
        if (nloc == 0u) { xcd_barrier_complete(bar, b.x, nloc, nx); b.st[0] = nloc; b.st[1] = nx; }
        const unsigned old = xb_add(&bar[XB_XSUB(b.x)], 1u);
        const unsigned gen = old / nloc;
        if (old + 1u == (gen + 1u) * nloc) {
            __builtin_amdgcn_fence(__ATOMIC_RELEASE, "agent");
            asm volatile("s_waitcnt vmcnt(0)" ::: "memory");
            const unsigned og = xb_add(&bar[XB_TOP], 1u);
            const unsigned tg = og / nx;
            if (og + 1u == (tg + 1u) * nx) xb_add(&bar[XB_TOPGEN], 1u);
            else XB_SPIN(xb_ld(&bar[XB_TOPGEN]) == tg, bar);
            __builtin_amdgcn_fence(__ATOMIC_ACQUIRE, "agent");
            xb_add(&bar[XB_XGEN(b.x)], 1u);
            asm volatile("s_waitcnt vmcnt(0)" ::: "memory");
        } else {
            XB_SPIN(xb_ld(&bar[XB_XGEN(b.x)]) == gen, bar);
            __builtin_amdgcn_fence(__ATOMIC_ACQUIRE, "agent");
            asm volatile("s_waitcnt vmcnt(0)" ::: "memory");
        }
    }
    __syncthreads();
}

__global__ void __launch_bounds__(NTHR, 2) mega(Params p) {
    extern __shared__ __attribute__((aligned(16))) unsigned char lds_raw[];
    LAS unsigned char* lds = (LAS unsigned char*)lds_raw;
    cg::grid_group grid = cg::this_grid();
    if (threadIdx.x < 2) ((volatile LAS unsigned*)(lds + LDS_RING + 16))[threadIdx.x] = 0u;
    __syncthreads();
    const XcdBarrier bar = xcd_barrier_post(p.ctl + 1024, (volatile LAS unsigned*)(lds + LDS_RING + 16));
#define GSYNC() xcd_barrier(bar)
    float* Xs = p.X + (size_t)TP * 1024;
    phase0(p, lds); grid.sync();
    norm_phase<true>(p, 0, 0, p.x_prompt, p.x_sample); GSYNC();
    { EmitQkvAB e{p.Q, p.Kp, p.Vp, p.U, p.fk_p, p.fv_p, p.fk_s, p.fv_s}; gemm_all(lds, p.XN, p.Wab, 2048, 1024, e); } GSYNC();
    phase3(p, lds); GSYNC();
    attn_phase<0, 8>(p, lds, p.ctl); GSYNC();
    { EmitRes e{p.x_prompt, p.x_sample, p.mod + 2048, p.X}; gemm_all(lds, p.CAT, p.Woab, 1024, 1024, e); } GSYNC();
    norm_phase<false>(p, 0, 1, p.X, Xs); GSYNC();
    { EmitUp e{p.H}; gemm_all(lds, p.XN, p.Wup, 4096, 1024, e); } GSYNC();
    { EmitRes e{p.X, Xs, p.mod + 5120, p.X}; gemm_all(lds, p.H, p.Wdn, 1024, 4096, e); } GSYNC();
    norm_phase<false>(p, 1, 0, p.X, Xs); GSYNC();
    { EmitQkvSB e{p.Q, p.Kp, p.Vp, p.sk_p, p.sv_p, p.sk_s, p.sv_s}; gemm_all(lds, p.XN, p.Wsb, 3072, 1024, e); } GSYNC();
    attn_phase<1, 16>(p, lds, p.ctl + 64); GSYNC();
    { EmitRes e{p.X, Xs, p.mod + (size_t)NSEQ * 6144 + 2048, p.X}; gemm_all(lds, p.CAT, p.Wosb, 1024, 1024, e); } GSYNC();
    norm_phase<false>(p, 1, 1, p.X, Xs); GSYNC();
    { EmitUp e{p.H}; gemm_all(lds, p.XN, p.Wup + (size_t)4096 * 1024, 4096, 1024, e); } GSYNC();
    { EmitRes e{p.X, Xs, p.mod + (size_t)NSEQ * 6144 + 5120, p.X}; gemm_all(lds, p.H, p.Wdn + (size_t)1024 * 4096, 1024, 4096, e); } GSYNC();
    final_norm_phase(p);
}

extern "C" void kernel_launch(void* const* d_in, const int* in_sizes, int n_in, void* d_out, int out_size, void* d_ws, size_t ws_size, hipStream_t stream) {
    static int grid = 0;
    if (grid == 0) {
        int dev = 0, cus = 0, per_cu = 0;
        hipGetDevice(&dev);
        hipDeviceGetAttribute(&cus, hipDeviceAttributeMultiprocessorCount, dev);
        if (hipFuncSetAttribute((const void*)mega, hipFuncAttributeMaxDynamicSharedMemorySize, LDS_BYTES) != hipSuccess) fprintf(stderr, "kernel_launch: hipFuncSetAttribute failed\n");
        if (hipOccupancyMaxActiveBlocksPerMultiprocessor(&per_cu, (const void*)mega, NTHR, LDS_BYTES) != hipSuccess || per_cu < 1) { fprintf(stderr, "kernel_launch: occupancy query says %d\n", per_cu); per_cu = 1; }
        (void)hipGetLastError();
        if (per_cu > 1) per_cu = 1;
        grid = cus * per_cu;
        if (n_in != 23 || out_size != 68428800 || ws_size < ((size_t)446 << 20)) fprintf(stderr, "kernel_launch: unexpected sizes n_in %d out %d ws %zu\n", n_in, out_size, ws_size);
    }
    const float* const* in = (const float* const*)d_in;
    Params p{};
    p.x_prompt = in[0]; p.x_sample = in[1]; p.c_prompt = in[2]; p.c_sample = in[3]; p.cfk = in[4]; p.cfv = in[5]; p.cfl = in[6]; p.spool = in[7]; p.csk = in[8]; p.csv = in[9];
    p.w_ada = in[10]; p.b_ada = in[11]; p.norm_g = in[12]; p.w_in_ab = in[13]; p.b_forget = in[14]; p.w_pool = in[15]; p.pool_scale = in[16]; p.w_out_ab = in[17];
    p.w_in_sb = in[18]; p.w_out_sb = in[19]; p.w_up = in[20]; p.w_down = in[21]; p.final_g = in[22];
    float* o = (float*)d_out;
    p.y_p = o; p.y_s = o + 16777216; p.fk_p = o + 17039360; p.fv_p = o + 25427968; p.fl_p = o + 33816576; p.pool_p = o + 33947648; p.sk_p = o + 33963008; p.sv_p = o + 50740224;
    p.fk_s = o + 67517440; p.fv_s = o + 67648512; p.fl_s = o + 67779584; p.pool_s = o + 67781632; p.sk_s = o + 67904512; p.sv_s = o + 68166656;
    unsigned char* ws = (unsigned char*)d_ws; const size_t MB = (size_t)1 << 20;
    p.ctl = (unsigned*)ws; p.mod = (float*)(ws + 1 * MB); p.Wf = (float*)(ws + 2 * MB); p.Fp = (float*)(ws + 3 * MB); p.Fs = (float*)(ws + 4 * MB);
    p.Wab = (bf16_t*)(ws + 8 * MB); p.Woab = (bf16_t*)(ws + 12 * MB); p.Wsb = (bf16_t*)(ws + 14 * MB); p.Wosb = (bf16_t*)(ws + 20 * MB); p.Wup = (bf16_t*)(ws + 22 * MB); p.Wdn = (bf16_t*)(ws + 38 * MB);
    p.XN = (bf16_t*)(ws + 54 * MB); p.X = (float*)(ws + 87 * MB); p.Q = (bf16_t*)(ws + 152 * MB); p.Kp = (bf16_t*)(ws + 185 * MB); p.Vp = (bf16_t*)(ws + 217 * MB);
    p.U = (float*)(ws + 249 * MB); p.CAT = (bf16_t*)(ws + 282 * MB); p.H = (bf16_t*)(ws + 315 * MB);
    (void)hipMemsetAsync(ws, 0, 32768, stream);
    void* args[] = {&p};
    hipError_t e = hipLaunchCooperativeKernel((const void*)mega, dim3(grid), dim3(NTHR), args, LDS_BYTES, stream);
    if (e != hipSuccess) fprintf(stderr, "kernel_launch: cooperative launch failed: %s (grid %d)\n", hipGetErrorString(e), grid);
}
```

```cpp
#include <hip/hip_runtime.h>
#include <hip/hip_cooperative_groups.h>
#include <cstdio>
#include <cstdint>
namespace cg = cooperative_groups;
__device__ __forceinline__ int tid_l() { int t = threadIdx.x; asm volatile("" : "+v"(t)); return t; }
namespace pg8 {
#define PG8_LAS __attribute__((address_space(3)))
typedef unsigned short bf16_t;
typedef short bf16x8 __attribute__((ext_vector_type(8)));
typedef float f32x4 __attribute__((ext_vector_type(4)));
typedef unsigned u32x4 __attribute__((ext_vector_type(4)));
constexpr int BM = 256, BK = 64, HALF = 128, HTB = HALF * BK * 2  , STAGE_BYTES = 8 * HTB, NXCD = 8, WGM = 8;

__host__ __device__ __forceinline__ int lds_byte(int r, int c) { const int st = (r >> 4) * 2 + (c >> 5), rr = r & 15, cc = c & 31, ob = rr * 64 + cc * 2; return st * 1024 + (ob ^ (((ob >> 9) & 1) << 5)); }
__host__ __device__ __forceinline__ void stage_rc(int b, int& R, int& C) { const int st = b / 1024, sb = b % 1024, swz = sb ^ (((sb >> 9) & 1) << 5); R = (st >> 1) * 16 + swz / 64; C = (st & 1) * 32 + (swz % 64) / 2; }
__host__ __device__ __forceinline__ int perm32(int rho) { const int n = rho >> 4, i = rho & 15; return 8 * (i >> 2) + 4 * n + (i & 3); }

struct Unit { int pm, pn; };
struct Gemm { const bf16_t* A; const bf16_t* Bt; int M, N, K; };

struct StaticOrder {
    int nM, nN, nwg, G, c;
    __host__ __device__ void init(int M, int N, int G_, int c_) { nM = M / BM; nN = N / BM; nwg = nM * nN; G = G_; c = c_; }
    __host__ __device__ bool next(int i, Unit& u) const {
        const long L = (long)i * G + c; if (L >= nwg) return false;
        int wgid = (int)L; { const int q = nwg / NXCD, r = nwg % NXCD, xcd = wgid % NXCD, off = wgid / NXCD; wgid = (xcd < r ? xcd * (q + 1) : r * (q + 1) + (xcd - r) * q) + off; }
        const int nig = WGM * nN, gid = wgid / nig, fm = gid * WGM, gsz = (nM - fm) < WGM ? (nM - fm) : WGM;
        u.pm = fm + ((wgid % nig) % gsz); u.pn = (wgid % nig) / gsz; return true;
    }
    __device__ __forceinline__ void a_ready(const Unit&) const {}
    __device__ __forceinline__ void done(const Unit&) const {}
};

__device__ __forceinline__ unsigned cvt_pk_bf16(float lo, float hi) { unsigned r; asm volatile("v_cvt_pk_bf16_f32 %0, %1, %2" : "=v"(r) : "v"(lo), "v"(hi)); return r; }
template <class Epi, class Sched, bool ALIGN_EPI = false, bool SP2 = false>
__device__ __forceinline__ void gemm_phase(PG8_LAS unsigned char* lds, const Gemm g, const Sched& S, const Epi& E) {
    const int tid = tid_l(), wid = __builtin_amdgcn_readfirstlane(tid >> 6), lane = tid & 63, wr = wid >> 2, wc = wid & 3, fr = lane & 15, fq = lane >> 4;
    const int K = g.K, nt = K / BK;
    unsigned voffA[2], voffB[2];
#pragma unroll
    for (int i = 0; i < 2; ++i) { int R, C; stage_rc(tid * 16 + i * 8192, R, C); const int Rb = Epi::PERM ? ((R & ~31) + perm32(R & 31)) : R;
        voffA[i] = (unsigned)(R * K + C) * 2u; voffB[i] = (unsigned)(Rb * K + C) * 2u; }
    const size_t kstep = (size_t)(BK * 2);
    const size_t hstep = (size_t)HALF * K * 2;
    const size_t tstep = 2 * hstep;
    const unsigned ldsw = (unsigned)wid * 1024u;
    const int aoff = lds_byte(wr * 64 + fr, fq * 8), boff = lds_byte(wc * 32 + fr, fq * 8);
#define PG8_SA(b, h) (((b) * 2 + (h)) * HTB)
#define PG8_SB(b, h) ((4 + (b) * 2 + (h)) * HTB)
#define PG8_STAGE(bufoff, gbase, voff) do { _Pragma("unroll") for (int _i = 0; _i < 2; ++_i) \
        __builtin_amdgcn_global_load_lds((const unsigned*)((const char*)(gbase) + (voff)[_i]), (PG8_LAS unsigned*)(lds + (bufoff) + ldsw + _i * 8192), 16, 0, 0); } while (0)
#define PG8_LDA(dst, b, h) do { _Pragma("unroll") for (int m = 0; m < 4; ++m) _Pragma("unroll") for (int k = 0; k < 2; ++k) dst[m][k] = *(const PG8_LAS bf16x8*)(lds + PG8_SA(b, h) + aoff + m * 2048 + k * 1024); } while (0)
#define PG8_LDB(dst, b, h) do { _Pragma("unroll") for (int n = 0; n < 2; ++n) _Pragma("unroll") for (int k = 0; k < 2; ++k) dst[n][k] = *(const PG8_LAS bf16x8*)(lds + PG8_SB(b, h) + boff + n * 2048 + k * 1024); } while (0)
#define PG8_MMA(ai, bj, At, Bt) do { __builtin_amdgcn_s_setprio(1); _Pragma("unroll") for (int m = 0; m < 4; ++m) _Pragma("unroll") for (int n = 0; n < 2; ++n) _Pragma("unroll") for (int k = 0; k < 2; ++k) \
        acc[ai][bj][m][n] = __builtin_amdgcn_mfma_f32_16x16x32_bf16(Bt[n][k], At[m][k], acc[ai][bj][m][n], 0, 0, 0); __builtin_amdgcn_s_setprio(0); } while (0)
#define PG8_WAIT_V(n) asm volatile("s_waitcnt vmcnt(" #n ")" ::: "memory")
#define PG8_WAIT_L(n) asm volatile("s_waitcnt lgkmcnt(" #n ")" ::: "memory")
#define PG8_BAR __builtin_amdgcn_s_barrier()
#define PG8_SCHED __builtin_amdgcn_sched_barrier(0)
    Unit cur, nxt; int ui = 0;
    if (!S.next(0, cur)) return;
    f32x4 acc[2][2][4][2];
#pragma unroll
    for (int a = 0; a < 2; ++a)
#pragma unroll
        for (int b = 0; b < 2; ++b)
#pragma unroll
            for (int m = 0; m < 4; ++m)
#pragma unroll
                for (int n = 0; n < 2; ++n) acc[a][b][m][n] = (f32x4){0.f, 0.f, 0.f, 0.f};
    bf16x8 At[4][2], B0[2][2], B1[2][2];
    const char* cA = (const char*)g.A + (size_t)cur.pm * tstep; const char* cB = (const char*)g.Bt + (size_t)cur.pn * tstep;
    S.a_ready(cur);
    if constexpr (SP2) {
        PG8_STAGE(PG8_SB(0, 0), cB, voffB); PG8_STAGE(PG8_SB(0, 1), cB + hstep, voffB); PG8_STAGE(PG8_SA(0, 0), cA, voffA); PG8_STAGE(PG8_SA(0, 1), cA + hstep, voffA);
        if (wr == 1) PG8_BAR;
        PG8_WAIT_V(2); PG8_BAR;
        PG8_STAGE(PG8_SB(1, 0), cB + kstep, voffB); PG8_STAGE(PG8_SA(1, 0), cA + kstep, voffA); PG8_STAGE(PG8_SB(1, 1), cB + hstep + kstep, voffB);
        PG8_WAIT_V(6); PG8_BAR;
    } else {
        PG8_STAGE(PG8_SB(0, 0), cB, voffB); PG8_STAGE(PG8_SA(0, 0), cA, voffA); PG8_STAGE(PG8_SB(0, 1), cB + hstep, voffB); PG8_STAGE(PG8_SA(0, 1), cA + hstep, voffA);
        if (wr == 1) PG8_BAR;
        PG8_WAIT_V(4); PG8_BAR;
        PG8_STAGE(PG8_SB(1, 0), cB + kstep, voffB); PG8_STAGE(PG8_SA(1, 0), cA + kstep, voffA); PG8_STAGE(PG8_SB(1, 1), cB + hstep + kstep, voffB);
        PG8_WAIT_V(6); PG8_BAR;
    }
    for (;;) {
        const bool has_next = S.next(ui + 1, nxt);
        const char* nA = has_next ? (const char*)g.A + (size_t)nxt.pm * tstep : cA; const char* nB = has_next ? (const char*)g.Bt + (size_t)nxt.pn * tstep : cB;
        for (int t = 0; t < nt; t += 2) {
            const bool last = (t == nt - 2);
            const char* a1 = cA + (size_t)(t + 1) * kstep;
            const char* a2 = last ? nA : cA + (size_t)(t + 2) * kstep; const char* b2 = last ? nB : cB + (size_t)(t + 2) * kstep;
            const char* a3 = a2 + kstep; const char* b3 = b2 + kstep;
            if (last && has_next) S.a_ready(nxt);
            if constexpr (SP2) {
            PG8_LDB(B0, 0, 0); PG8_LDB(B1, 0, 1); PG8_SCHED; PG8_LDA(At, 0, 0); PG8_STAGE(PG8_SA(1, 1), a1 + hstep, voffA);
            PG8_WAIT_V(8); PG8_WAIT_L(0); PG8_BAR; PG8_MMA(0, 0, At, B0); PG8_MMA(0, 1, At, B1); PG8_BAR; PG8_SCHED;
            PG8_LDA(At, 0, 1); PG8_STAGE(PG8_SB(0, 0), b2, voffB); PG8_STAGE(PG8_SB(0, 1), b2 + hstep, voffB); PG8_STAGE(PG8_SA(0, 0), a2, voffA);
            PG8_WAIT_V(8); PG8_WAIT_L(0); PG8_BAR; PG8_MMA(1, 0, At, B0); PG8_MMA(1, 1, At, B1); PG8_BAR; PG8_SCHED;
            PG8_LDB(B0, 1, 0); PG8_LDB(B1, 1, 1); PG8_SCHED; PG8_LDA(At, 1, 0); PG8_STAGE(PG8_SA(0, 1), a2 + hstep, voffA);
            PG8_WAIT_V(8); PG8_WAIT_L(0); PG8_BAR; PG8_MMA(0, 0, At, B0); PG8_MMA(0, 1, At, B1); PG8_BAR; PG8_SCHED;
            PG8_LDA(At, 1, 1); PG8_STAGE(PG8_SB(1, 0), b3, voffB); PG8_STAGE(PG8_SB(1, 1), b3 + hstep, voffB); PG8_STAGE(PG8_SA(1, 0), a3, voffA);
            PG8_WAIT_V(8); PG8_WAIT_L(0); PG8_BAR; PG8_MMA(1, 0, At, B0); PG8_MMA(1, 1, At, B1); PG8_BAR; PG8_SCHED;
            } else {
            PG8_LDB(B0, 0, 0); PG8_SCHED; PG8_LDA(At, 0, 0); PG8_STAGE(PG8_SA(1, 1), a1 + hstep, voffA);
            PG8_WAIT_L(8); PG8_BAR; PG8_WAIT_L(0); PG8_MMA(0, 0, At, B0); PG8_BAR; PG8_SCHED;
            PG8_LDB(B1, 0, 1); PG8_STAGE(PG8_SB(0, 0), b2, voffB);
            PG8_BAR; PG8_WAIT_L(0); PG8_MMA(0, 1, At, B1); PG8_BAR;
            PG8_LDA(At, 0, 1); PG8_STAGE(PG8_SA(0, 0), a2, voffA);
            PG8_BAR; PG8_WAIT_L(0); PG8_MMA(1, 0, At, B0); PG8_BAR; PG8_SCHED;
            PG8_STAGE(PG8_SB(0, 1), b2 + hstep, voffB);
            PG8_WAIT_V(6); PG8_BAR; PG8_MMA(1, 1, At, B1); PG8_BAR;
            PG8_LDB(B0, 1, 0); PG8_SCHED; PG8_LDA(At, 1, 0); PG8_STAGE(PG8_SA(0, 1), a2 + hstep, voffA);
            PG8_WAIT_L(8); PG8_BAR; PG8_WAIT_L(0); PG8_MMA(0, 0, At, B0); PG8_BAR; PG8_SCHED;
            PG8_LDB(B1, 1, 1); PG8_STAGE(PG8_SB(1, 0), b3, voffB);
            PG8_BAR; PG8_WAIT_L(0); PG8_MMA(0, 1, At, B1); PG8_BAR;
            PG8_LDA(At, 1, 1); PG8_STAGE(PG8_SA(1, 0), a3, voffA);
            PG8_BAR; PG8_WAIT_L(0); PG8_MMA(1, 0, At, B0); PG8_BAR; PG8_SCHED;
            PG8_STAGE(PG8_SB(1, 1), b3 + hstep, voffB);
            PG8_WAIT_V(6); PG8_BAR; PG8_MMA(1, 1, At, B1); PG8_BAR;
            }
        }
        if constexpr (ALIGN_EPI) { if (wr == 0) PG8_BAR; }
        if constexpr (!Epi::AFTER_DRAIN) { E(acc, cur, wr, wc, fr, fq); S.done(cur); }
        if (!has_next) break;
#pragma unroll
        for (int a = 0; a < 2; ++a)
#pragma unroll
            for (int b = 0; b < 2; ++b)
#pragma unroll
                for (int m = 0; m < 4; ++m)
#pragma unroll
                    for (int n = 0; n < 2; ++n) acc[a][b][m][n] = (f32x4){0.f, 0.f, 0.f, 0.f};
        cur = nxt; cA = nA; cB = nB; ++ui;
        if constexpr (ALIGN_EPI) { if (wr == 1) PG8_BAR; }
    }
    PG8_WAIT_V(0);
    if constexpr (!ALIGN_EPI) { if (wr == 0) PG8_BAR; }
    PG8_BAR;
    if constexpr (Epi::AFTER_DRAIN) { E.fused(acc, cur, wr, wc, fr, fq, lds, wid, lane); S.done(cur); }
#undef PG8_SA
#undef PG8_SB
#undef PG8_STAGE
#undef PG8_LDA
#undef PG8_LDB
#undef PG8_MMA
#undef PG8_WAIT_V
#undef PG8_WAIT_L
#undef PG8_BAR
#undef PG8_SCHED
}
}

#define LAS __attribute__((address_space(3)))
typedef unsigned short bf16_t;
typedef short bf16x8 __attribute__((ext_vector_type(8)));
typedef short s16x4 __attribute__((ext_vector_type(4)));
typedef float f32x4 __attribute__((ext_vector_type(4)));
typedef float f32x16 __attribute__((ext_vector_type(16)));
typedef unsigned u32x4 __attribute__((ext_vector_type(4)));
typedef unsigned u32x2 __attribute__((ext_vector_type(2)));
typedef float f32x2_t __attribute__((ext_vector_type(2)));
typedef __bf16 bf16x2_t __attribute__((ext_vector_type(2)));

constexpr int TP = 16384, TS = 256, TT = TP + TS, DM = 1024, DFF = 4096;
constexpr int SEQ = 8192, PAST = 4096, LPAD = 4160, NSEQ = 18;
constexpr float LOG2E = 1.4426950408889634f;
constexpr int NTHR = 512, NWV = 8;
constexpr int LDS_RING = 131072, LDS_BYTES = LDS_RING + 1024;

struct Params {
    const float *x_prompt, *x_sample, *c_prompt, *c_sample, *cfk, *cfv, *cfl, *spool, *csk, *csv;
    const float *w_ada, *b_ada, *norm_g, *w_in_ab, *b_forget, *w_pool, *pool_scale, *w_out_ab, *w_in_sb, *w_out_sb, *w_up, *w_down, *final_g;
    float *y_p, *y_s, *fk_p, *fv_p, *fl_p, *pool_p, *sk_p, *sv_p, *fk_s, *fv_s, *fl_s, *pool_s, *sk_s, *sv_s;
    unsigned* ctl; float *mod, *Wf, *Fp, *Fs;
    bf16_t *Wab, *Woab, *Wsb, *Wosb, *Wup, *Wdn, *XN;
    float* X; bf16_t *Q, *Kp, *Vp; float* U; bf16_t *CAT, *H;
};

#define DI __device__ __forceinline__
DI unsigned cvtpk(float lo, float hi) { f32x2_t v = {lo, hi}; bf16x2_t b = __builtin_convertvector(v, bf16x2_t); return __builtin_bit_cast(unsigned, b); }
DI int seq_of(int t) { return t < TP ? (t >> 13) : 2 + ((t - TP) >> 4); }
DI float wave_sum(float v) {
#pragma unroll
    for (int o = 1; o < 64; o <<= 1) v += __shfl_xor(v, o);
    return v;
}
DI void st_bf4(bf16_t* p, f32x4 v) { u32x2 w; w.x = cvtpk(v[0], v[1]); w.y = cvtpk(v[2], v[3]); *(u32x2*)p = w; }
#define LDS_WAIT() asm volatile("s_waitcnt lgkmcnt(0)" ::: "memory")

DI void tr_item(const float* W, int ldw, int k0, int c0, bf16_t* WT, int ldt, int r0, int kd0, LAS float* scr, int lane) {
#pragma unroll 8
    for (int i = 0; i < 32; ++i) { const int kk = 2 * i + (lane >> 5); scr[kk * 33 + (lane & 31)] = W[(size_t)(k0 + kk) * ldw + c0 + (lane & 31)]; }
    LDS_WAIT();
    const int c = lane & 7;
#pragma unroll
    for (int j = 0; j < 4; ++j) { const int n = (lane >> 3) + 8 * j; const LAS float* s = scr + (8 * c) * 33 + n;
        u32x4 o; o.x = cvtpk(s[0 * 33], s[1 * 33]); o.y = cvtpk(s[2 * 33], s[3 * 33]); o.z = cvtpk(s[4 * 33], s[5 * 33]); o.w = cvtpk(s[6 * 33], s[7 * 33]);
        *(u32x4*)(WT + (size_t)(r0 + n) * ldt + kd0 + 8 * c) = o; }
    LDS_WAIT();
}

DI void phase0(const Params& p, LAS unsigned char* lds) {
    const int tid = tid_l(), lane = tid & 63, wave = tid >> 6;
    if ((int)blockIdx.x < 192) {
        LAS float* cond = (LAS float*)lds;
        LAS float* red = (LAS float*)(lds + 73728);
        for (int i = tid; i < NSEQ * 1024; i += NTHR) { const int s = i >> 10, k = i & 1023; const float c = s < 2 ? p.c_prompt[s * 1024 + k] : p.c_sample[(s - 2) * 1024 + k]; cond[i] = c / (1.0f + expf(-c)); }
        __syncthreads();
        for (int item = blockIdx.x; item < 192; item += gridDim.x) {
            const int layer = item / 96, col0 = (item % 96) * 64, quad = tid & 15, kc = tid >> 4;
            float acc[NSEQ][4];
#pragma unroll
            for (int s = 0; s < NSEQ; ++s) { acc[s][0] = 0.f; acc[s][1] = 0.f; acc[s][2] = 0.f; acc[s][3] = 0.f; }
            const float* wp = p.w_ada + ((size_t)layer * 1024 + kc * 32) * 6144 + col0 + 4 * quad;
#pragma unroll 4
            for (int kk = 0; kk < 32; ++kk) { const f32x4 w = *(const f32x4*)(wp + (size_t)kk * 6144);
#pragma unroll
                for (int s = 0; s < NSEQ; ++s) { const float cs = cond[s * 1024 + kc * 32 + kk]; acc[s][0] += cs * w[0]; acc[s][1] += cs * w[1]; acc[s][2] += cs * w[2]; acc[s][3] += cs * w[3]; } }
#pragma unroll
            for (int s = 0; s < NSEQ; ++s)
#pragma unroll
                for (int j = 0; j < 4; ++j) { float v = acc[s][j]; v += __shfl_xor(v, 16); v += __shfl_xor(v, 32); if (lane < 16) red[((wave * 16 + quad) * NSEQ + s) * 4 + j] = v; }
            __syncthreads();
            for (int o = tid; o < 16 * NSEQ * 4; o += NTHR) { const int qd = o / (NSEQ * 4), rem = o % (NSEQ * 4), s = rem >> 2, j = rem & 3; float sum = 0.f;
#pragma unroll
                for (int w = 0; w < 8; ++w) sum += red[((w * 16 + qd) * NSEQ + s) * 4 + j];
                const int col = col0 + 4 * qd + j; p.mod[((size_t)layer * NSEQ + s) * 6144 + col] = sum + p.b_ada[layer * 6144 + col]; }
            __syncthreads();
        }
    }
    for (int it = (int)gridDim.x - 1 - (int)blockIdx.x; it < 128; it += gridDim.x) {
        const int g = it >> 5, rem = it & 31, cblk = rem >> 1, n = (rem & 1) * 512 + tid;
        float acc[8];
#pragma unroll
        for (int j = 0; j < 8; ++j) acc[j] = 0.f;
        for (int e = 0; e < 128; ++e) { const float wv = p.w_out_ab[(size_t)(512 + 128 * g + e) * 1024 + n] * p.pool_scale[128 * g + e];
#pragma unroll
            for (int j = 0; j < 8; ++j) acc[j] += p.w_pool[((g * 128) + cblk * 8 + j) * 128 + e] * wv; }
        u32x4 o; o.x = cvtpk(acc[0], acc[1]); o.y = cvtpk(acc[2], acc[3]); o.z = cvtpk(acc[4], acc[5]); o.w = cvtpk(acc[6], acc[7]);
        *(u32x4*)(p.Woab + (size_t)n * 1024 + 512 + 128 * g + cblk * 8) = o;
    }
    for (int i = blockIdx.x * NTHR + tid; i < 8192; i += gridDim.x * NTHR) { const int h = i >> 10, k = i & 1023; p.Wf[i] = p.w_in_ab[(size_t)k * 2056 + 1536 + h]; }
    __syncthreads();
    LAS float* scr = (LAS float*)(lds + wave * 16384);
    const int gw = blockIdx.x * NWV + wave, NGW = gridDim.x * NWV;
    constexpr int NITEMS = 1024 + 256 + 1536 + 512 + 4096 + 4096;
    for (int it = gw; it < NITEMS; it += NGW) {
        int r = it;
        if (r < 1024) { const int kb = r >> 6, n0 = (r & 63) * 32, c0 = n0 < 1536 ? n0 : n0 + 8; tr_item(p.w_in_ab, 2056, kb * 64, c0, p.Wab, 1024, n0, kb * 64, scr, lane); continue; } r -= 1024;
        if (r < 256) { const int kb = r >> 5, n0 = (r & 31) * 32; tr_item(p.w_out_ab, 1024, kb * 64, n0, p.Woab, 1024, n0, kb * 64, scr, lane); continue; } r -= 256;
        if (r < 1536) { const int kb = r / 96, n0 = (r % 96) * 32; tr_item(p.w_in_sb, 3072, kb * 64, n0, p.Wsb, 1024, n0, kb * 64, scr, lane); continue; } r -= 1536;
        if (r < 512) { const int kb = r >> 5, n0 = (r & 31) * 32; tr_item(p.w_out_sb, 1024, kb * 64, n0, p.Wosb, 1024, n0, kb * 64, scr, lane); continue; } r -= 512;
        if (r < 4096) { const int layer = r >> 11, r2 = r & 2047, kb = r2 >> 7, n0 = (r2 & 127) * 32;
            tr_item(p.w_up + (size_t)layer * 1024 * 4096, 4096, kb * 64, n0, p.Wup + (size_t)layer * 4096 * 1024, 1024, n0, kb * 64, scr, lane); continue; } r -= 4096;
        { const int layer = r >> 11, r2 = r & 2047, kb = r2 >> 5, n0 = (r2 & 31) * 32;
            tr_item(p.w_down + (size_t)layer * 4096 * 1024, 1024, kb * 64, n0, p.Wdn + (size_t)layer * 1024 * 4096, 4096, n0, kb * 64, scr, lane); }
    }
}

template <bool FLOGIT>
DI void norm_phase(const Params& p, int layer, int which, const float* xin_p, const float* xin_s) {
    const int tid = tid_l(), lane = tid & 63, wave = tid >> 6;
    const int gw = blockIdx.x * NWV + wave, NGW = gridDim.x * NWV;
    const float* gptr = p.norm_g + (layer * 2 + which) * 1024;
    for (int t = gw; t < TT; t += NGW) {
        const float* xr = t < TP ? xin_p + (size_t)t * 1024 : xin_s + (size_t)(t - TP) * 1024;
        const float* md = p.mod + ((size_t)layer * NSEQ + seq_of(t)) * 6144 + (which ? 3072 : 0);
        f32x4 v[4]; float ss = 0.f;
#pragma unroll
        for (int j = 0; j < 4; ++j) { v[j] = *(const f32x4*)(xr + 4 * lane + 256 * j); ss += (v[j][0] * v[j][0] + v[j][1] * v[j][1]) + (v[j][2] * v[j][2] + v[j][3] * v[j][3]); }
        const float rstd = 1.0f / sqrtf(wave_sum(ss) * (1.0f / 1024.0f) + 1e-6f);
        float fd[8];
#pragma unroll
        for (int h = 0; h < 8; ++h) fd[h] = 0.f;
#pragma unroll
        for (int j = 0; j < 4; ++j) { const int col = 4 * lane + 256 * j;
            const f32x4 g = *(const f32x4*)(gptr + col), sh = *(const f32x4*)(md + col), sc = *(const f32x4*)(md + 1024 + col);
            f32x4 y;
#pragma unroll
            for (int e = 0; e < 4; ++e) y[e] = (v[j][e] * rstd * g[e]) * (1.0f + sc[e]) + sh[e];
            st_bf4(p.XN + (size_t)t * 1024 + col, y);
            if (FLOGIT) {
#pragma unroll
                for (int h = 0; h < 8; ++h) { const f32x4 w = *(const f32x4*)(p.Wf + h * 1024 + col); fd[h] += (y[0] * w[0] + y[1] * w[1]) + (y[2] * w[2] + y[3] * w[3]); } }
        }
        if (FLOGIT) {
            float mine = 0.f;
#pragma unroll
            for (int h = 0; h < 8; ++h) { const float s = wave_sum(fd[h]); if (lane == h) mine = s; }
            if (lane < 8) { const float z = mine + p.b_forget[lane]; const float lf = fminf(z, 0.f) - log1pf(expf(-fabsf(z)));
                if (t < TP) p.fl_p[(size_t)t * 8 + lane] = lf; else p.fl_s[(size_t)(t - TP) * 8 + lane] = lf; }
        }
    }
}
DI void final_norm_phase(const Params& p) {
    const int tid = tid_l(), lane = tid & 63, wave = tid >> 6;
    const int gw = blockIdx.x * NWV + wave, NGW = gridDim.x * NWV;
    for (int t = gw; t < TT; t += NGW) {
        const float* xr = p.X + (size_t)t * 1024; float* yr = t < TP ? p.y_p + (size_t)t * 1024 : p.y_s + (size_t)(t - TP) * 1024;
        f32x4 v[4]; float ss = 0.f;
#pragma unroll
        for (int j = 0; j < 4; ++j) { v[j] = *(const f32x4*)(xr + 4 * lane + 256 * j); ss += (v[j][0] * v[j][0] + v[j][1] * v[j][1]) + (v[j][2] * v[j][2] + v[j][3] * v[j][3]); }
        const float rstd = 1.0f / sqrtf(wave_sum(ss) * (1.0f / 1024.0f) + 1e-6f);
#pragma unroll
        for (int j = 0; j < 4; ++j) { const int col = 4 * lane + 256 * j; const f32x4 g = *(const f32x4*)(p.final_g + col); f32x4 y;
#pragma unroll
            for (int e = 0; e < 4; ++e) y[e] = v[j][e] * rstd * g[e];
            *(f32x4*)(yr + col) = y; }
    }
}

struct EmitQkvAB { bf16_t *Q, *Kp, *Vp; float *U, *fk_p, *fv_p, *fk_s, *fv_s;
    DI void emit(int t, int c, f32x4 v) const {
        if (c < 512) { st_bf4(Q + (size_t)t * 512 + c, v * (0.125f * LOG2E)); }
        else if (c < 1024) { const int cc = c - 512; if (t < TP) { st_bf4(Kp + (size_t)t * 512 + cc, v); *(f32x4*)(fk_p + (size_t)t * 512 + cc) = v; } else *(f32x4*)(fk_s + (size_t)(t - TP) * 512 + cc) = v; }
        else if (c < 1536) { const int cc = c - 1024; if (t < TP) { st_bf4(Vp + (size_t)t * 512 + cc, v); *(f32x4*)(fv_p + (size_t)t * 512 + cc) = v; } else *(f32x4*)(fv_s + (size_t)(t - TP) * 512 + cc) = v; }
        else { *(f32x4*)(U + (size_t)t * 512 + (c - 1536)) = v; }
    } };
struct EmitQkvSB { bf16_t *Q, *Kp, *Vp; float *sk_p, *sv_p, *sk_s, *sv_s;
    DI void emit(int t, int c, f32x4 v) const {
        if (c < 1024) { st_bf4(Q + (size_t)t * 1024 + c, v * (0.125f * LOG2E)); }
        else if (c < 2048) { const int cc = c - 1024; if (t < TP) { st_bf4(Kp + (size_t)t * 1024 + cc, v); *(f32x4*)(sk_p + (size_t)t * 1024 + cc) = v; } else *(f32x4*)(sk_s + (size_t)(t - TP) * 1024 + cc) = v; }
        else { const int cc = c - 2048; if (t < TP) { st_bf4(Vp + (size_t)t * 1024 + cc, v); *(f32x4*)(sv_p + (size_t)t * 1024 + cc) = v; } else *(f32x4*)(sv_s + (size_t)(t - TP) * 1024 + cc) = v; }
    } };
struct EmitRes { const float* xin_p; const float* xin_s; const float* modg; float* X;
    DI void emit(int t, int c, f32x4 v) const {
        const float* xr = t < TP ? xin_p + (size_t)t * 1024 : xin_s + (size_t)(t - TP) * 1024;
        const f32x4 x = *(const f32x4*)(xr + c), g = *(const f32x4*)(modg + (size_t)seq_of(t) * 6144 + c);
        *(f32x4*)(X + (size_t)t * 1024 + c) = x + g * v;
    } };
struct EmitUp { bf16_t* H;
    DI void emit(int t, int c, f32x4 v) const { f32x4 r;
#pragma unroll
        for (int e = 0; e < 4; ++e) { const float a = fmaxf(v[e], 0.f); r[e] = a * a; }
        st_bf4(H + (size_t)t * 4096 + c, r); } };

template <class F> struct EpiEmit {
    static constexpr bool PERM = false, AFTER_DRAIN = false;
    F f;
    DI void operator()(const pg8::f32x4 (&acc)[2][2][4][2], const pg8::Unit& u, int wr, int wc, int fr, int fq) const {
        const int row0 = u.pm * 256 + wr * 64 + fr, col0 = u.pn * 256 + wc * 32 + 4 * fq;
#pragma unroll
        for (int ai = 0; ai < 2; ++ai)
#pragma unroll
            for (int m = 0; m < 4; ++m)
#pragma unroll
                for (int bj = 0; bj < 2; ++bj)
#pragma unroll
                    for (int n = 0; n < 2; ++n) f.emit(row0 + ai * 128 + m * 16, col0 + bj * 128 + n * 16, acc[ai][bj][m][n]);
    }
};

template <class F>
DI void skinny_gemm(LAS unsigned char* lds, const bf16_t* A, const bf16_t* Bt, int N, int K, const F& f) {
    const int tid = tid_l(), lane = tid & 63, wave = tid >> 6, rsub = wave & 3, kh = wave >> 2, fr = lane & 15, fq = lane >> 4;
    const int nitems = 4 * (N >> 4), Kh = K >> 1;
    LAS f32x4* red = (LAS f32x4*)lds;
    for (int item = blockIdx.x; item < nitems; item += gridDim.x) {
        const int rb = item & 3, cb = item >> 2;
        const bf16_t* ap = A + (size_t)(rb * 64 + rsub * 16 + fr) * K + kh * Kh + 8 * fq;
        const bf16_t* bp = Bt + (size_t)(cb * 16 + fr) * K + kh * Kh + 8 * fq;
        f32x4 acc = {0.f, 0.f, 0.f, 0.f};
        for (int ks = 0; ks < Kh; ks += 256) {
            bf16x8 a[8], b[8];
#pragma unroll
            for (int i = 0; i < 8; ++i) { a[i] = *(const bf16x8*)(ap + ks + 32 * i); b[i] = *(const bf16x8*)(bp + ks + 32 * i); }
#pragma unroll
            for (int i = 0; i < 8; ++i) acc = __builtin_amdgcn_mfma_f32_16x16x32_bf16(b[i], a[i], acc, 0, 0, 0);
        }
        if (kh == 1) red[rsub * 64 + lane] = acc;
        __syncthreads();
        if (kh == 0) { acc = acc + red[rsub * 64 + lane]; f.emit(TP + rb * 64 + rsub * 16 + fr, cb * 16 + 4 * fq, acc); }
        __syncthreads();
    }
}

template <class F>
DI void gemm_all(LAS unsigned char* lds, const bf16_t* A, const bf16_t* Bt, int N, int K, const F& f) {
    { pg8::Gemm g{A, Bt, TP, N, K}; pg8::StaticOrder S; S.init(TP, N, (int)gridDim.x, (int)blockIdx.x);
      EpiEmit<F> E{f};
      pg8::gemm_phase<EpiEmit<F>, pg8::StaticOrder, true, true>(lds, g, S, E); }
    __syncthreads();
    skinny_gemm<F>(lds, A + (size_t)TP * K, Bt, N, K, f);
}

template <int PER>
DI void scan_item(LAS unsigned char* lds, const float* src_a, int na, const float* src_b, int ntot, int stride, float* dst, int ndst) {
    const int tid = tid_l(), lane = tid & 63, wave = tid >> 6;
    LAS float* wt = (LAS float*)lds;
    float v[PER]; float tot = 0.f;
#pragma unroll
    for (int i = 0; i < PER; ++i) { const int pos = tid * PER + i; float x = 0.f; if (pos < na) x = src_a[(size_t)pos * stride]; else if (pos < ntot) x = src_b[(size_t)(pos - na) * stride]; tot += x; v[i] = tot; }
    float inc = tot;
#pragma unroll
    for (int o = 1; o < 64; o <<= 1) { const float t = __shfl_up(inc, o); if (lane >= o) inc += t; }
    __syncthreads();
    if (lane == 63) wt[wave] = inc;
    __syncthreads();
    float base = 0.f;
#pragma unroll
    for (int w = 0; w < 8; ++w) if (w < wave) base += wt[w];
    const float ex = base + inc - tot;
#pragma unroll
    for (int i = 0; i < PER; ++i) { const int pos = tid * PER + i; if (pos < ntot) dst[pos] = ex + v[i]; else if (pos < ndst) dst[pos] = 0.f; }
}
DI void phase3(const Params& p, LAS unsigned char* lds) {
    const int tid = tid_l();
    for (int it = blockIdx.x; it < 144; it += gridDim.x) {
        if (it < 16) { scan_item<16>(lds, p.fl_p + (size_t)(it >> 3) * SEQ * 8 + (it & 7), SEQ, nullptr, SEQ, 8, p.Fp + (size_t)it * SEQ, SEQ); }
        else { const int bh = it - 16, b = bh >> 3, h = bh & 7;
            scan_item<9>(lds, p.cfl + (size_t)b * PAST * 8 + h, PAST, p.fl_s + (size_t)b * 16 * 8 + h, PAST + 16, 8, p.Fs + (size_t)bh * LPAD, LPAD); }
    }
    for (int i = blockIdx.x * NTHR + tid; i < TT * 128; i += gridDim.x * NTHR) {
        const int t = i >> 7, c = (i & 127) * 4, g = c >> 7, w = 2 << g;
        const f32x4 u = *(const f32x4*)(p.U + (size_t)t * 512 + c);
        f32x4 sum = u; float cnt;
        if (t < TP) { const int pos = t & (SEQ - 1); const int nw = pos + 1 < w ? pos + 1 : w; cnt = (float)nw;
            for (int k = 1; k < nw; ++k) sum += *(const f32x4*)(p.U + (size_t)(t - k) * 512 + c);
            if (pos >= SEQ - 15) *(f32x4*)(p.pool_p + ((size_t)(t >> 13) * 15 + (pos - (SEQ - 15))) * 512 + c) = u;
        } else { const int b = (t - TP) >> 4, loc = (t - TP) & 15; cnt = (float)w;
            for (int k = 1; k < w; ++k) { const int li = loc - k; sum += li >= 0 ? *(const f32x4*)(p.U + (size_t)(t - k) * 512 + c) : *(const f32x4*)(p.spool + ((size_t)b * 15 + 15 + li) * 512 + c); }
            if (loc >= 1) *(f32x4*)(p.pool_s + ((size_t)b * 15 + loc - 1) * 512 + c) = u;
        }
        f32x4 r;
#pragma unroll
        for (int e = 0; e < 4; ++e) r[e] = sum[e] / cnt - u[e];
        st_bf4(p.CAT + (size_t)t * 1024 + 512 + c, r);
    }
}

constexpr int AKS = 9216;
constexpr int ABUF = 2 * AKS + 256;
#define MFMA32(a, b, c) __builtin_amdgcn_mfma_f32_32x32x16_bf16((a), (b), (c), 0, 0, 0)
DI float max3f(float a, float b, float c) { float r; asm("v_max3_f32 %0, %1, %2, %3" : "=v"(r) : "v"(a), "v"(b), "v"(c)); return r; }
DI bf16x8 pack8(const f32x16& s, int base) { u32x4 w; w.x = cvtpk(s[base], s[base + 1]); w.y = cvtpk(s[base + 2], s[base + 3]); w.z = cvtpk(s[base + 4], s[base + 5]); w.w = cvtpk(s[base + 6], s[base + 7]); return __builtin_bit_cast(bf16x8, w); }
#define TR4(O) "ds_read_b64_tr_b16 %" #O ", %16 offset:"
#define TR16(v, addr) asm volatile( \
    "ds_read_b64_tr_b16 %0, %16\n\tds_read_b64_tr_b16 %1, %16 offset:64\n\tds_read_b64_tr_b16 %2, %16 offset:576\n\tds_read_b64_tr_b16 %3, %16 offset:640\n\t" \
    "ds_read_b64_tr_b16 %4, %16 offset:1152\n\tds_read_b64_tr_b16 %5, %16 offset:1216\n\tds_read_b64_tr_b16 %6, %16 offset:1728\n\tds_read_b64_tr_b16 %7, %16 offset:1792\n\t" \
    "ds_read_b64_tr_b16 %8, %16 offset:2304\n\tds_read_b64_tr_b16 %9, %16 offset:2368\n\tds_read_b64_tr_b16 %10, %16 offset:2880\n\tds_read_b64_tr_b16 %11, %16 offset:2944\n\t" \
    "ds_read_b64_tr_b16 %12, %16 offset:3456\n\tds_read_b64_tr_b16 %13, %16 offset:3520\n\tds_read_b64_tr_b16 %14, %16 offset:4032\n\tds_read_b64_tr_b16 %15, %16 offset:4096" \
    : "=&v"(v[0]), "=&v"(v[1]), "=&v"(v[2]), "=&v"(v[3]), "=&v"(v[4]), "=&v"(v[5]), "=&v"(v[6]), "=&v"(v[7]), "=&v"(v[8]), "=&v"(v[9]), "=&v"(v[10]), "=&v"(v[11]), "=&v"(v[12]), "=&v"(v[13]), "=&v"(v[14]), "=&v"(v[15]) \
    : "v"(addr) : "memory")
#define TRWAIT(v) asm volatile("s_waitcnt lgkmcnt(0)" : "+v"(v[0]), "+v"(v[1]), "+v"(v[2]), "+v"(v[3]), "+v"(v[4]), "+v"(v[5]), "+v"(v[6]), "+v"(v[7]), "+v"(v[8]), "+v"(v[9]), "+v"(v[10]), "+v"(v[11]), "+v"(v[12]), "+v"(v[13]), "+v"(v[14]), "+v"(v[15]) :: "memory")

template <int MODE>
DI void s_tile(LAS unsigned char* lds, unsigned kaddr, unsigned faddr, const bf16x8 (&qf)[4], f32x16& s0, f32x16& s1) {
    if (MODE == 0) {
#pragma unroll
        for (int g = 0; g < 4; ++g) { const f32x4 f0 = *(const LAS f32x4*)(lds + faddr + 16 * g), f1 = *(const LAS f32x4*)(lds + faddr + 64 + 16 * g);
#pragma unroll
            for (int r = 0; r < 4; ++r) { s0[4 * g + r] = f0[r]; s1[4 * g + r] = f1[r]; } }
    } else {
#pragma unroll
        for (int i = 0; i < 16; ++i) { s0[i] = 0.f; s1[i] = 0.f; }
    }
#pragma unroll
    for (int s = 0; s < 4; ++s) { const bf16x8 k0 = *(const LAS bf16x8*)(lds + kaddr + s * 32), k1 = *(const LAS bf16x8*)(lds + kaddr + 16 * 144 + s * 32);
        s0 = MFMA32(k0, qf[s], s0); s1 = MFMA32(k1, qf[s], s1); }
}
DI void fox_softmax(f32x16& s0, f32x16& s1, f32x16& o0, f32x16& o1, float& m_run, float& l_run, bool domask, int kpos0, int qpos) {
    if (domask) {
#pragma unroll
        for (int i = 0; i < 16; ++i) { if (kpos0 + i > qpos) s0[i] = -INFINITY; if (kpos0 + 16 + i > qpos) s1[i] = -INFINITY; }
    }
    float tmax = fmaxf(s0[0], s1[0]);
#pragma unroll
    for (int i = 1; i < 16; ++i) tmax = max3f(tmax, s0[i], s1[i]);
    tmax = fmaxf(tmax, __shfl_xor(tmax, 32));
    const float m_new = fmaxf(m_run, tmax);
    if (__builtin_amdgcn_ballot_w64(m_new - m_run > 8.0f) != 0ull) {
        const float alpha = __builtin_amdgcn_exp2f(m_run - m_new);
        m_run = m_new; l_run *= alpha;
#pragma unroll
        for (int i = 0; i < 16; ++i) { o0[i] *= alpha; o1[i] *= alpha; }
    }
    float ls = 0.f;
#pragma unroll
    for (int i = 0; i < 16; ++i) { const float p0 = __builtin_amdgcn_exp2f(s0[i] - m_run), p1 = __builtin_amdgcn_exp2f(s1[i] - m_run); s0[i] = p0; s1[i] = p1; ls += p0 + p1; }
    l_run += ls;
}
DI void sb_weights(f32x16& s0, f32x16& s1, float& R, bool domask, int kpos0, int qpos, int hh) {
#pragma unroll
    for (int i = 0; i < 16; ++i) { s0[i] = __builtin_amdgcn_rcpf(1.0f + __builtin_amdgcn_exp2f(s0[i])); s1[i] = __builtin_amdgcn_rcpf(1.0f + __builtin_amdgcn_exp2f(s1[i])); }
    if (domask) {
#pragma unroll
        for (int i = 0; i < 16; ++i) { if (kpos0 + i >= qpos) s0[i] = 1.0f; if (kpos0 + 16 + i >= qpos) s1[i] = 1.0f; }
    }
    float c = 1.0f;
#pragma unroll
    for (int i = 15; i >= 0; --i) { const float cn = c * s1[i]; s1[i] = c - cn; c = cn; }
#pragma unroll
    for (int i = 15; i >= 0; --i) { const float cn = c * s0[i]; s0[i] = c - cn; c = cn; }
    const float cp = __shfl_xor(c, 32);
    const float scale = hh == 0 ? R * cp : R;
#pragma unroll
    for (int i = 0; i < 16; ++i) { s0[i] *= scale; s1[i] *= scale; }
    R = R * (c * cp);
}
DI void pv_tile(const s16x4 (&v)[16], const f32x16& s0, const f32x16& s1, f32x16& o0, f32x16& o1) {
    bf16x8 pf;
    pf = pack8(s0, 0); o0 = MFMA32(__builtin_shufflevector(v[0], v[2], 0, 1, 2, 3, 4, 5, 6, 7), pf, o0); o1 = MFMA32(__builtin_shufflevector(v[1], v[3], 0, 1, 2, 3, 4, 5, 6, 7), pf, o1);
    pf = pack8(s0, 8); o0 = MFMA32(__builtin_shufflevector(v[4], v[6], 0, 1, 2, 3, 4, 5, 6, 7), pf, o0); o1 = MFMA32(__builtin_shufflevector(v[5], v[7], 0, 1, 2, 3, 4, 5, 6, 7), pf, o1);
    pf = pack8(s1, 0); o0 = MFMA32(__builtin_shufflevector(v[8], v[10], 0, 1, 2, 3, 4, 5, 6, 7), pf, o0); o1 = MFMA32(__builtin_shufflevector(v[9], v[11], 0, 1, 2, 3, 4, 5, 6, 7), pf, o1);
    pf = pack8(s1, 8); o0 = MFMA32(__builtin_shufflevector(v[12], v[14], 0, 1, 2, 3, 4, 5, 6, 7), pf, o0); o1 = MFMA32(__builtin_shufflevector(v[13], v[15], 0, 1, 2, 3, 4, 5, 6, 7), pf, o1);
}
DI void attn_store(bf16_t* op, const f32x16& o0, const f32x16& o1) {
#pragma unroll
    for (int g = 0; g < 4; ++g) { u32x2 w0, w1; w0.x = cvtpk(o0[4 * g], o0[4 * g + 1]); w0.y = cvtpk(o0[4 * g + 2], o0[4 * g + 3]); w1.x = cvtpk(o1[4 * g], o1[4 * g + 1]); w1.y = cvtpk(o1[4 * g + 2], o1[4 * g + 3]);
        *(u32x2*)(op + 8 * g) = w0; *(u32x2*)(op + 32 + 8 * g) = w1; }
}

template <int MODE, bool DIAG>
DI void prompt_iter(LAS unsigned char* lds, unsigned ldsb, int t, int jt_w, int qpos, int hh, const bf16x8 (&qf)[4], unsigned kofs, unsigned fofs, unsigned vofs,
                    f32x16& c0, f32x16& c1, f32x16& n0, f32x16& n1, f32x16& o0, f32x16& o1, float& m_run, float& l_run, float& R) {
    if (t >= 1 && (!DIAG || t - 1 <= jt_w)) { const unsigned bo = ((t - 1) % 3) * ABUF; s_tile<MODE>(lds, bo + kofs, bo + fofs, qf, n0, n1); }
    if (!DIAG || t <= jt_w) {
        s16x4 v[16];
        const unsigned va = ldsb + (t % 3) * ABUF + vofs;
        TR16(v, va);
        const bool domask = DIAG && (t == jt_w);
        if (MODE == 0) fox_softmax(c0, c1, o0, o1, m_run, l_run, domask, 64 * t + 32 * hh, qpos);
        else sb_weights(c0, c1, R, domask, 64 * t + 32 * hh, qpos, hh);
        TRWAIT(v);
        pv_tile(v, c0, c1, o0, o1);
    }
}
template <int MODE, int H>
DI void attn_prompt(const Params& p, LAS unsigned char* lds, int b, int head, int qb) {
    constexpr int PITCH = H * 64;
    const int tid = tid_l(), lane = tid & 63, wave = tid >> 6, l31 = lane & 31, hh = lane >> 5;
    const int row = tid >> 3, ch = tid & 7;
    const int top = 4 * qb + 3, jt_w = 4 * qb + (wave >> 1), qpos = 256 * qb + 32 * wave + l31, qrow = b * SEQ + qpos;
    bf16x8 qf[4];
    { const bf16_t* qp = p.Q + (size_t)qrow * PITCH + head * 64 + 8 * hh;
#pragma unroll
      for (int s = 0; s < 4; ++s) qf[s] = *(const bf16x8*)(qp + 16 * s); }
    const float* Fh = p.Fp + (size_t)(b * 8 + (MODE == 0 ? head : 0)) * SEQ;
    float fref = 0.f; if (MODE == 0) fref = Fh[256 * qb];
    f32x16 o0, o1;
#pragma unroll
    for (int i = 0; i < 16; ++i) { o0[i] = 0.f; o1[i] = 0.f; }
    float m_run = -INFINITY, l_run = 0.f, R = 1.0f;
    u32x4 kA, vA, kB, vB; float fA = 0.f, fB = 0.f;
    const bf16_t* kg = p.Kp + (size_t)(b * SEQ + row) * PITCH + head * 64 + ch * 8;
    const bf16_t* vg = p.Vp + (size_t)(b * SEQ + row) * PITCH + head * 64 + ch * 8;
#define PL_LOAD(JT, KR, VR, FR) do { const int jt_ = (JT); KR = *(const u32x4*)(kg + (size_t)jt_ * 64 * PITCH); VR = *(const u32x4*)(vg + (size_t)jt_ * 64 * PITCH); \
        if (MODE == 0 && tid < 64) FR = (fref - Fh[64 * jt_ + tid]) * LOG2E; } while (0)
#define PL_STORE(JT, KR, VR, FR) do { const unsigned bo_ = (unsigned)(((JT) % 3) * ABUF); *(LAS u32x4*)(lds + bo_ + row * 144 + ch * 16) = KR; *(LAS u32x4*)(lds + bo_ + AKS + row * 144 + ch * 16) = VR; \
        if (MODE == 0 && tid < 64) *(LAS float*)(lds + bo_ + 2 * AKS + tid * 4) = FR; } while (0)
#define PL_STAGE(T, KR, VR, FR) do { if ((T) >= 2) PL_STORE((T) - 2, KR, VR, FR); if ((T) >= 4) PL_LOAD((T) - 4, KR, VR, FR); } while (0)
    const unsigned ldsb = (unsigned)(uintptr_t)lds;
    const unsigned krow = 32 * ((l31 >> 2) & 1) + 4 * (l31 >> 3) + (l31 & 3);
    const unsigned kofs = krow * 144 + hh * 16, fofs = 2 * AKS + hh * 128;
    const unsigned vofs = AKS + (32 * hh + ((lane & 15) >> 2)) * 144 + 32 * ((lane >> 4) & 1) + 8 * (lane & 3);
    __syncthreads();
    PL_LOAD(top, kA, vA, fA); PL_LOAD(top - 1, kB, vB, fB);
    PL_STORE(top, kA, vA, fA); PL_STORE(top - 1, kB, vB, fB);
    PL_LOAD(top - 2, kA, vA, fA); PL_LOAD(top - 3, kB, vB, fB);
    __syncthreads();
    f32x16 sa0, sa1, sb0, sb1;
#pragma unroll
    for (int i = 0; i < 16; ++i) { sa0[i] = 0.f; sa1[i] = 0.f; sb0[i] = 0.f; sb1[i] = 0.f; }
    if (top <= jt_w) s_tile<MODE>(lds, (top % 3) * ABUF + kofs, (top % 3) * ABUF + fofs, qf, sa0, sa1);
    for (int t = top; t >= 4 * qb; t -= 2) {
        PL_STAGE(t, kA, vA, fA);
        prompt_iter<MODE, true>(lds, ldsb, t, jt_w, qpos, hh, qf, kofs, fofs, vofs, sa0, sa1, sb0, sb1, o0, o1, m_run, l_run, R);
        __syncthreads();
        PL_STAGE(t - 1, kB, vB, fB);
        prompt_iter<MODE, true>(lds, ldsb, t - 1, jt_w, qpos, hh, qf, kofs, fofs, vofs, sb0, sb1, sa0, sa1, o0, o1, m_run, l_run, R);
        __syncthreads();
    }
    for (int t = 4 * qb - 1; t >= 1; t -= 2) {
        PL_STAGE(t, kA, vA, fA);
        prompt_iter<MODE, false>(lds, ldsb, t, jt_w, qpos, hh, qf, kofs, fofs, vofs, sa0, sa1, sb0, sb1, o0, o1, m_run, l_run, R);
        __syncthreads();
        PL_STAGE(t - 1, kB, vB, fB);
        prompt_iter<MODE, false>(lds, ldsb, t - 1, jt_w, qpos, hh, qf, kofs, fofs, vofs, sb0, sb1, sa0, sa1, o0, o1, m_run, l_run, R);
        __syncthreads();
    }
#undef PL_LOAD
#undef PL_STORE
#undef PL_STAGE
    if (MODE == 0) { const float lt = l_run + __shfl_xor(l_run, 32); const float inv = 1.0f / lt;
#pragma unroll
        for (int i = 0; i < 16; ++i) { o0[i] *= inv; o1[i] *= inv; } }
    attn_store(p.CAT + (size_t)qrow * 1024 + head * 64 + 4 * hh, o0, o1);
}

template <int MODE, int H>
DI void attn_sample(const Params& p, LAS unsigned char* lds, int b, int ub) {
    constexpr int SBUF = 4 * AKS;
    const int tid = tid_l(), lane = tid & 63, wave = tid >> 6, l31 = lane & 31, hh = lane >> 5;
    const int row = tid >> 3, ch = tid & 7;
    const int slot = wave & 3, head = 4 * ub + slot, qpos = PAST + (lane & 15), qrow = TP + 16 * b + (lane & 15);
    const bool active = wave < 4;
    const float* cK = MODE == 0 ? p.cfk : p.csk; const float* cV = MODE == 0 ? p.cfv : p.csv;
    const float* nK = MODE == 0 ? p.fk_s : p.sk_s; const float* nV = MODE == 0 ? p.fv_s : p.sv_s;
    bf16x8 qf[4];
    { const bf16_t* qp = p.Q + (size_t)qrow * (H * 64) + head * 64 + 8 * hh;
#pragma unroll
      for (int s = 0; s < 4; ++s) qf[s] = *(const bf16x8*)(qp + 16 * s); }
    const float* Fl = p.Fs + (size_t)(b * 8 + (MODE == 0 ? 4 * ub + (tid >> 6) : 0)) * LPAD;
    float fref = 0.f; if (MODE == 0 && tid < 256) fref = Fl[PAST];
    f32x16 o0, o1;
#pragma unroll
    for (int i = 0; i < 16; ++i) { o0[i] = 0.f; o1[i] = 0.f; }
    float m_run = -INFINITY, l_run = 0.f, R = 1.0f;
    float freg = 0.f; f32x4 kr[4][2], vr[4][2];
#define SL_LOAD(JT) do { const int jt_ = (JT); \
        _Pragma("unroll") for (int i = 0; i < 4; ++i) { const int hd = 4 * ub + i; \
            if (jt_ < 64) { const size_t off = ((size_t)(b * PAST + 64 * jt_ + row) * H + hd) * 64 + 8 * ch; \
                kr[i][0] = *(const f32x4*)(cK + off); kr[i][1] = *(const f32x4*)(cK + off + 4); vr[i][0] = *(const f32x4*)(cV + off); vr[i][1] = *(const f32x4*)(cV + off + 4); } \
            else if (row < 16) { const size_t off = ((size_t)(b * 16 + row) * H + hd) * 64 + 8 * ch; \
                kr[i][0] = *(const f32x4*)(nK + off); kr[i][1] = *(const f32x4*)(nK + off + 4); vr[i][0] = *(const f32x4*)(nV + off); vr[i][1] = *(const f32x4*)(nV + off + 4); } \
            else { kr[i][0] = (f32x4){0.f, 0.f, 0.f, 0.f}; kr[i][1] = kr[i][0]; vr[i][0] = kr[i][0]; vr[i][1] = kr[i][0]; } } \
        if (MODE == 0 && tid < 256) freg = (fref - Fl[64 * jt_ + (tid & 63)]) * LOG2E; } while (0)
#define SL_STORE() do { \
        _Pragma("unroll") for (int i = 0; i < 4; ++i) { u32x4 kk, vv; \
            kk.x = cvtpk(kr[i][0][0], kr[i][0][1]); kk.y = cvtpk(kr[i][0][2], kr[i][0][3]); kk.z = cvtpk(kr[i][1][0], kr[i][1][1]); kk.w = cvtpk(kr[i][1][2], kr[i][1][3]); \
            vv.x = cvtpk(vr[i][0][0], vr[i][0][1]); vv.y = cvtpk(vr[i][0][2], vr[i][0][3]); vv.z = cvtpk(vr[i][1][0], vr[i][1][1]); vv.w = cvtpk(vr[i][1][2], vr[i][1][3]); \
            *(LAS u32x4*)(lds + i * AKS + row * 144 + ch * 16) = kk; *(LAS u32x4*)(lds + SBUF + i * AKS + row * 144 + ch * 16) = vv; } \
        if (MODE == 0 && tid < 256) *(LAS float*)(lds + 2 * SBUF + tid * 4) = freg; } while (0)
    const unsigned ldsb = (unsigned)(uintptr_t)lds;
    const unsigned krow = 32 * ((l31 >> 2) & 1) + 4 * (l31 >> 3) + (l31 & 3);
    const unsigned kofs = slot * AKS + krow * 144 + hh * 16, fofs = 2 * SBUF + slot * 256 + hh * 128;
    const unsigned va = ldsb + SBUF + slot * AKS + (32 * hh + ((lane & 15) >> 2)) * 144 + 32 * ((lane >> 4) & 1) + 8 * (lane & 3);
    SL_LOAD(64);
    for (int t = 64; t >= 0; --t) {
        __syncthreads();
        SL_STORE();
        __syncthreads();
        if (t > 0) SL_LOAD(t - 1);
        if (active) {
            f32x16 s0, s1; s16x4 v[16];
            s_tile<MODE>(lds, kofs, fofs, qf, s0, s1);
            TR16(v, va);
            const bool domask = (t == 64);
            if (MODE == 0) fox_softmax(s0, s1, o0, o1, m_run, l_run, domask, 64 * t + 32 * hh, qpos);
            else sb_weights(s0, s1, R, domask, 64 * t + 32 * hh, qpos, hh);
            TRWAIT(v);
            pv_tile(v, s0, s1, o0, o1);
        }
    }
#undef SL_LOAD
#undef SL_STORE
    if (MODE == 0) { const float lt = l_run + __shfl_xor(l_run, 32); const float inv = 1.0f / lt;
#pragma unroll
        for (int i = 0; i < 16; ++i) { o0[i] *= inv; o1[i] *= inv; } }
    if (active && l31 < 16) attn_store(p.CAT + (size_t)qrow * 1024 + head * 64 + 4 * hh, o0, o1);
}

template <int MODE, int H>
DI void attn_phase(const Params& p, LAS unsigned char* lds, unsigned* ctr) {
    constexpr int NS = 16 * (H / 4), NPB = 2 * H, TOTAL = NS + NPB * 32;
    volatile LAS int* slotw = (volatile LAS int*)(lds + LDS_RING);
    for (;;) {
        __syncthreads();
        if (threadIdx.x == 0) *slotw = (int)atomicAdd(ctr, 1u);
        __syncthreads();
        int u = *slotw;
        if (u >= TOTAL) break;
        if (u < NS) attn_sample<MODE, H>(p, lds, u / (H / 4), u % (H / 4));
        else { u -= NS; const int qb = 31 - u / NPB, bh = u % NPB; attn_prompt<MODE, H>(p, lds, bh / H, bh % H, qb); }
    }
}

#define XB_TMO      128
#define XB_XCNT(j)  (256  + 64 * (j))
#define XB_XSUB(j)  (1280 + 64 * (j))
#define XB_XGEN(j)  (2304 + 64 * (j))
#define XB_TOP      3328
#define XB_TOPGEN   3392
#define XCD_BAR_WORDS 3456
#define XB_SPIN_CAP (1u << 18)

__device__ __forceinline__ unsigned xb_ld(unsigned* p)              { return __hip_atomic_load(p, __ATOMIC_RELAXED, __HIP_MEMORY_SCOPE_AGENT); }
__device__ __forceinline__ unsigned xb_add(unsigned* p, unsigned v) { return __hip_atomic_fetch_add(p, v, __ATOMIC_RELAXED, __HIP_MEMORY_SCOPE_AGENT); }
__device__ __forceinline__ unsigned xb_xcc_id() { return (unsigned)__builtin_amdgcn_s_getreg((3 << 11) | 20) & 0xFu; }
#define XB_SPIN(cond, bar) do { unsigned _sp = 0; while (cond) { __builtin_amdgcn_s_sleep(1); \
    if ((++_sp & 255u) == 0u) { if (xb_ld(&(bar)[XB_TMO])) break; if (_sp > XB_SPIN_CAP) { atomicAdd(&(bar)[XB_TMO], 1u); break; } } } } while (0)

struct XcdBarrier {
    unsigned* bar; unsigned x;
    volatile LAS unsigned* st;
};

__device__ __forceinline__ XcdBarrier xcd_barrier_post(unsigned* bar, volatile LAS unsigned* st) {
    XcdBarrier b; b.bar = bar; b.x = xb_xcc_id(); b.st = st;
    if (threadIdx.x == 0) (void)xb_add(&bar[XB_XCNT(b.x)], 1u);
    return b;
}
__device__ __forceinline__ void xcd_barrier_complete(unsigned* bar, unsigned x, unsigned& nloc, unsigned& nx) {
    const unsigned G = gridDim.x * gridDim.y * gridDim.z;
    unsigned sum, cnt, mine, sp = 0u;
    for (;;) {
        sum = 0u; cnt = 0u; mine = 0u;
#pragma unroll
        for (unsigned j = 0; j < 16; ++j) { const unsigned c = xb_ld(&bar[XB_XCNT(j)]); sum += c; cnt += (c > 0u) ? 1u : 0u; mine = (j == x) ? c : mine; }
        if (sum == G) break;
        __builtin_amdgcn_s_sleep(1);
        if ((++sp & 255u) == 0u) { if (xb_ld(&bar[XB_TMO])) break; if (sp > XB_SPIN_CAP) { atomicAdd(&bar[XB_TMO], 1u); break; } }
    }
    nloc = mine > 0u ? mine : 1u; nx = cnt > 0u ? cnt : 1u;
}

__device__ __forceinline__ void xcd_barrier(const XcdBarrier& b) {
    asm volatile("s_waitcnt vmcnt(0)" ::: "memory");
    __syncthreads();
    if (threadIdx.x == 0) {
        unsigned* bar = b.bar;
        __builtin_amdgcn_s_waitcnt(0);
        unsigned nloc = b.st[0], nx = b.st[1];
        if (nloc == 0u) { xcd_barrier_complete(bar, b.x, nloc, nx); b.st[0] = nloc; b.st[1] = nx; }
        const unsigned old = xb_add(&bar[XB_XSUB(b.x)], 1u);
        const unsigned gen = old / nloc;
        if (old + 1u == (gen + 1u) * nloc) {
            __builtin_amdgcn_fence(__ATOMIC_RELEASE, "agent");
            asm volatile("s_waitcnt vmcnt(0)" ::: "memory");
            const unsigned og = xb_add(&bar[XB_TOP], 1u);
            const unsigned tg = og / nx;
            if (og + 1u == (tg + 1u) * nx) xb_add(&bar[XB_TOPGEN], 1u);
            else XB_SPIN(xb_ld(&bar[XB_TOPGEN]) == tg, bar);
            __builtin_amdgcn_fence(__ATOMIC_ACQUIRE, "agent");
            xb_add(&bar[XB_XGEN(b.x)], 1u);
            asm volatile("s_waitcnt vmcnt(0)" ::: "memory");
        } else {
            XB_SPIN(xb_ld(&bar[XB_XGEN(b.x)]) == gen, bar);
            __builtin_amdgcn_fence(__ATOMIC_ACQUIRE, "agent");
            asm volatile("s_waitcnt vmcnt(0)" ::: "memory");
        }
    }
    __syncthreads();
}

typedef const __attribute__((address_space(4))) Params* KParams;
#define LOADP(q) Params q; { KParams k_ = (KParams)__builtin_amdgcn_kernarg_segment_ptr(); asm volatile("" : "+s"(k_)); q = *k_; }
__global__ void __launch_bounds__(NTHR, 2) mega(Params p_unused) {
#if defined(__HIP_DEVICE_COMPILE__)
    extern __shared__ __attribute__((aligned(16))) unsigned char lds_raw[];
    LAS unsigned char* lds = (LAS unsigned char*)lds_raw;
    cg::grid_group grid = cg::this_grid();
    if (threadIdx.x < 2) ((volatile LAS unsigned*)(lds + LDS_RING + 16))[threadIdx.x] = 0u;
    __syncthreads();
    XcdBarrier bar;
    { LOADP(p); bar = xcd_barrier_post(p.ctl + 1024, (volatile LAS unsigned*)(lds + LDS_RING + 16)); }
#define GSYNC() xcd_barrier(bar)
    { LOADP(p); phase0(p, lds); } grid.sync();
    { LOADP(p); norm_phase<true>(p, 0, 0, p.x_prompt, p.x_sample); } GSYNC();
    { LOADP(p); EmitQkvAB e{p.Q, p.Kp, p.Vp, p.U, p.fk_p, p.fv_p, p.fk_s, p.fv_s}; gemm_all(lds, p.XN, p.Wab, 2048, 1024, e); } GSYNC();
    { LOADP(p); phase3(p, lds); } GSYNC();
    { LOADP(p); attn_phase<0, 8>(p, lds, p.ctl); } GSYNC();
    { LOADP(p); EmitRes e{p.x_prompt, p.x_sample, p.mod + 2048, p.X}; gemm_all(lds, p.CAT, p.Woab, 1024, 1024, e); } GSYNC();
    { LOADP(p); norm_phase<false>(p, 0, 1, p.X, p.X + (size_t)TP * 1024); } GSYNC();
    { LOADP(p); EmitUp e{p.H}; gemm_all(lds, p.XN, p.Wup, 4096, 1024, e); } GSYNC();
    { LOADP(p); EmitRes e{p.X, p.X + (size_t)TP * 1024, p.mod + 5120, p.X}; gemm_all(lds, p.H, p.Wdn, 1024, 4096, e); } GSYNC();
    { LOADP(p); norm_phase<false>(p, 1, 0, p.X, p.X + (size_t)TP * 1024); } GSYNC();
    { LOADP(p); EmitQkvSB e{p.Q, p.Kp, p.Vp, p.sk_p, p.sv_p, p.sk_s, p.sv_s}; gemm_all(lds, p.XN, p.Wsb, 3072, 1024, e); } GSYNC();
    { LOADP(p); attn_phase<1, 16>(p, lds, p.ctl + 64); } GSYNC();
    { LOADP(p); EmitRes e{p.X, p.X + (size_t)TP * 1024, p.mod + (size_t)NSEQ * 6144 + 2048, p.X}; gemm_all(lds, p.CAT, p.Wosb, 1024, 1024, e); } GSYNC();
    { LOADP(p); norm_phase<false>(p, 1, 1, p.X, p.X + (size_t)TP * 1024); } GSYNC();
    { LOADP(p); EmitUp e{p.H}; gemm_all(lds, p.XN, p.Wup + (size_t)4096 * 1024, 4096, 1024, e); } GSYNC();
    { LOADP(p); EmitRes e{p.X, p.X + (size_t)TP * 1024, p.mod + (size_t)NSEQ * 6144 + 5120, p.X}; gemm_all(lds, p.H, p.Wdn + (size_t)1024 * 4096, 1024, 4096, e); } GSYNC();
    { LOADP(p); final_norm_phase(p); }
#endif
}

extern "C" void kernel_launch(void* const* d_in, const int* in_sizes, int n_in, void* d_out, int out_size, void* d_ws, size_t ws_size, hipStream_t stream) {
    static int grid = 0;
    if (grid == 0) {
        int dev = 0, cus = 0, per_cu = 0;
        hipGetDevice(&dev);
        hipDeviceGetAttribute(&cus, hipDeviceAttributeMultiprocessorCount, dev);
        if (hipFuncSetAttribute((const void*)mega, hipFuncAttributeMaxDynamicSharedMemorySize, LDS_BYTES) != hipSuccess) fprintf(stderr, "kernel_launch: hipFuncSetAttribute failed\n");
        if (hipOccupancyMaxActiveBlocksPerMultiprocessor(&per_cu, (const void*)mega, NTHR, LDS_BYTES) != hipSuccess || per_cu < 1) { fprintf(stderr, "kernel_launch: occupancy query says %d\n", per_cu); per_cu = 1; }
        (void)hipGetLastError();
        if (per_cu > 1) per_cu = 1;
        grid = cus * per_cu;
        if (n_in != 23 || out_size != 68428800 || ws_size < ((size_t)446 << 20)) fprintf(stderr, "kernel_launch: unexpected sizes n_in %d out %d ws %zu\n", n_in, out_size, ws_size);
    }
    const float* const* in = (const float* const*)d_in;
    Params p{};
    p.x_prompt = in[0]; p.x_sample = in[1]; p.c_prompt = in[2]; p.c_sample = in[3]; p.cfk = in[4]; p.cfv = in[5]; p.cfl = in[6]; p.spool = in[7]; p.csk = in[8]; p.csv = in[9];
    p.w_ada = in[10]; p.b_ada = in[11]; p.norm_g = in[12]; p.w_in_ab = in[13]; p.b_forget = in[14]; p.w_pool = in[15]; p.pool_scale = in[16]; p.w_out_ab = in[17];
    p.w_in_sb = in[18]; p.w_out_sb = in[19]; p.w_up = in[20]; p.w_down = in[21]; p.final_g = in[22];
    float* o = (float*)d_out;
    p.y_p = o; p.y_s = o + 16777216; p.fk_p = o + 17039360; p.fv_p = o + 25427968; p.fl_p = o + 33816576; p.pool_p = o + 33947648; p.sk_p = o + 33963008; p.sv_p = o + 50740224;
    p.fk_s = o + 67517440; p.fv_s = o + 67648512; p.fl_s = o + 67779584; p.pool_s = o + 67781632; p.sk_s = o + 67904512; p.sv_s = o + 68166656;
    unsigned char* ws = (unsigned char*)d_ws; const size_t MB = (size_t)1 << 20;
    p.ctl = (unsigned*)ws; p.mod = (float*)(ws + 1 * MB); p.Wf = (float*)(ws + 2 * MB); p.Fp = (float*)(ws + 3 * MB); p.Fs = (float*)(ws + 4 * MB);
    p.Wab = (bf16_t*)(ws + 8 * MB); p.Woab = (bf16_t*)(ws + 12 * MB); p.Wsb = (bf16_t*)(ws + 14 * MB); p.Wosb = (bf16_t*)(ws + 20 * MB); p.Wup = (bf16_t*)(ws + 22 * MB); p.Wdn = (bf16_t*)(ws + 38 * MB);
    p.XN = (bf16_t*)(ws + 54 * MB); p.X = (float*)(ws + 87 * MB); p.Q = (bf16_t*)(ws + 152 * MB); p.Kp = (bf16_t*)(ws + 185 * MB); p.Vp = (bf16_t*)(ws + 217 * MB);
    p.U = (float*)(ws + 249 * MB); p.CAT = (bf16_t*)(ws + 282 * MB); p.H = (bf16_t*)(ws + 315 * MB);
    (void)hipMemsetAsync(ws, 0, 32768, stream);
    void* args[] = {&p};
    hipError_t e = hipLaunchCooperativeKernel((const void*)mega, dim3(grid), dim3(NTHR), args, LDS_BYTES, stream);
    if (e != hipSuccess) fprintf(stderr, "kernel_launch: cooperative launch failed: %s (grid %d)\n", hipGetErrorString(e), grid);
}
```

```cpp
#include <hip/hip_runtime.h>
#include <hip/hip_cooperative_groups.h>
#include <cstdio>
#include <cstdint>
namespace cg = cooperative_groups;
__device__ __forceinline__ int tid_l() { int t = threadIdx.x; asm volatile("" : "+v"(t)); return t; }
namespace pg8 {
#define PG8_LAS __attribute__((address_space(3)))
typedef unsigned short bf16_t;
typedef short bf16x8 __attribute__((ext_vector_type(8)));
typedef float f32x4 __attribute__((ext_vector_type(4)));
typedef unsigned u32x4 __attribute__((ext_vector_type(4)));
constexpr int BM = 256, BK = 64, HALF = 128, HTB = HALF * BK * 2  , STAGE_BYTES = 8 * HTB, NXCD = 8, WGM = 8;

__host__ __device__ __forceinline__ int lds_byte(int r, int c) { const int st = (r >> 4) * 2 + (c >> 5), rr = r & 15, cc = c & 31, ob = rr * 64 + cc * 2; return st * 1024 + (ob ^ (((ob >> 9) & 1) << 5)); }
__host__ __device__ __forceinline__ void stage_rc(int b, int& R, int& C) { const int st = b / 1024, sb = b % 1024, swz = sb ^ (((sb >> 9) & 1) << 5); R = (st >> 1) * 16 + swz / 64; C = (st & 1) * 32 + (swz % 64) / 2; }
__host__ __device__ __forceinline__ int perm32(int rho) { const int n = rho >> 4, i = rho & 15; return 8 * (i >> 2) + 4 * n + (i & 3); }

struct Unit { int pm, pn; };
struct Gemm { const bf16_t* A; const bf16_t* Bt; int M, N, K; };

struct StaticOrder {
    int nM, nN, nwg, G, c;
    __host__ __device__ void init(int M, int N, int G_, int c_) { nM = M / BM; nN = N / BM; nwg = nM * nN; G = G_; c = c_; }
    __host__ __device__ bool next(int i, Unit& u) const {
        const long L = (long)i * G + c; if (L >= nwg) return false;
        int wgid = (int)L; { const int q = nwg / NXCD, r = nwg % NXCD, xcd = wgid % NXCD, off = wgid / NXCD; wgid = (xcd < r ? xcd * (q + 1) : r * (q + 1) + (xcd - r) * q) + off; }
        const int nig = WGM * nN, gid = wgid / nig, fm = gid * WGM, gsz = (nM - fm) < WGM ? (nM - fm) : WGM;
        u.pm = fm + ((wgid % nig) % gsz); u.pn = (wgid % nig) / gsz; return true;
    }
    __device__ __forceinline__ void a_ready(const Unit&) const {}
    __device__ __forceinline__ void done(const Unit&) const {}
};

__device__ __forceinline__ unsigned cvt_pk_bf16(float lo, float hi) { unsigned r; asm volatile("v_cvt_pk_bf16_f32 %0, %1, %2" : "=v"(r) : "v"(lo), "v"(hi)); return r; }
template <class Epi, class Sched, bool ALIGN_EPI = false, bool SP2 = false>
__device__ __forceinline__ void gemm_phase(PG8_LAS unsigned char* lds, const Gemm g, const Sched& S, const Epi& E) {
    const int tid = tid_l(), wid = __builtin_amdgcn_readfirstlane(tid >> 6), lane = tid & 63, wr = wid >> 2, wc = wid & 3, fr = lane & 15, fq = lane >> 4;
    const int K = g.K, nt = K / BK;
    unsigned voffA[2], voffB[2];
#pragma unroll
    for (int i = 0; i < 2; ++i) { int R, C; stage_rc(tid * 16 + i * 8192, R, C); const int Rb = Epi::PERM ? ((R & ~31) + perm32(R & 31)) : R;
        voffA[i] = (unsigned)(R * K + C) * 2u; voffB[i] = (unsigned)(Rb * K + C) * 2u; }
    const size_t kstep = (size_t)(BK * 2);
    const size_t hstep = (size_t)HALF * K * 2;
    const size_t tstep = 2 * hstep;
    const unsigned ldsw = (unsigned)wid * 1024u;
    const int aoff = lds_byte(wr * 64 + fr, fq * 8), boff = lds_byte(wc * 32 + fr, fq * 8);
#define PG8_SA(b, h) (((b) * 2 + (h)) * HTB)
#define PG8_SB(b, h) ((4 + (b) * 2 + (h)) * HTB)
#define PG8_STAGE(bufoff, gbase, voff) do { _Pragma("unroll") for (int _i = 0; _i < 2; ++_i) \
        __builtin_amdgcn_global_load_lds((const unsigned*)((const char*)(gbase) + (voff)[_i]), (PG8_LAS unsigned*)(lds + (bufoff) + ldsw + _i * 8192), 16, 0, 0); } while (0)
#define PG8_LDA(dst, b, h) do { _Pragma("unroll") for (int m = 0; m < 4; ++m) _Pragma("unroll") for (int k = 0; k < 2; ++k) dst[m][k] = *(const PG8_LAS bf16x8*)(lds + PG8_SA(b, h) + aoff + m * 2048 + k * 1024); } while (0)
#define PG8_LDB(dst, b, h) do { _Pragma("unroll") for (int n = 0; n < 2; ++n) _Pragma("unroll") for (int k = 0; k < 2; ++k) dst[n][k] = *(const PG8_LAS bf16x8*)(lds + PG8_SB(b, h) + boff + n * 2048 + k * 1024); } while (0)
#define PG8_MMA(ai, bj, At, Bt) do { __builtin_amdgcn_s_setprio(1); _Pragma("unroll") for (int m = 0; m < 4; ++m) _Pragma("unroll") for (int n = 0; n < 2; ++n) _Pragma("unroll") for (int k = 0; k < 2; ++k) \
        acc[ai][bj][m][n] = __builtin_amdgcn_mfma_f32_16x16x32_bf16(Bt[n][k], At[m][k], acc[ai][bj][m][n], 0, 0, 0); __builtin_amdgcn_s_setprio(0); } while (0)
#define PG8_WAIT_V(n) asm volatile("s_waitcnt vmcnt(" #n ")" ::: "memory")
#define PG8_WAIT_L(n) asm volatile("s_waitcnt lgkmcnt(" #n ")" ::: "memory")
#define PG8_BAR __builtin_amdgcn_s_barrier()
#define PG8_SCHED __builtin_amdgcn_sched_barrier(0)
    Unit cur, nxt; int ui = 0;
    if (!S.next(0, cur)) return;
    f32x4 acc[2][2][4][2];
#pragma unroll
    for (int a = 0; a < 2; ++a)
#pragma unroll
        for (int b = 0; b < 2; ++b)
#pragma unroll
            for (int m = 0; m < 4; ++m)
#pragma unroll
                for (int n = 0; n < 2; ++n) acc[a][b][m][n] = (f32x4){0.f, 0.f, 0.f, 0.f};
    bf16x8 At[4][2], B0[2][2], B1[2][2];
    const char* cA = (const char*)g.A + (size_t)cur.pm * tstep; const char* cB = (const char*)g.Bt + (size_t)cur.pn * tstep;
    S.a_ready(cur);
    if constexpr (SP2) {
        PG8_STAGE(PG8_SB(0, 0), cB, voffB); PG8_STAGE(PG8_SB(0, 1), cB + hstep, voffB); PG8_STAGE(PG8_SA(0, 0), cA, voffA); PG8_STAGE(PG8_SA(0, 1), cA + hstep, voffA);
        if (wr == 1) PG8_BAR;
        PG8_WAIT_V(2); PG8_BAR;
        PG8_STAGE(PG8_SB(1, 0), cB + kstep, voffB); PG8_STAGE(PG8_SA(1, 0), cA + kstep, voffA); PG8_STAGE(PG8_SB(1, 1), cB + hstep + kstep, voffB);
        PG8_WAIT_V(6); PG8_BAR;
    } else {
        PG8_STAGE(PG8_SB(0, 0), cB, voffB); PG8_STAGE(PG8_SA(0, 0), cA, voffA); PG8_STAGE(PG8_SB(0, 1), cB + hstep, voffB); PG8_STAGE(PG8_SA(0, 1), cA + hstep, voffA);
        if (wr == 1) PG8_BAR;
        PG8_WAIT_V(4); PG8_BAR;
        PG8_STAGE(PG8_SB(1, 0), cB + kstep, voffB); PG8_STAGE(PG8_SA(1, 0), cA + kstep, voffA); PG8_STAGE(PG8_SB(1, 1), cB + hstep + kstep, voffB);
        PG8_WAIT_V(6); PG8_BAR;
    }
    for (;;) {
        const bool has_next = S.next(ui + 1, nxt);
        const char* nA = has_next ? (const char*)g.A + (size_t)nxt.pm * tstep : cA; const char* nB = has_next ? (const char*)g.Bt + (size_t)nxt.pn * tstep : cB;
        for (int t = 0; t < nt; t += 2) {
            const bool last = (t == nt - 2);
            const char* a1 = cA + (size_t)(t + 1) * kstep;
            const char* a2 = last ? nA : cA + (size_t)(t + 2) * kstep; const char* b2 = last ? nB : cB + (size_t)(t + 2) * kstep;
            const char* a3 = a2 + kstep; const char* b3 = b2 + kstep;
            if (last && has_next) S.a_ready(nxt);
            if constexpr (SP2) {
            PG8_LDB(B0, 0, 0); PG8_LDB(B1, 0, 1); PG8_SCHED; PG8_LDA(At, 0, 0); PG8_STAGE(PG8_SA(1, 1), a1 + hstep, voffA);
            PG8_WAIT_V(8); PG8_WAIT_L(0); PG8_BAR; PG8_MMA(0, 0, At, B0); PG8_MMA(0, 1, At, B1); PG8_BAR; PG8_SCHED;
            PG8_LDA(At, 0, 1); PG8_STAGE(PG8_SB(0, 0), b2, voffB); PG8_STAGE(PG8_SB(0, 1), b2 + hstep, voffB); PG8_STAGE(PG8_SA(0, 0), a2, voffA);
            PG8_WAIT_V(8); PG8_WAIT_L(0); PG8_BAR; PG8_MMA(1, 0, At, B0); PG8_MMA(1, 1, At, B1); PG8_BAR; PG8_SCHED;
            PG8_LDB(B0, 1, 0); PG8_LDB(B1, 1, 1); PG8_SCHED; PG8_LDA(At, 1, 0); PG8_STAGE(PG8_SA(0, 1), a2 + hstep, voffA);
            PG8_WAIT_V(8); PG8_WAIT_L(0); PG8_BAR; PG8_MMA(0, 0, At, B0); PG8_MMA(0, 1, At, B1); PG8_BAR; PG8_SCHED;
            PG8_LDA(At, 1, 1); PG8_STAGE(PG8_SB(1, 0), b3, voffB); PG8_STAGE(PG8_SB(1, 1), b3 + hstep, voffB); PG8_STAGE(PG8_SA(1, 0), a3, voffA);
            PG8_WAIT_V(8); PG8_WAIT_L(0); PG8_BAR; PG8_MMA(1, 0, At, B0); PG8_MMA(1, 1, At, B1); PG8_BAR; PG8_SCHED;
            } else {
            PG8_LDB(B0, 0, 0); PG8_SCHED; PG8_LDA(At, 0, 0); PG8_STAGE(PG8_SA(1, 1), a1 + hstep, voffA);
            PG8_WAIT_L(8); PG8_BAR; PG8_WAIT_L(0); PG8_MMA(0, 0, At, B0); PG8_BAR; PG8_SCHED;
            PG8_LDB(B1, 0, 1); PG8_STAGE(PG8_SB(0, 0), b2, voffB);
            PG8_BAR; PG8_WAIT_L(0); PG8_MMA(0, 1, At, B1); PG8_BAR;
            PG8_LDA(At, 0, 1); PG8_STAGE(PG8_SA(0, 0), a2, voffA);
            PG8_BAR; PG8_WAIT_L(0); PG8_MMA(1, 0, At, B0); PG8_BAR; PG8_SCHED;
            PG8_STAGE(PG8_SB(0, 1), b2 + hstep, voffB);
            PG8_WAIT_V(6); PG8_BAR; PG8_MMA(1, 1, At, B1); PG8_BAR;
            PG8_LDB(B0, 1, 0); PG8_SCHED; PG8_LDA(At, 1, 0); PG8_STAGE(PG8_SA(0, 1), a2 + hstep, voffA);
            PG8_WAIT_L(8); PG8_BAR; PG8_WAIT_L(0); PG8_MMA(0, 0, At, B0); PG8_BAR; PG8_SCHED;
            PG8_LDB(B1, 1, 1); PG8_STAGE(PG8_SB(1, 0), b3, voffB);
            PG8_BAR; PG8_WAIT_L(0); PG8_MMA(0, 1, At, B1); PG8_BAR;
            PG8_LDA(At, 1, 1); PG8_STAGE(PG8_SA(1, 0), a3, voffA);
            PG8_BAR; PG8_WAIT_L(0); PG8_MMA(1, 0, At, B0); PG8_BAR; PG8_SCHED;
            PG8_STAGE(PG8_SB(1, 1), b3 + hstep, voffB);
            PG8_WAIT_V(6); PG8_BAR; PG8_MMA(1, 1, At, B1); PG8_BAR;
            }
        }
        if constexpr (ALIGN_EPI) { if (wr == 0) PG8_BAR; }
        if constexpr (!Epi::AFTER_DRAIN) { E(acc, cur, wr, wc, fr, fq); S.done(cur); }
        if (!has_next) break;
#pragma unroll
        for (int a = 0; a < 2; ++a)
#pragma unroll
            for (int b = 0; b < 2; ++b)
#pragma unroll
                for (int m = 0; m < 4; ++m)
#pragma unroll
                    for (int n = 0; n < 2; ++n) acc[a][b][m][n] = (f32x4){0.f, 0.f, 0.f, 0.f};
        cur = nxt; cA = nA; cB = nB; ++ui;
        if constexpr (ALIGN_EPI) { if (wr == 1) PG8_BAR; }
    }
    PG8_WAIT_V(0);
    if constexpr (!ALIGN_EPI) { if (wr == 0) PG8_BAR; }
    PG8_BAR;
    if constexpr (Epi::AFTER_DRAIN) { E.fused(acc, cur, wr, wc, fr, fq, lds, wid, lane); S.done(cur); }
#undef PG8_SA
#undef PG8_SB
#undef PG8_STAGE
#undef PG8_LDA
#undef PG8_LDB
#undef PG8_MMA
#undef PG8_WAIT_V
#undef PG8_WAIT_L
#undef PG8_BAR
#undef PG8_SCHED
}
}

#define LAS __attribute__((address_space(3)))
typedef unsigned short bf16_t;
typedef short bf16x8 __attribute__((ext_vector_type(8)));
typedef short s16x4 __attribute__((ext_vector_type(4)));
typedef float f32x4 __attribute__((ext_vector_type(4)));
typedef float f32x16 __attribute__((ext_vector_type(16)));
typedef unsigned u32x4 __attribute__((ext_vector_type(4)));
typedef unsigned u32x2 __attribute__((ext_vector_type(2)));
typedef float f32x2_t __attribute__((ext_vector_type(2)));
typedef __bf16 bf16x2_t __attribute__((ext_vector_type(2)));

constexpr int TP = 16384, TS = 256, TT = TP + TS, DM = 1024, DFF = 4096;
constexpr int SEQ = 8192, PAST = 4096, LPAD = 4160, NSEQ = 18;
constexpr float LOG2E = 1.4426950408889634f;
constexpr int NTHR = 512, NWV = 8;
constexpr int LDS_RING = 131072, LDS_BYTES = LDS_RING + 1024;

struct Params {
    const float *x_prompt, *x_sample, *c_prompt, *c_sample, *cfk, *cfv, *cfl, *spool, *csk, *csv;
    const float *w_ada, *b_ada, *norm_g, *w_in_ab, *b_forget, *w_pool, *pool_scale, *w_out_ab, *w_in_sb, *w_out_sb, *w_up, *w_down, *final_g;
    float *y_p, *y_s, *fk_p, *fv_p, *fl_p, *pool_p, *sk_p, *sv_p, *fk_s, *fv_s, *fl_s, *pool_s, *sk_s, *sv_s;
    unsigned* ctl; float *mod, *Wf, *Fp, *Fs;
    bf16_t *Wab, *Woab, *Wsb, *Wosb, *Wup, *Wdn, *XN;
    float* X; bf16_t *Q, *Kp, *Vp; float* U; bf16_t *CAT, *H;
};

#define DI __device__ __forceinline__
DI unsigned cvtpk(float lo, float hi) { f32x2_t v = {lo, hi}; bf16x2_t b = __builtin_convertvector(v, bf16x2_t); return __builtin_bit_cast(unsigned, b); }
DI int seq_of(int t) { return t < TP ? (t >> 13) : 2 + ((t - TP) >> 4); }
DI float wave_sum(float v) {
#pragma unroll
    for (int o = 1; o < 64; o <<= 1) v += __shfl_xor(v, o);
    return v;
}
DI void st_bf4(bf16_t* p, f32x4 v) { u32x2 w; w.x = cvtpk(v[0], v[1]); w.y = cvtpk(v[2], v[3]); *(u32x2*)p = w; }
#define LDS_WAIT() asm volatile("s_waitcnt lgkmcnt(0)" ::: "memory")

DI void tr_item(const float* W, int ldw, int k0, int c0, bf16_t* WT, int ldt, int r0, int kd0, LAS float* scr, int lane) {
#pragma unroll 8
    for (int i = 0; i < 32; ++i) { const int kk = 2 * i + (lane >> 5); scr[kk * 33 + (lane & 31)] = W[(size_t)(k0 + kk) * ldw + c0 + (lane & 31)]; }
    LDS_WAIT();
    const int c = lane & 7;
#pragma unroll
    for (int j = 0; j < 4; ++j) { const int n = (lane >> 3) + 8 * j; const LAS float* s = scr + (8 * c) * 33 + n;
        u32x4 o; o.x = cvtpk(s[0 * 33], s[1 * 33]); o.y = cvtpk(s[2 * 33], s[3 * 33]); o.z = cvtpk(s[4 * 33], s[5 * 33]); o.w = cvtpk(s[6 * 33], s[7 * 33]);
        *(u32x4*)(WT + (size_t)(r0 + n) * ldt + kd0 + 8 * c) = o; }
    LDS_WAIT();
}

DI void phase0(const Params& p, LAS unsigned char* lds) {
    const int tid = tid_l(), lane = tid & 63, wave = tid >> 6;
    if ((int)blockIdx.x < 192) {
        LAS float* cond = (LAS float*)lds;
        LAS float* red = (LAS float*)(lds + 73728);
        for (int i = tid; i < NSEQ * 1024; i += NTHR) { const int s = i >> 10, k = i & 1023; const float c = s < 2 ? p.c_prompt[s * 1024 + k] : p.c_sample[(s - 2) * 1024 + k]; cond[i] = c / (1.0f + expf(-c)); }
        __syncthreads();
        for (int item = blockIdx.x; item < 192; item += gridDim.x) {
            const int layer = item / 96, col0 = (item % 96) * 64, quad = tid & 15, kc = tid >> 4;
            float acc[NSEQ][4];
#pragma unroll
            for (int s = 0; s < NSEQ; ++s) { acc[s][0] = 0.f; acc[s][1] = 0.f; acc[s][2] = 0.f; acc[s][3] = 0.f; }
            const float* wp = p.w_ada + ((size_t)layer * 1024 + kc * 32) * 6144 + col0 + 4 * quad;
#pragma unroll 4
            for (int kk = 0; kk < 32; ++kk) { const f32x4 w = *(const f32x4*)(wp + (size_t)kk * 6144);
#pragma unroll
                for (int s = 0; s < NSEQ; ++s) { const float cs = cond[s * 1024 + kc * 32 + kk]; acc[s][0] += cs * w[0]; acc[s][1] += cs * w[1]; acc[s][2] += cs * w[2]; acc[s][3] += cs * w[3]; } }
#pragma unroll
            for (int s = 0; s < NSEQ; ++s)
#pragma unroll
                for (int j = 0; j < 4; ++j) { float v = acc[s][j]; v += __shfl_xor(v, 16); v += __shfl_xor(v, 32); if (lane < 16) red[((wave * 16 + quad) * NSEQ + s) * 4 + j] = v; }
            __syncthreads();
            for (int o = tid; o < 16 * NSEQ * 4; o += NTHR) { const int qd = o / (NSEQ * 4), rem = o % (NSEQ * 4), s = rem >> 2, j = rem & 3; float sum = 0.f;
#pragma unroll
                for (int w = 0; w < 8; ++w) sum += red[((w * 16 + qd) * NSEQ + s) * 4 + j];
                const int col = col0 + 4 * qd + j; p.mod[((size_t)layer * NSEQ + s) * 6144 + col] = sum + p.b_ada[layer * 6144 + col]; }
            __syncthreads();
        }
    }
    for (int it = (int)gridDim.x - 1 - (int)blockIdx.x; it < 128; it += gridDim.x) {
        const int g = it >> 5, rem = it & 31, cblk = rem >> 1, n = (rem & 1) * 512 + tid;
        LAS float* wps = (LAS float*)lds;
        __syncthreads();
        for (int i = tid; i < 1024; i += NTHR) { const int j = i >> 7, e = i & 127; wps[i] = p.w_pool[((g * 128) + cblk * 8 + j) * 128 + e] * p.pool_scale[128 * g + e]; }
        __syncthreads();
        float acc[8];
#pragma unroll
        for (int j = 0; j < 8; ++j) acc[j] = 0.f;
        const float* wo = p.w_out_ab + (size_t)(512 + 128 * g) * 1024 + n;
#pragma unroll 8
        for (int e = 0; e < 128; ++e) { const float wv = wo[(size_t)e * 1024];
#pragma unroll
            for (int j = 0; j < 8; ++j) acc[j] += wps[j * 128 + e] * wv; }
        u32x4 o; o.x = cvtpk(acc[0], acc[1]); o.y = cvtpk(acc[2], acc[3]); o.z = cvtpk(acc[4], acc[5]); o.w = cvtpk(acc[6], acc[7]);
        *(u32x4*)(p.Woab + (size_t)n * 1024 + 512 + 128 * g + cblk * 8) = o;
    }
    for (int i = blockIdx.x * NTHR + tid; i < 8192; i += gridDim.x * NTHR) { const int h = i >> 10, k = i & 1023; p.Wf[i] = p.w_in_ab[(size_t)k * 2056 + 1536 + h]; }
    __syncthreads();
    LAS float* scr = (LAS float*)(lds + wave * 16384);
    const int gw = blockIdx.x * NWV + wave, NGW = gridDim.x * NWV;
    constexpr int NITEMS = 1024 + 256 + 1536 + 512 + 4096 + 4096;
    for (int it = gw; it < NITEMS; it += NGW) {
        int r = it;
        if (r < 1024) { const int kb = r >> 6, n0 = (r & 63) * 32, c0 = n0 < 1536 ? n0 : n0 + 8; tr_item(p.w_in_ab, 2056, kb * 64, c0, p.Wab, 1024, n0, kb * 64, scr, lane); continue; } r -= 1024;
        if (r < 256) { const int kb = r >> 5, n0 = (r & 31) * 32; tr_item(p.w_out_ab, 1024, kb * 64, n0, p.Woab, 1024, n0, kb * 64, scr, lane); continue; } r -= 256;
        if (r < 1536) { const int kb = r / 96, n0 = (r % 96) * 32; tr_item(p.w_in_sb, 3072, kb * 64, n0, p.Wsb, 1024, n0, kb * 64, scr, lane); continue; } r -= 1536;
        if (r < 512) { const int kb = r >> 5, n0 = (r & 31) * 32; tr_item(p.w_out_sb, 1024, kb * 64, n0, p.Wosb, 1024, n0, kb * 64, scr, lane); continue; } r -= 512;
        if (r < 4096) { const int layer = r >> 11, r2 = r & 2047, kb = r2 >> 7, n0 = (r2 & 127) * 32;
            tr_item(p.w_up + (size_t)layer * 1024 * 4096, 4096, kb * 64, n0, p.Wup + (size_t)layer * 4096 * 1024, 1024, n0, kb * 64, scr, lane); continue; } r -= 4096;
        { const int layer = r >> 11, r2 = r & 2047, kb = r2 >> 5, n0 = (r2 & 31) * 32;
            tr_item(p.w_down + (size_t)layer * 4096 * 1024, 1024, kb * 64, n0, p.Wdn + (size_t)layer * 1024 * 4096, 4096, n0, kb * 64, scr, lane); }
    }
}

template <bool FLOGIT>
DI void norm_phase(const Params& p, int layer, int which, const float* xin_p, const float* xin_s) {
    const int tid = tid_l(), lane = tid & 63, wave = tid >> 6;
    const int gw = blockIdx.x * NWV + wave, NGW = gridDim.x * NWV;
    const float* gptr = p.norm_g + (layer * 2 + which) * 1024;
    for (int t = gw; t < TT; t += NGW) {
        const float* xr = t < TP ? xin_p + (size_t)t * 1024 : xin_s + (size_t)(t - TP) * 1024;
        const float* md = p.mod + ((size_t)layer * NSEQ + seq_of(t)) * 6144 + (which ? 3072 : 0);
        f32x4 v[4]; float ss = 0.f;
#pragma unroll
        for (int j = 0; j < 4; ++j) { v[j] = *(const f32x4*)(xr + 4 * lane + 256 * j); ss += (v[j][0] * v[j][0] + v[j][1] * v[j][1]) + (v[j][2] * v[j][2] + v[j][3] * v[j][3]); }
        const float rstd = 1.0f / sqrtf(wave_sum(ss) * (1.0f / 1024.0f) + 1e-6f);
        float fd[8];
#pragma unroll
        for (int h = 0; h < 8; ++h) fd[h] = 0.f;
#pragma unroll
        for (int j = 0; j < 4; ++j) { const int col = 4 * lane + 256 * j;
            const f32x4 g = *(const f32x4*)(gptr + col), sh = *(const f32x4*)(md + col), sc = *(const f32x4*)(md + 1024 + col);
            f32x4 y;
#pragma unroll
            for (int e = 0; e < 4; ++e) y[e] = (v[j][e] * rstd * g[e]) * (1.0f + sc[e]) + sh[e];
            st_bf4(p.XN + (size_t)t * 1024 + col, y);
            if (FLOGIT) {
#pragma unroll
                for (int h = 0; h < 8; ++h) { const f32x4 w = *(const f32x4*)(p.Wf + h * 1024 + col); fd[h] += (y[0] * w[0] + y[1] * w[1]) + (y[2] * w[2] + y[3] * w[3]); } }
        }
        if (FLOGIT) {
            float mine = 0.f;
#pragma unroll
            for (int h = 0; h < 8; ++h) { const float s = wave_sum(fd[h]); if (lane == h) mine = s; }
            if (lane < 8) { const float z = mine + p.b_forget[lane]; const float lf = fminf(z, 0.f) - log1pf(expf(-fabsf(z)));
                if (t < TP) p.fl_p[(size_t)t * 8 + lane] = lf; else p.fl_s[(size_t)(t - TP) * 8 + lane] = lf; }
        }
    }
}
DI void final_norm_phase(const Params& p) {
    const int tid = tid_l(), lane = tid & 63, wave = tid >> 6;
    const int gw = blockIdx.x * NWV + wave, NGW = gridDim.x * NWV;
    for (int t = gw; t < TT; t += NGW) {
        const float* xr = p.X + (size_t)t * 1024; float* yr = t < TP ? p.y_p + (size_t)t * 1024 : p.y_s + (size_t)(t - TP) * 1024;
        f32x4 v[4]; float ss = 0.f;
#pragma unroll
        for (int j = 0; j < 4; ++j) { v[j] = *(const f32x4*)(xr + 4 * lane + 256 * j); ss += (v[j][0] * v[j][0] + v[j][1] * v[j][1]) + (v[j][2] * v[j][2] + v[j][3] * v[j][3]); }
        const float rstd = 1.0f / sqrtf(wave_sum(ss) * (1.0f / 1024.0f) + 1e-6f);
#pragma unroll
        for (int j = 0; j < 4; ++j) { const int col = 4 * lane + 256 * j; const f32x4 g = *(const f32x4*)(p.final_g + col); f32x4 y;
#pragma unroll
            for (int e = 0; e < 4; ++e) y[e] = v[j][e] * rstd * g[e];
            *(f32x4*)(yr + col) = y; }
    }
}

struct EmitQkvAB { bf16_t *Q, *Kp, *Vp; float *U, *fk_p, *fv_p, *fk_s, *fv_s;
    DI void emit(int t, int c, f32x4 v) const {
        if (c < 512) { st_bf4(Q + (size_t)t * 512 + c, v * (0.125f * LOG2E)); }
        else if (c < 1024) { const int cc = c - 512; if (t < TP) { st_bf4(Kp + (size_t)t * 512 + cc, v); *(f32x4*)(fk_p + (size_t)t * 512 + cc) = v; } else *(f32x4*)(fk_s + (size_t)(t - TP) * 512 + cc) = v; }
        else if (c < 1536) { const int cc = c - 1024; if (t < TP) { st_bf4(Vp + (size_t)t * 512 + cc, v); *(f32x4*)(fv_p + (size_t)t * 512 + cc) = v; } else *(f32x4*)(fv_s + (size_t)(t - TP) * 512 + cc) = v; }
        else { *(f32x4*)(U + (size_t)t * 512 + (c - 1536)) = v; }
    } };
struct EmitQkvSB { bf16_t *Q, *Kp, *Vp; float *sk_p, *sv_p, *sk_s, *sv_s;
    DI void emit(int t, int c, f32x4 v) const {
        if (c < 1024) { st_bf4(Q + (size_t)t * 1024 + c, v * (0.125f * LOG2E)); }
        else if (c < 2048) { const int cc = c - 1024; if (t < TP) { st_bf4(Kp + (size_t)t * 1024 + cc, v); *(f32x4*)(sk_p + (size_t)t * 1024 + cc) = v; } else *(f32x4*)(sk_s + (size_t)(t - TP) * 1024 + cc) = v; }
        else { const int cc = c - 2048; if (t < TP) { st_bf4(Vp + (size_t)t * 1024 + cc, v); *(f32x4*)(sv_p + (size_t)t * 1024 + cc) = v; } else *(f32x4*)(sv_s + (size_t)(t - TP) * 1024 + cc) = v; }
    } };
struct EmitRes { const float* xin_p; const float* xin_s; const float* modg; float* X;
    DI void emit(int t, int c, f32x4 v) const {
        const float* xr = t < TP ? xin_p + (size_t)t * 1024 : xin_s + (size_t)(t - TP) * 1024;
        const f32x4 x = *(const f32x4*)(xr + c), g = *(const f32x4*)(modg + (size_t)seq_of(t) * 6144 + c);
        *(f32x4*)(X + (size_t)t * 1024 + c) = x + g * v;
    } };
struct EmitUp { bf16_t* H;
    DI void emit(int t, int c, f32x4 v) const { f32x4 r;
#pragma unroll
        for (int e = 0; e < 4; ++e) { const float a = fmaxf(v[e], 0.f); r[e] = a * a; }
        st_bf4(H + (size_t)t * 4096 + c, r); } };

template <class F> struct EpiEmit {
    static constexpr bool PERM = false, AFTER_DRAIN = false;
    F f;
    DI void operator()(const pg8::f32x4 (&acc)[2][2][4][2], const pg8::Unit& u, int wr, int wc, int fr, int fq) const {
        const int row0 = u.pm * 256 + wr * 64 + fr, col0 = u.pn * 256 + wc * 32 + 4 * fq;
#pragma unroll
        for (int ai = 0; ai < 2; ++ai)
#pragma unroll
            for (int m = 0; m < 4; ++m)
#pragma unroll
                for (int bj = 0; bj < 2; ++bj)
#pragma unroll
                    for (int n = 0; n < 2; ++n) f.emit(row0 + ai * 128 + m * 16, col0 + bj * 128 + n * 16, acc[ai][bj][m][n]);
    }
};

template <class F, int KS>
DI void skinny_gemm(LAS unsigned char* lds, const bf16_t* A, const bf16_t* Bt, int N, int K, const F& f) {
    const int tid = tid_l(), lane = tid & 63, wave = tid >> 6, fr = lane & 15, fq = lane >> 4;
    constexpr int WPB = 8 / KS;
    const int wsub = wave % WPB, kh = wave / WPB, Kh = K / KS;
    LAS f32x4* red = (LAS f32x4*)lds;
    for (int item0 = blockIdx.x * WPB; item0 < N; item0 += gridDim.x * WPB) {
        const int item = item0 + wsub, rb = item & 15, cb = item >> 4;
        const bf16_t* ap = A + (size_t)(rb * 16 + fr) * K + kh * Kh + 8 * fq;
        const bf16_t* bp = Bt + (size_t)(cb * 16 + fr) * K + kh * Kh + 8 * fq;
        f32x4 acc = {0.f, 0.f, 0.f, 0.f};
        for (int ks = 0; ks < Kh; ks += 512) {
            bf16x8 a[16], b[16];
#pragma unroll
            for (int i = 0; i < 16; ++i) { a[i] = *(const bf16x8*)(ap + ks + 32 * i); b[i] = *(const bf16x8*)(bp + ks + 32 * i); }
#pragma unroll
            for (int i = 0; i < 16; ++i) acc = __builtin_amdgcn_mfma_f32_16x16x32_bf16(b[i], a[i], acc, 0, 0, 0);
        }
        if (KS == 2) { if (kh == 1) red[wsub * 64 + lane] = acc; __syncthreads(); if (kh == 0) acc = acc + red[wsub * 64 + lane]; }
        if (kh == 0) f.emit(TP + rb * 16 + fr, cb * 16 + 4 * fq, acc);
        if (KS == 2) __syncthreads();
    }
}

template <class F>
DI void gemm_all(LAS unsigned char* lds, const bf16_t* A, const bf16_t* Bt, int N, int K, const F& f) {
    { pg8::Gemm g{A, Bt, TP, N, K}; pg8::StaticOrder S; S.init(TP, N, (int)gridDim.x, (int)blockIdx.x);
      EpiEmit<F> E{f};
      pg8::gemm_phase<EpiEmit<F>, pg8::StaticOrder, true, true>(lds, g, S, E); }
    __syncthreads();
    if (K > 1024) skinny_gemm<F, 2>(lds, A + (size_t)TP * K, Bt, N, K, f); else skinny_gemm<F, 1>(lds, A + (size_t)TP * K, Bt, N, K, f);
}

template <int PER>
DI void scan_item(LAS unsigned char* lds, const float* src_a, int na, const float* src_b, int ntot, int stride, float* dst, int ndst) {
    const int tid = tid_l(), lane = tid & 63, wave = tid >> 6;
    LAS float* wt = (LAS float*)lds;
    float v[PER]; float tot = 0.f;
#pragma unroll
    for (int i = 0; i < PER; ++i) { const int pos = tid * PER + i; float x = 0.f; if (pos < na) x = src_a[(size_t)pos * stride]; else if (pos < ntot) x = src_b[(size_t)(pos - na) * stride]; tot += x; v[i] = tot; }
    float inc = tot;
#pragma unroll
    for (int o = 1; o < 64; o <<= 1) { const float t = __shfl_up(inc, o); if (lane >= o) inc += t; }
    __syncthreads();
    if (lane == 63) wt[wave] = inc;
    __syncthreads();
    float base = 0.f;
#pragma unroll
    for (int w = 0; w < 8; ++w) if (w < wave) base += wt[w];
    const float ex = base + inc - tot;
#pragma unroll
    for (int i = 0; i < PER; ++i) { const int pos = tid * PER + i; if (pos < ntot) dst[pos] = ex + v[i]; else if (pos < ndst) dst[pos] = 0.f; }
}
DI void phase3(const Params& p, LAS unsigned char* lds) {
    const int tid = tid_l();
    for (int it = blockIdx.x; it < 144; it += gridDim.x) {
        if (it < 16) { scan_item<16>(lds, p.fl_p + (size_t)(it >> 3) * SEQ * 8 + (it & 7), SEQ, nullptr, SEQ, 8, p.Fp + (size_t)it * SEQ, SEQ); }
        else { const int bh = it - 16, b = bh >> 3, h = bh & 7;
            scan_item<9>(lds, p.cfl + (size_t)b * PAST * 8 + h, PAST, p.fl_s + (size_t)b * 16 * 8 + h, PAST + 16, 8, p.Fs + (size_t)bh * LPAD, LPAD); }
    }
    for (int i = blockIdx.x * NTHR + tid; i < TT * 128; i += gridDim.x * NTHR) {
        const int t = i >> 7, c = (i & 127) * 4, g = c >> 7, w = 2 << g;
        const f32x4 u = *(const f32x4*)(p.U + (size_t)t * 512 + c);
        f32x4 sum = u; float cnt;
        if (t < TP) { const int pos = t & (SEQ - 1); const int nw = pos + 1 < w ? pos + 1 : w; cnt = (float)nw;
            for (int k = 1; k < nw; ++k) sum += *(const f32x4*)(p.U + (size_t)(t - k) * 512 + c);
            if (pos >= SEQ - 15) *(f32x4*)(p.pool_p + ((size_t)(t >> 13) * 15 + (pos - (SEQ - 15))) * 512 + c) = u;
        } else { const int b = (t - TP) >> 4, loc = (t - TP) & 15; cnt = (float)w;
            for (int k = 1; k < w; ++k) { const int li = loc - k; sum += li >= 0 ? *(const f32x4*)(p.U + (size_t)(t - k) * 512 + c) : *(const f32x4*)(p.spool + ((size_t)b * 15 + 15 + li) * 512 + c); }
            if (loc >= 1) *(f32x4*)(p.pool_s + ((size_t)b * 15 + loc - 1) * 512 + c) = u;
        }
        f32x4 r;
#pragma unroll
        for (int e = 0; e < 4; ++e) r[e] = sum[e] / cnt - u[e];
        st_bf4(p.CAT + (size_t)t * 1024 + 512 + c, r);
    }
}

constexpr int AKS = 9216;
constexpr int ABUF = 2 * AKS + 256;
#define MFMA32(a, b, c) __builtin_amdgcn_mfma_f32_32x32x16_bf16((a), (b), (c), 0, 0, 0)
DI float max3f(float a, float b, float c) { float r; asm("v_max3_f32 %0, %1, %2, %3" : "=v"(r) : "v"(a), "v"(b), "v"(c)); return r; }
DI bf16x8 pack8(const f32x16& s, int base) { u32x4 w; w.x = cvtpk(s[base], s[base + 1]); w.y = cvtpk(s[base + 2], s[base + 3]); w.z = cvtpk(s[base + 4], s[base + 5]); w.w = cvtpk(s[base + 6], s[base + 7]); return __builtin_bit_cast(bf16x8, w); }
#define TR4(O) "ds_read_b64_tr_b16 %" #O ", %16 offset:"
#define TR16(v, addr) asm volatile( \
    "ds_read_b64_tr_b16 %0, %16\n\tds_read_b64_tr_b16 %1, %16 offset:64\n\tds_read_b64_tr_b16 %2, %16 offset:576\n\tds_read_b64_tr_b16 %3, %16 offset:640\n\t" \
    "ds_read_b64_tr_b16 %4, %16 offset:1152\n\tds_read_b64_tr_b16 %5, %16 offset:1216\n\tds_read_b64_tr_b16 %6, %16 offset:1728\n\tds_read_b64_tr_b16 %7, %16 offset:1792\n\t" \
    "ds_read_b64_tr_b16 %8, %16 offset:2304\n\tds_read_b64_tr_b16 %9, %16 offset:2368\n\tds_read_b64_tr_b16 %10, %16 offset:2880\n\tds_read_b64_tr_b16 %11, %16 offset:2944\n\t" \
    "ds_read_b64_tr_b16 %12, %16 offset:3456\n\tds_read_b64_tr_b16 %13, %16 offset:3520\n\tds_read_b64_tr_b16 %14, %16 offset:4032\n\tds_read_b64_tr_b16 %15, %16 offset:4096" \
    : "=&v"(v[0]), "=&v"(v[1]), "=&v"(v[2]), "=&v"(v[3]), "=&v"(v[4]), "=&v"(v[5]), "=&v"(v[6]), "=&v"(v[7]), "=&v"(v[8]), "=&v"(v[9]), "=&v"(v[10]), "=&v"(v[11]), "=&v"(v[12]), "=&v"(v[13]), "=&v"(v[14]), "=&v"(v[15]) \
    : "v"(addr) : "memory")
#define TRWAIT(v) asm volatile("s_waitcnt lgkmcnt(0)" : "+v"(v[0]), "+v"(v[1]), "+v"(v[2]), "+v"(v[3]), "+v"(v[4]), "+v"(v[5]), "+v"(v[6]), "+v"(v[7]), "+v"(v[8]), "+v"(v[9]), "+v"(v[10]), "+v"(v[11]), "+v"(v[12]), "+v"(v[13]), "+v"(v[14]), "+v"(v[15]) :: "memory")

template <int MODE>
DI void s_tile(LAS unsigned char* lds, unsigned kaddr, unsigned faddr, const bf16x8 (&qf)[4], f32x16& s0, f32x16& s1) {
    if (MODE == 0) {
#pragma unroll
        for (int g = 0; g < 4; ++g) { const f32x4 f0 = *(const LAS f32x4*)(lds + faddr + 16 * g), f1 = *(const LAS f32x4*)(lds + faddr + 64 + 16 * g);
#pragma unroll
            for (int r = 0; r < 4; ++r) { s0[4 * g + r] = f0[r]; s1[4 * g + r] = f1[r]; } }
    } else {
#pragma unroll
        for (int i = 0; i < 16; ++i) { s0[i] = 0.f; s1[i] = 0.f; }
    }
#pragma unroll
    for (int s = 0; s < 4; ++s) { const bf16x8 k0 = *(const LAS bf16x8*)(lds + kaddr + s * 32), k1 = *(const LAS bf16x8*)(lds + kaddr + 16 * 144 + s * 32);
        s0 = MFMA32(k0, qf[s], s0); s1 = MFMA32(k1, qf[s], s1); }
}
DI float fox_max(f32x16& s0, f32x16& s1, bool domask, int kpos0, int qpos) {
    if (domask) {
#pragma unroll
        for (int i = 0; i < 16; ++i) { if (kpos0 + i > qpos) s0[i] = -INFINITY; if (kpos0 + 16 + i > qpos) s1[i] = -INFINITY; }
    }
    float tmax = fmaxf(s0[0], s1[0]);
#pragma unroll
    for (int i = 1; i < 16; ++i) tmax = max3f(tmax, s0[i], s1[i]);
    return fmaxf(tmax, __shfl_xor(tmax, 32));
}
DI void fox_rest(f32x16& s0, f32x16& s1, f32x16& o0, f32x16& o1, float& m_run, float& l_run, float tmax) {
    const float m_new = fmaxf(m_run, tmax);
    if (__builtin_amdgcn_ballot_w64(m_new - m_run > 8.0f) != 0ull) {
        const float alpha = __builtin_amdgcn_exp2f(m_run - m_new);
        m_run = m_new; l_run *= alpha;
#pragma unroll
        for (int i = 0; i < 16; ++i) { o0[i] *= alpha; o1[i] *= alpha; }
    }
    float ls = 0.f;
#pragma unroll
    for (int i = 0; i < 16; ++i) { const float p0 = __builtin_amdgcn_exp2f(s0[i] - m_run), p1 = __builtin_amdgcn_exp2f(s1[i] - m_run); s0[i] = p0; s1[i] = p1; ls += p0 + p1; }
    l_run += ls;
}
DI void sb_weights(f32x16& s0, f32x16& s1, float& R, bool domask, int kpos0, int qpos, int hh) {
#pragma unroll
    for (int i = 0; i < 16; ++i) { s0[i] = __builtin_amdgcn_rcpf(1.0f + __builtin_amdgcn_exp2f(s0[i])); s1[i] = __builtin_amdgcn_rcpf(1.0f + __builtin_amdgcn_exp2f(s1[i])); }
    if (domask) {
#pragma unroll
        for (int i = 0; i < 16; ++i) { if (kpos0 + i >= qpos) s0[i] = 1.0f; if (kpos0 + 16 + i >= qpos) s1[i] = 1.0f; }
    }
    float c = 1.0f;
#pragma unroll
    for (int i = 15; i >= 0; --i) { const float cn = c * s1[i]; s1[i] = c - cn; c = cn; }
#pragma unroll
    for (int i = 15; i >= 0; --i) { const float cn = c * s0[i]; s0[i] = c - cn; c = cn; }
    const float cp = __shfl_xor(c, 32);
    const float scale = hh == 0 ? R * cp : R;
#pragma unroll
    for (int i = 0; i < 16; ++i) { s0[i] *= scale; s1[i] *= scale; }
    R = R * (c * cp);
}
DI void pv_tile(const s16x4 (&v)[16], const f32x16& s0, const f32x16& s1, f32x16& o0, f32x16& o1) {
    bf16x8 pf;
    pf = pack8(s0, 0); o0 = MFMA32(__builtin_shufflevector(v[0], v[2], 0, 1, 2, 3, 4, 5, 6, 7), pf, o0); o1 = MFMA32(__builtin_shufflevector(v[1], v[3], 0, 1, 2, 3, 4, 5, 6, 7), pf, o1);
    pf = pack8(s0, 8); o0 = MFMA32(__builtin_shufflevector(v[4], v[6], 0, 1, 2, 3, 4, 5, 6, 7), pf, o0); o1 = MFMA32(__builtin_shufflevector(v[5], v[7], 0, 1, 2, 3, 4, 5, 6, 7), pf, o1);
    pf = pack8(s1, 0); o0 = MFMA32(__builtin_shufflevector(v[8], v[10], 0, 1, 2, 3, 4, 5, 6, 7), pf, o0); o1 = MFMA32(__builtin_shufflevector(v[9], v[11], 0, 1, 2, 3, 4, 5, 6, 7), pf, o1);
    pf = pack8(s1, 8); o0 = MFMA32(__builtin_shufflevector(v[12], v[14], 0, 1, 2, 3, 4, 5, 6, 7), pf, o0); o1 = MFMA32(__builtin_shufflevector(v[13], v[15], 0, 1, 2, 3, 4, 5, 6, 7), pf, o1);
}
DI void attn_store(bf16_t* op, const f32x16& o0, const f32x16& o1) {
#pragma unroll
    for (int g = 0; g < 4; ++g) { u32x2 w0, w1; w0.x = cvtpk(o0[4 * g], o0[4 * g + 1]); w0.y = cvtpk(o0[4 * g + 2], o0[4 * g + 3]); w1.x = cvtpk(o1[4 * g], o1[4 * g + 1]); w1.y = cvtpk(o1[4 * g + 2], o1[4 * g + 3]);
        *(u32x2*)(op + 8 * g) = w0; *(u32x2*)(op + 32 + 8 * g) = w1; }
}

template <int MODE>
DI void tile_compute(unsigned va, f32x16& c0, f32x16& c1, f32x16& o0, f32x16& o1, float& m_run, float& l_run, float& R, bool domask, int kpos0, int qpos, int hh) {
    if (MODE == 0) {
        const float tmax = fox_max(c0, c1, domask, kpos0, qpos);
        if (__builtin_amdgcn_ballot_w64(tmax - m_run > -126.0f) == 0ull) return;
        s16x4 v[16];
        TR16(v, va);
        fox_rest(c0, c1, o0, o1, m_run, l_run, tmax);
        TRWAIT(v);
        pv_tile(v, c0, c1, o0, o1);
    } else {
        if (__builtin_amdgcn_ballot_w64(R != 0.f) == 0ull) return;
        s16x4 v[16];
        TR16(v, va);
        sb_weights(c0, c1, R, domask, kpos0, qpos, hh);
        TRWAIT(v);
        pv_tile(v, c0, c1, o0, o1);
    }
}
DI void sb_post(LAS unsigned char* lds, int t, int wave, int lane, float R) { if (lane == 0) *(LAS unsigned*)(lds + LDS_RING + 64 + (t & 1) * 32 + wave * 4) = (__builtin_amdgcn_ballot_w64(R != 0.f) != 0ull) ? 1u : 0u; }
DI bool sb_all_done(LAS unsigned char* lds, int t) { const LAS u32x4* fp = (const LAS u32x4*)(lds + LDS_RING + 64 + (t & 1) * 32); const u32x4 a = fp[0], b = fp[1];
    return __builtin_amdgcn_readfirstlane((a.x | a.y | a.z | a.w) | (b.x | b.y | b.z | b.w)) == 0u; }

template <int MODE, bool DIAG>
DI void prompt_iter(LAS unsigned char* lds, unsigned ldsb, int t, int jt_w, int qpos, int hh, const bf16x8 (&qf)[4], unsigned kofs, unsigned fofs, unsigned vofs,
                    f32x16& c0, f32x16& c1, f32x16& n0, f32x16& n1, f32x16& o0, f32x16& o1, float& m_run, float& l_run, float& R) {
    if (t >= 1 && (!DIAG || t - 1 <= jt_w)) { const unsigned bo = ((t - 1) % 3) * ABUF; s_tile<MODE>(lds, bo + kofs, bo + fofs, qf, n0, n1); }
    if (!DIAG || t <= jt_w) tile_compute<MODE>(ldsb + (t % 3) * ABUF + vofs, c0, c1, o0, o1, m_run, l_run, R, DIAG && (t == jt_w), 64 * t + 32 * hh, qpos, hh);
}
template <int MODE, int H>
DI void attn_prompt(const Params& p, LAS unsigned char* lds, int b, int head, int qb) {
    constexpr int PITCH = H * 64;
    const int tid = tid_l(), lane = tid & 63, wave = tid >> 6, l31 = lane & 31, hh = lane >> 5;
    const int row = tid >> 3, ch = tid & 7;
    const int top = 4 * qb + 3, jt_w = 4 * qb + (wave >> 1), qpos = 256 * qb + 32 * wave + l31, qrow = b * SEQ + qpos;
    bf16x8 qf[4];
    { const bf16_t* qp = p.Q + (size_t)qrow * PITCH + head * 64 + 8 * hh;
#pragma unroll
      for (int s = 0; s < 4; ++s) qf[s] = *(const bf16x8*)(qp + 16 * s); }
    const float* Fh = p.Fp + (size_t)(b * 8 + (MODE == 0 ? head : 0)) * SEQ;
    float fref = 0.f; if (MODE == 0) fref = Fh[256 * qb];
    f32x16 o0, o1;
#pragma unroll
    for (int i = 0; i < 16; ++i) { o0[i] = 0.f; o1[i] = 0.f; }
    float m_run = -INFINITY, l_run = 0.f, R = 1.0f;
    u32x4 kA, vA, kB, vB; float fA = 0.f, fB = 0.f;
    const bf16_t* kg = p.Kp + (size_t)(b * SEQ + row) * PITCH + head * 64 + ch * 8;
    const bf16_t* vg = p.Vp + (size_t)(b * SEQ + row) * PITCH + head * 64 + ch * 8;
#define PL_LOAD(JT, KR, VR, FR) do { const int jt_ = (JT); KR = *(const u32x4*)(kg + (size_t)jt_ * 64 * PITCH); VR = *(const u32x4*)(vg + (size_t)jt_ * 64 * PITCH); \
        if (MODE == 0 && tid < 64) FR = (fref - Fh[64 * jt_ + tid]) * LOG2E; } while (0)
#define PL_STORE(JT, KR, VR, FR) do { const unsigned bo_ = (unsigned)(((JT) % 3) * ABUF); *(LAS u32x4*)(lds + bo_ + row * 144 + ch * 16) = KR; *(LAS u32x4*)(lds + bo_ + AKS + row * 144 + ch * 16) = VR; \
        if (MODE == 0 && tid < 64) *(LAS float*)(lds + bo_ + 2 * AKS + tid * 4) = FR; } while (0)
#define PL_STAGE(T, KR, VR, FR) do { if ((T) >= 2) PL_STORE((T) - 2, KR, VR, FR); if ((T) >= 4) PL_LOAD((T) - 4, KR, VR, FR); } while (0)
    const unsigned ldsb = (unsigned)(uintptr_t)lds;
    const unsigned krow = 32 * ((l31 >> 2) & 1) + 4 * (l31 >> 3) + (l31 & 3);
    const unsigned kofs = krow * 144 + hh * 16, fofs = 2 * AKS + hh * 128;
    const unsigned vofs = AKS + (32 * hh + ((lane & 15) >> 2)) * 144 + 32 * ((lane >> 4) & 1) + 8 * (lane & 3);
    __syncthreads();
    PL_LOAD(top, kA, vA, fA); PL_LOAD(top - 1, kB, vB, fB);
    PL_STORE(top, kA, vA, fA); PL_STORE(top - 1, kB, vB, fB);
    PL_LOAD(top - 2, kA, vA, fA); PL_LOAD(top - 3, kB, vB, fB);
    __syncthreads();
    f32x16 sa0, sa1, sb0, sb1;
#pragma unroll
    for (int i = 0; i < 16; ++i) { sa0[i] = 0.f; sa1[i] = 0.f; sb0[i] = 0.f; sb1[i] = 0.f; }
    if (top <= jt_w) s_tile<MODE>(lds, (top % 3) * ABUF + kofs, (top % 3) * ABUF + fofs, qf, sa0, sa1);
    bool done = false;
#define PL_ITER(T, DG, KR, VR, FR, C0, C1, N0, N1) do { PL_STAGE(T, KR, VR, FR); \
        prompt_iter<MODE, DG>(lds, ldsb, (T), jt_w, qpos, hh, qf, kofs, fofs, vofs, C0, C1, N0, N1, o0, o1, m_run, l_run, R); \
        if (MODE == 1) sb_post(lds, (T), wave, lane, R); \
        __syncthreads(); \
        if (MODE == 1) done = sb_all_done(lds, (T)); } while (0)
    for (int t = top; t >= 4 * qb && !done; t -= 2) {
        PL_ITER(t, true, kA, vA, fA, sa0, sa1, sb0, sb1);
        if (done) break;
        PL_ITER(t - 1, true, kB, vB, fB, sb0, sb1, sa0, sa1);
    }
    for (int t = 4 * qb - 1; t >= 1 && !done; t -= 2) {
        PL_ITER(t, false, kA, vA, fA, sa0, sa1, sb0, sb1);
        if (done) break;
        PL_ITER(t - 1, false, kB, vB, fB, sb0, sb1, sa0, sa1);
    }
#undef PL_ITER
#undef PL_LOAD
#undef PL_STORE
#undef PL_STAGE
    if (MODE == 0) { const float lt = l_run + __shfl_xor(l_run, 32); const float inv = 1.0f / lt;
#pragma unroll
        for (int i = 0; i < 16; ++i) { o0[i] *= inv; o1[i] *= inv; } }
    attn_store(p.CAT + (size_t)qrow * 1024 + head * 64 + 4 * hh, o0, o1);
}

template <int MODE, int H>
DI void attn_sample(const Params& p, LAS unsigned char* lds, int b, int ub) {
    constexpr int SBUF = 4 * AKS;
    const int tid = tid_l(), lane = tid & 63, wave = tid >> 6, l31 = lane & 31, hh = lane >> 5;
    const int row = tid >> 3, ch = tid & 7;
    const int slot = wave & 3, head = 4 * ub + slot, qpos = PAST + (lane & 15), qrow = TP + 16 * b + (lane & 15);
    const bool active = wave < 4;
    const float* cK = MODE == 0 ? p.cfk : p.csk; const float* cV = MODE == 0 ? p.cfv : p.csv;
    const float* nK = MODE == 0 ? p.fk_s : p.sk_s; const float* nV = MODE == 0 ? p.fv_s : p.sv_s;
    bf16x8 qf[4];
    { const bf16_t* qp = p.Q + (size_t)qrow * (H * 64) + head * 64 + 8 * hh;
#pragma unroll
      for (int s = 0; s < 4; ++s) qf[s] = *(const bf16x8*)(qp + 16 * s); }
    const float* Fl = p.Fs + (size_t)(b * 8 + (MODE == 0 ? 4 * ub + (tid >> 6) : 0)) * LPAD;
    float fref = 0.f; if (MODE == 0 && tid < 256) fref = Fl[PAST];
    f32x16 o0, o1;
#pragma unroll
    for (int i = 0; i < 16; ++i) { o0[i] = 0.f; o1[i] = 0.f; }
    float m_run = -INFINITY, l_run = 0.f, R = 1.0f;
    float freg = 0.f; f32x4 kr[4][2], vr[4][2];
#define SL_LOAD(JT) do { const int jt_ = (JT); \
        _Pragma("unroll") for (int i = 0; i < 4; ++i) { const int hd = 4 * ub + i; \
            if (jt_ < 64) { const size_t off = ((size_t)(b * PAST + 64 * jt_ + row) * H + hd) * 64 + 8 * ch; \
                kr[i][0] = *(const f32x4*)(cK + off); kr[i][1] = *(const f32x4*)(cK + off + 4); vr[i][0] = *(const f32x4*)(cV + off); vr[i][1] = *(const f32x4*)(cV + off + 4); } \
            else if (row < 16) { const size_t off = ((size_t)(b * 16 + row) * H + hd) * 64 + 8 * ch; \
                kr[i][0] = *(const f32x4*)(nK + off); kr[i][1] = *(const f32x4*)(nK + off + 4); vr[i][0] = *(const f32x4*)(nV + off); vr[i][1] = *(const f32x4*)(nV + off + 4); } \
            else { kr[i][0] = (f32x4){0.f, 0.f, 0.f, 0.f}; kr[i][1] = kr[i][0]; vr[i][0] = kr[i][0]; vr[i][1] = kr[i][0]; } } \
        if (MODE == 0 && tid < 256) freg = (fref - Fl[64 * jt_ + (tid & 63)]) * LOG2E; } while (0)
#define SL_STORE() do { \
        _Pragma("unroll") for (int i = 0; i < 4; ++i) { u32x4 kk, vv; \
            kk.x = cvtpk(kr[i][0][0], kr[i][0][1]); kk.y = cvtpk(kr[i][0][2], kr[i][0][3]); kk.z = cvtpk(kr[i][1][0], kr[i][1][1]); kk.w = cvtpk(kr[i][1][2], kr[i][1][3]); \
            vv.x = cvtpk(vr[i][0][0], vr[i][0][1]); vv.y = cvtpk(vr[i][0][2], vr[i][0][3]); vv.z = cvtpk(vr[i][1][0], vr[i][1][1]); vv.w = cvtpk(vr[i][1][2], vr[i][1][3]); \
            *(LAS u32x4*)(lds + i * AKS + row * 144 + ch * 16) = kk; *(LAS u32x4*)(lds + SBUF + i * AKS + row * 144 + ch * 16) = vv; } \
        if (MODE == 0 && tid < 256) *(LAS float*)(lds + 2 * SBUF + tid * 4) = freg; } while (0)
    const unsigned ldsb = (unsigned)(uintptr_t)lds;
    const unsigned krow = 32 * ((l31 >> 2) & 1) + 4 * (l31 >> 3) + (l31 & 3);
    const unsigned kofs = slot * AKS + krow * 144 + hh * 16, fofs = 2 * SBUF + slot * 256 + hh * 128;
    const unsigned va = ldsb + SBUF + slot * AKS + (32 * hh + ((lane & 15) >> 2)) * 144 + 32 * ((lane >> 4) & 1) + 8 * (lane & 3);
    SL_LOAD(64);
    if (!active) R = 0.f;
    for (int t = 64; t >= 0; --t) {
        __syncthreads();
        if (MODE == 1 && t < 64 && sb_all_done(lds, t + 1)) break;
        SL_STORE();
        __syncthreads();
        if (t > 0) SL_LOAD(t - 1);
        if (active) {
            f32x16 s0, s1;
            s_tile<MODE>(lds, kofs, fofs, qf, s0, s1);
            tile_compute<MODE>(va, s0, s1, o0, o1, m_run, l_run, R, t == 64, 64 * t + 32 * hh, qpos, hh);
        }
        if (MODE == 1) sb_post(lds, t, wave, lane, R);
    }
#undef SL_LOAD
#undef SL_STORE
    if (MODE == 0) { const float lt = l_run + __shfl_xor(l_run, 32); const float inv = 1.0f / lt;
#pragma unroll
        for (int i = 0; i < 16; ++i) { o0[i] *= inv; o1[i] *= inv; } }
    if (active && l31 < 16) attn_store(p.CAT + (size_t)qrow * 1024 + head * 64 + 4 * hh, o0, o1);
}

template <int MODE, int H>
DI void attn_phase(const Params& p, LAS unsigned char* lds, unsigned* ctr) {
    constexpr int NS = 16 * (H / 4), NPB = 2 * H, TOTAL = NS + NPB * 32;
    volatile LAS int* slotw = (volatile LAS int*)(lds + LDS_RING);
    for (;;) {
        __syncthreads();
        if (threadIdx.x == 0) *slotw = (int)atomicAdd(ctr, 1u);
        __syncthreads();
        int u = *slotw;
        if (u >= TOTAL) break;
        if (u < NS) attn_sample<MODE, H>(p, lds, u / (H / 4), u % (H / 4));
        else { u -= NS; const int qb = 31 - u / NPB, bh = u % NPB; attn_prompt<MODE, H>(p, lds, bh / H, bh % H, qb); }
    }
}

#define XB_TMO      128
#define XB_XCNT(j)  (256  + 64 * (j))
#define XB_XSUB(j)  (1280 + 64 * (j))
#define XB_XGEN(j)  (2304 + 64 * (j))
#define XB_TOP      3328
#define XB_TOPGEN   3392
#define XCD_BAR_WORDS 3456
#define XB_SPIN_CAP (1u << 18)

__device__ __forceinline__ unsigned xb_ld(unsigned* p)              { return __hip_atomic_load(p, __ATOMIC_RELAXED, __HIP_MEMORY_SCOPE_AGENT); }
__device__ __forceinline__ unsigned xb_add(unsigned* p, unsigned v) { return __hip_atomic_fetch_add(p, v, __ATOMIC_RELAXED, __HIP_MEMORY_SCOPE_AGENT); }
__device__ __forceinline__ unsigned xb_xcc_id() { return (unsigned)__builtin_amdgcn_s_getreg((3 << 11) | 20) & 0xFu; }
#define XB_SPIN(cond, bar) do { unsigned _sp = 0; while (cond) { __builtin_amdgcn_s_sleep(1); \
    if ((++_sp & 255u) == 0u) { if (xb_ld(&(bar)[XB_TMO])) break; if (_sp > XB_SPIN_CAP) { atomicAdd(&(bar)[XB_TMO], 1u); break; } } } } while (0)

struct XcdBarrier {
    unsigned* bar; unsigned x;
    volatile LAS unsigned* st;
};

__device__ __forceinline__ XcdBarrier xcd_barrier_post(unsigned* bar, volatile LAS unsigned* st) {
    XcdBarrier b; b.bar = bar; b.x = xb_xcc_id(); b.st = st;
    if (threadIdx.x == 0) (void)xb_add(&bar[XB_XCNT(b.x)], 1u);
    return b;
}
__device__ __forceinline__ void xcd_barrier_complete(unsigned* bar, unsigned x, unsigned& nloc, unsigned& nx) {
    const unsigned G = gridDim.x * gridDim.y * gridDim.z;
    unsigned sum, cnt, mine, sp = 0u;
    for (;;) {
        sum = 0u; cnt = 0u; mine = 0u;
#pragma unroll
        for (unsigned j = 0; j < 16; ++j) { const unsigned c = xb_ld(&bar[XB_XCNT(j)]); sum += c; cnt += (c > 0u) ? 1u : 0u; mine = (j == x) ? c : mine; }
        if (sum == G) break;
        __builtin_amdgcn_s_sleep(1);
        if ((++sp & 255u) == 0u) { if (xb_ld(&bar[XB_TMO])) break; if (sp > XB_SPIN_CAP) { atomicAdd(&bar[XB_TMO], 1u); break; } }
    }
    nloc = mine > 0u ? mine : 1u; nx = cnt > 0u ? cnt : 1u;
}

__device__ __forceinline__ void xcd_barrier(const XcdBarrier& b) {
    asm volatile("s_waitcnt vmcnt(0)" ::: "memory");
    __syncthreads();
    if (threadIdx.x == 0) {
        unsigned* bar = b.bar;
        __builtin_amdgcn_s_waitcnt(0);
        unsigned nloc = b.st[0], nx = b.st[1];
        if (nloc == 0u) { xcd_barrier_complete(bar, b.x, nloc, nx); b.st[0] = nloc; b.st[1] = nx; }
        const unsigned old = xb_add(&bar[XB_XSUB(b.x)], 1u);
        const unsigned gen = old / nloc;
        if (old + 1u == (gen + 1u) * nloc) {
            __builtin_amdgcn_fence(__ATOMIC_RELEASE, "agent");
            asm volatile("s_waitcnt vmcnt(0)" ::: "memory");
            const unsigned og = xb_add(&bar[XB_TOP], 1u);
            const unsigned tg = og / nx;
            if (og + 1u == (tg + 1u) * nx) xb_add(&bar[XB_TOPGEN], 1u);
            else XB_SPIN(xb_ld(&bar[XB_TOPGEN]) == tg, bar);
            __builtin_amdgcn_fence(__ATOMIC_ACQUIRE, "agent");
            xb_add(&bar[XB_XGEN(b.x)], 1u);
            asm volatile("s_waitcnt vmcnt(0)" ::: "memory");
        } else {
            XB_SPIN(xb_ld(&bar[XB_XGEN(b.x)]) == gen, bar);
            __builtin_amdgcn_fence(__ATOMIC_ACQUIRE, "agent");
            asm volatile("s_waitcnt vmcnt(0)" ::: "memory");
        }
    }
    __syncthreads();
}

typedef const __attribute__((address_space(4))) Params* KParams;
#define LOADP(q) Params q; { KParams k_ = (KParams)__builtin_amdgcn_kernarg_segment_ptr(); asm volatile("" : "+s"(k_)); q = *k_; }
__global__ void __launch_bounds__(NTHR, 2) mega(Params p_unused) {
#if defined(__HIP_DEVICE_COMPILE__)
    extern __shared__ __attribute__((aligned(16))) unsigned char lds_raw[];
    LAS unsigned char* lds = (LAS unsigned char*)lds_raw;
    cg::grid_group grid = cg::this_grid();
    if (threadIdx.x < 2) ((volatile LAS unsigned*)(lds + LDS_RING + 16))[threadIdx.x] = 0u;
    __syncthreads();
    XcdBarrier bar;
    { LOADP(p); bar = xcd_barrier_post(p.ctl + 1024, (volatile LAS unsigned*)(lds + LDS_RING + 16)); }
#define GSYNC() xcd_barrier(bar)
    { LOADP(p); phase0(p, lds); } grid.sync();
    { LOADP(p); norm_phase<true>(p, 0, 0, p.x_prompt, p.x_sample); } GSYNC();
    { LOADP(p); EmitQkvAB e{p.Q, p.Kp, p.Vp, p.U, p.fk_p, p.fv_p, p.fk_s, p.fv_s}; gemm_all(lds, p.XN, p.Wab, 2048, 1024, e); } GSYNC();
    { LOADP(p); phase3(p, lds); } GSYNC();
    { LOADP(p); attn_phase<0, 8>(p, lds, p.ctl); } GSYNC();
    { LOADP(p); EmitRes e{p.x_prompt, p.x_sample, p.mod + 2048, p.X}; gemm_all(lds, p.CAT, p.Woab, 1024, 1024, e); } GSYNC();
    { LOADP(p); norm_phase<false>(p, 0, 1, p.X, p.X + (size_t)TP * 1024); } GSYNC();
    { LOADP(p); EmitUp e{p.H}; gemm_all(lds, p.XN, p.Wup, 4096, 1024, e); } GSYNC();
    { LOADP(p); EmitRes e{p.X, p.X + (size_t)TP * 1024, p.mod + 5120, p.X}; gemm_all(lds, p.H, p.Wdn, 1024, 4096, e); } GSYNC();
    { LOADP(p); norm_phase<false>(p, 1, 0, p.X, p.X + (size_t)TP * 1024); } GSYNC();
    { LOADP(p); EmitQkvSB e{p.Q, p.Kp, p.Vp, p.sk_p, p.sv_p, p.sk_s, p.sv_s}; gemm_all(lds, p.XN, p.Wsb, 3072, 1024, e); } GSYNC();
    { LOADP(p); attn_phase<1, 16>(p, lds, p.ctl + 64); } GSYNC();
    { LOADP(p); EmitRes e{p.X, p.X + (size_t)TP * 1024, p.mod + (size_t)NSEQ * 6144 + 2048, p.X}; gemm_all(lds, p.CAT, p.Wosb, 1024, 1024, e); } GSYNC();
    { LOADP(p); norm_phase<false>(p, 1, 1, p.X, p.X + (size_t)TP * 1024); } GSYNC();
    { LOADP(p); EmitUp e{p.H}; gemm_all(lds, p.XN, p.Wup + (size_t)4096 * 1024, 4096, 1024, e); } GSYNC();
    { LOADP(p); EmitRes e{p.X, p.X + (size_t)TP * 1024, p.mod + (size_t)NSEQ * 6144 + 5120, p.X}; gemm_all(lds, p.H, p.Wdn + (size_t)1024 * 4096, 1024, 4096, e); } GSYNC();
    { LOADP(p); final_norm_phase(p); }
#endif
}

extern "C" void kernel_launch(void* const* d_in, const int* in_sizes, int n_in, void* d_out, int out_size, void* d_ws, size_t ws_size, hipStream_t stream) {
    static int grid = 0;
    if (grid == 0) {
        int dev = 0, cus = 0, per_cu = 0;
        hipGetDevice(&dev);
        hipDeviceGetAttribute(&cus, hipDeviceAttributeMultiprocessorCount, dev);
        if (hipFuncSetAttribute((const void*)mega, hipFuncAttributeMaxDynamicSharedMemorySize, LDS_BYTES) != hipSuccess) fprintf(stderr, "kernel_launch: hipFuncSetAttribute failed\n");
        if (hipOccupancyMaxActiveBlocksPerMultiprocessor(&per_cu, (const void*)mega, NTHR, LDS_BYTES) != hipSuccess || per_cu < 1) { fprintf(stderr, "kernel_launch: occupancy query says %d\n", per_cu); per_cu = 1; }
        (void)hipGetLastError();
        if (per_cu > 1) per_cu = 1;
        grid = cus * per_cu;
        if (n_in != 23 || out_size != 68428800 || ws_size < ((size_t)446 << 20)) fprintf(stderr, "kernel_launch: unexpected sizes n_in %d out %d ws %zu\n", n_in, out_size, ws_size);
    }
    const float* const* in = (const float* const*)d_in;
    Params p{};
    p.x_prompt = in[0]; p.x_sample = in[1]; p.c_prompt = in[2]; p.c_sample = in[3]; p.cfk = in[4]; p.cfv = in[5]; p.cfl = in[6]; p.spool = in[7]; p.csk = in[8]; p.csv = in[9];
    p.w_ada = in[10]; p.b_ada = in[11]; p.norm_g = in[12]; p.w_in_ab = in[13]; p.b_forget = in[14]; p.w_pool = in[15]; p.pool_scale = in[16]; p.w_out_ab = in[17];
    p.w_in_sb = in[18]; p.w_out_sb = in[19]; p.w_up = in[20]; p.w_down = in[21]; p.final_g = in[22];
    float* o = (float*)d_out;
    p.y_p = o; p.y_s = o + 16777216; p.fk_p = o + 17039360; p.fv_p = o + 25427968; p.fl_p = o + 33816576; p.pool_p = o + 33947648; p.sk_p = o + 33963008; p.sv_p = o + 50740224;
    p.fk_s = o + 67517440; p.fv_s = o + 67648512; p.fl_s = o + 67779584; p.pool_s = o + 67781632; p.sk_s = o + 67904512; p.sv_s = o + 68166656;
    unsigned char* ws = (unsigned char*)d_ws; const size_t MB = (size_t)1 << 20;
    p.ctl = (unsigned*)ws; p.mod = (float*)(ws + 1 * MB); p.Wf = (float*)(ws + 2 * MB); p.Fp = (float*)(ws + 3 * MB); p.Fs = (float*)(ws + 4 * MB);
    p.Wab = (bf16_t*)(ws + 8 * MB); p.Woab = (bf16_t*)(ws + 12 * MB); p.Wsb = (bf16_t*)(ws + 14 * MB); p.Wosb = (bf16_t*)(ws + 20 * MB); p.Wup = (bf16_t*)(ws + 22 * MB); p.Wdn = (bf16_t*)(ws + 38 * MB);
    p.XN = (bf16_t*)(ws + 54 * MB); p.X = (float*)(ws + 87 * MB); p.Q = (bf16_t*)(ws + 152 * MB); p.Kp = (bf16_t*)(ws + 185 * MB); p.Vp = (bf16_t*)(ws + 217 * MB);
    p.U = (float*)(ws + 249 * MB); p.CAT = (bf16_t*)(ws + 282 * MB); p.H = (bf16_t*)(ws + 315 * MB);
    (void)hipMemsetAsync(ws, 0, 32768, stream);
    void* args[] = {&p};
    hipError_t e = hipLaunchCooperativeKernel((const void*)mega, dim3(grid), dim3(NTHR), args, LDS_BYTES, stream);
    if (e != hipSuccess) fprintf(stderr, "kernel_launch: cooperative launch failed: %s (grid %d)\n", hipGetErrorString(e), grid);
}
```

```cpp
#include <hip/hip_runtime.h>
#include <hip/hip_cooperative_groups.h>
#include <cstdio>
#include <cstdint>
namespace cg = cooperative_groups;
__device__ __forceinline__ int tid_l() { int t = threadIdx.x; asm volatile("" : "+v"(t)); return t; }
namespace pg8 {
#define PG8_LAS __attribute__((address_space(3)))
typedef unsigned short bf16_t;
typedef short bf16x8 __attribute__((ext_vector_type(8)));
typedef float f32x4 __attribute__((ext_vector_type(4)));
typedef unsigned u32x4 __attribute__((ext_vector_type(4)));
constexpr int BM = 256, BK = 64, HALF = 128, HTB = HALF * BK * 2  , STAGE_BYTES = 8 * HTB, NXCD = 8, WGM = 8;

__host__ __device__ __forceinline__ int lds_byte(int r, int c) { const int st = (r >> 4) * 2 + (c >> 5), rr = r & 15, cc = c & 31, ob = rr * 64 + cc * 2; return st * 1024 + (ob ^ (((ob >> 9) & 1) << 5)); }
__host__ __device__ __forceinline__ void stage_rc(int b, int& R, int& C) { const int st = b / 1024, sb = b % 1024, swz = sb ^ (((sb >> 9) & 1) << 5); R = (st >> 1) * 16 + swz / 64; C = (st & 1) * 32 + (swz % 64) / 2; }
__host__ __device__ __forceinline__ int perm32(int rho) { const int n = rho >> 4, i = rho & 15; return 8 * (i >> 2) + 4 * n + (i & 3); }

struct Unit { int pm, pn; };
struct Gemm { const bf16_t* A; const bf16_t* Bt; int M, N, K; };

struct StaticOrder {
    int nM, nN, nwg, G, c;
    __host__ __device__ void init(int M, int N, int G_, int c_) { nM = M / BM; nN = N / BM; nwg = nM * nN; G = G_; c = c_; }
    __host__ __device__ bool next(int i, Unit& u) const {
        const long L = (long)i * G + c; if (L >= nwg) return false;
        int wgid = (int)L; { const int q = nwg / NXCD, r = nwg % NXCD, xcd = wgid % NXCD, off = wgid / NXCD; wgid = (xcd < r ? xcd * (q + 1) : r * (q + 1) + (xcd - r) * q) + off; }
        const int nig = WGM * nN, gid = wgid / nig, fm = gid * WGM, gsz = (nM - fm) < WGM ? (nM - fm) : WGM;
        u.pm = fm + ((wgid % nig) % gsz); u.pn = (wgid % nig) / gsz; return true;
    }
    __device__ __forceinline__ void a_ready(const Unit&) const {}
    __device__ __forceinline__ void done(const Unit&) const {}
};

__device__ __forceinline__ unsigned cvt_pk_bf16(float lo, float hi) { unsigned r; asm volatile("v_cvt_pk_bf16_f32 %0, %1, %2" : "=v"(r) : "v"(lo), "v"(hi)); return r; }
template <class Epi, class Sched, bool ALIGN_EPI = false, bool SP2 = false>
__device__ __forceinline__ void gemm_phase(PG8_LAS unsigned char* lds, const Gemm g, const Sched& S, const Epi& E) {
    const int tid = tid_l(), wid = __builtin_amdgcn_readfirstlane(tid >> 6), lane = tid & 63, wr = wid >> 2, wc = wid & 3, fr = lane & 15, fq = lane >> 4;
    const int K = g.K, nt = K / BK;
    unsigned voffA[2], voffB[2];
#pragma unroll
    for (int i = 0; i < 2; ++i) { int R, C; stage_rc(tid * 16 + i * 8192, R, C); const int Rb = Epi::PERM ? ((R & ~31) + perm32(R & 31)) : R;
        voffA[i] = (unsigned)(R * K + C) * 2u; voffB[i] = (unsigned)(Rb * K + C) * 2u; }
    const size_t kstep = (size_t)(BK * 2);
    const size_t hstep = (size_t)HALF * K * 2;
    const size_t tstep = 2 * hstep;
    const unsigned ldsw = (unsigned)wid * 1024u;
    const int aoff = lds_byte(wr * 64 + fr, fq * 8), boff = lds_byte(wc * 32 + fr, fq * 8);
#define PG8_SA(b, h) (((b) * 2 + (h)) * HTB)
#define PG8_SB(b, h) ((4 + (b) * 2 + (h)) * HTB)
#define PG8_STAGE(bufoff, gbase, voff) do { _Pragma("unroll") for (int _i = 0; _i < 2; ++_i) \
        __builtin_amdgcn_global_load_lds((const unsigned*)((const char*)(gbase) + (voff)[_i]), (PG8_LAS unsigned*)(lds + (bufoff) + ldsw + _i * 8192), 16, 0, 0); } while (0)
#define PG8_LDA(dst, b, h) do { _Pragma("unroll") for (int m = 0; m < 4; ++m) _Pragma("unroll") for (int k = 0; k < 2; ++k) dst[m][k] = *(const PG8_LAS bf16x8*)(lds + PG8_SA(b, h) + aoff + m * 2048 + k * 1024); } while (0)
#define PG8_LDB(dst, b, h) do { _Pragma("unroll") for (int n = 0; n < 2; ++n) _Pragma("unroll") for (int k = 0; k < 2; ++k) dst[n][k] = *(const PG8_LAS bf16x8*)(lds + PG8_SB(b, h) + boff + n * 2048 + k * 1024); } while (0)
#define PG8_MMA(ai, bj, At, Bt) do { __builtin_amdgcn_s_setprio(1); _Pragma("unroll") for (int m = 0; m < 4; ++m) _Pragma("unroll") for (int n = 0; n < 2; ++n) _Pragma("unroll") for (int k = 0; k < 2; ++k) \
        acc[ai][bj][m][n] = __builtin_amdgcn_mfma_f32_16x16x32_bf16(Bt[n][k], At[m][k], acc[ai][bj][m][n], 0, 0, 0); __builtin_amdgcn_s_setprio(0); } while (0)
#define PG8_WAIT_V(n) asm volatile("s_waitcnt vmcnt(" #n ")" ::: "memory")
#define PG8_WAIT_L(n) asm volatile("s_waitcnt lgkmcnt(" #n ")" ::: "memory")
#define PG8_BAR __builtin_amdgcn_s_barrier()
#define PG8_SCHED __builtin_amdgcn_sched_barrier(0)
    Unit cur, nxt; int ui = 0;
    if (!S.next(0, cur)) return;
    f32x4 acc[2][2][4][2];
#pragma unroll
    for (int a = 0; a < 2; ++a)
#pragma unroll
        for (int b = 0; b < 2; ++b)
#pragma unroll
            for (int m = 0; m < 4; ++m)
#pragma unroll
                for (int n = 0; n < 2; ++n) acc[a][b][m][n] = (f32x4){0.f, 0.f, 0.f, 0.f};
    bf16x8 At[4][2], B0[2][2], B1[2][2];
    const char* cA = (const char*)g.A + (size_t)cur.pm * tstep; const char* cB = (const char*)g.Bt + (size_t)cur.pn * tstep;
    S.a_ready(cur);
    if constexpr (SP2) {
        PG8_STAGE(PG8_SB(0, 0), cB, voffB); PG8_STAGE(PG8_SB(0, 1), cB + hstep, voffB); PG8_STAGE(PG8_SA(0, 0), cA, voffA); PG8_STAGE(PG8_SA(0, 1), cA + hstep, voffA);
        if (wr == 1) PG8_BAR;
        PG8_WAIT_V(2); PG8_BAR;
        PG8_STAGE(PG8_SB(1, 0), cB + kstep, voffB); PG8_STAGE(PG8_SA(1, 0), cA + kstep, voffA); PG8_STAGE(PG8_SB(1, 1), cB + hstep + kstep, voffB);
        PG8_WAIT_V(6); PG8_BAR;
    } else {
        PG8_STAGE(PG8_SB(0, 0), cB, voffB); PG8_STAGE(PG8_SA(0, 0), cA, voffA); PG8_STAGE(PG8_SB(0, 1), cB + hstep, voffB); PG8_STAGE(PG8_SA(0, 1), cA + hstep, voffA);
        if (wr == 1) PG8_BAR;
        PG8_WAIT_V(4); PG8_BAR;
        PG8_STAGE(PG8_SB(1, 0), cB + kstep, voffB); PG8_STAGE(PG8_SA(1, 0), cA + kstep, voffA); PG8_STAGE(PG8_SB(1, 1), cB + hstep + kstep, voffB);
        PG8_WAIT_V(6); PG8_BAR;
    }
    for (;;) {
        const bool has_next = S.next(ui + 1, nxt);
        const char* nA = has_next ? (const char*)g.A + (size_t)nxt.pm * tstep : cA; const char* nB = has_next ? (const char*)g.Bt + (size_t)nxt.pn * tstep : cB;
        for (int t = 0; t < nt; t += 2) {
            const bool last = (t == nt - 2);
            const char* a1 = cA + (size_t)(t + 1) * kstep;
            const char* a2 = last ? nA : cA + (size_t)(t + 2) * kstep; const char* b2 = last ? nB : cB + (size_t)(t + 2) * kstep;
            const char* a3 = a2 + kstep; const char* b3 = b2 + kstep;
            if (last && has_next) S.a_ready(nxt);
            if constexpr (SP2) {
            PG8_LDB(B0, 0, 0); PG8_LDB(B1, 0, 1); PG8_SCHED; PG8_LDA(At, 0, 0); PG8_STAGE(PG8_SA(1, 1), a1 + hstep, voffA);
            PG8_WAIT_V(8); PG8_WAIT_L(0); PG8_BAR; PG8_MMA(0, 0, At, B0); PG8_MMA(0, 1, At, B1); PG8_BAR; PG8_SCHED;
            PG8_LDA(At, 0, 1); PG8_STAGE(PG8_SB(0, 0), b2, voffB); PG8_STAGE(PG8_SB(0, 1), b2 + hstep, voffB); PG8_STAGE(PG8_SA(0, 0), a2, voffA);
            PG8_WAIT_V(8); PG8_WAIT_L(0); PG8_BAR; PG8_MMA(1, 0, At, B0); PG8_MMA(1, 1, At, B1); PG8_BAR; PG8_SCHED;
            PG8_LDB(B0, 1, 0); PG8_LDB(B1, 1, 1); PG8_SCHED; PG8_LDA(At, 1, 0); PG8_STAGE(PG8_SA(0, 1), a2 + hstep, voffA);
            PG8_WAIT_V(8); PG8_WAIT_L(0); PG8_BAR; PG8_MMA(0, 0, At, B0); PG8_MMA(0, 1, At, B1); PG8_BAR; PG8_SCHED;
            PG8_LDA(At, 1, 1); PG8_STAGE(PG8_SB(1, 0), b3, voffB); PG8_STAGE(PG8_SB(1, 1), b3 + hstep, voffB); PG8_STAGE(PG8_SA(1, 0), a3, voffA);
            PG8_WAIT_V(8); PG8_WAIT_L(0); PG8_BAR; PG8_MMA(1, 0, At, B0); PG8_MMA(1, 1, At, B1); PG8_BAR; PG8_SCHED;
            } else {
            PG8_LDB(B0, 0, 0); PG8_SCHED; PG8_LDA(At, 0, 0); PG8_STAGE(PG8_SA(1, 1), a1 + hstep, voffA);
            PG8_WAIT_L(8); PG8_BAR; PG8_WAIT_L(0); PG8_MMA(0, 0, At, B0); PG8_BAR; PG8_SCHED;
            PG8_LDB(B1, 0, 1); PG8_STAGE(PG8_SB(0, 0), b2, voffB);
            PG8_BAR; PG8_WAIT_L(0); PG8_MMA(0, 1, At, B1); PG8_BAR;
            PG8_LDA(At, 0, 1); PG8_STAGE(PG8_SA(0, 0), a2, voffA);
            PG8_BAR; PG8_WAIT_L(0); PG8_MMA(1, 0, At, B0); PG8_BAR; PG8_SCHED;
            PG8_STAGE(PG8_SB(0, 1), b2 + hstep, voffB);
            PG8_WAIT_V(6); PG8_BAR; PG8_MMA(1, 1, At, B1); PG8_BAR;
            PG8_LDB(B0, 1, 0); PG8_SCHED; PG8_LDA(At, 1, 0); PG8_STAGE(PG8_SA(0, 1), a2 + hstep, voffA);
            PG8_WAIT_L(8); PG8_BAR; PG8_WAIT_L(0); PG8_MMA(0, 0, At, B0); PG8_BAR; PG8_SCHED;
            PG8_LDB(B1, 1, 1); PG8_STAGE(PG8_SB(1, 0), b3, voffB);
            PG8_BAR; PG8_WAIT_L(0); PG8_MMA(0, 1, At, B1); PG8_BAR;
            PG8_LDA(At, 1, 1); PG8_STAGE(PG8_SA(1, 0), a3, voffA);
            PG8_BAR; PG8_WAIT_L(0); PG8_MMA(1, 0, At, B0); PG8_BAR; PG8_SCHED;
            PG8_STAGE(PG8_SB(1, 1), b3 + hstep, voffB);
            PG8_WAIT_V(6); PG8_BAR; PG8_MMA(1, 1, At, B1); PG8_BAR;
            }
        }
        if constexpr (ALIGN_EPI) { if (wr == 0) PG8_BAR; }
        if constexpr (!Epi::AFTER_DRAIN) { E(acc, cur, wr, wc, fr, fq); S.done(cur); }
        if (!has_next) break;
#pragma unroll
        for (int a = 0; a < 2; ++a)
#pragma unroll
            for (int b = 0; b < 2; ++b)
#pragma unroll
                for (int m = 0; m < 4; ++m)
#pragma unroll
                    for (int n = 0; n < 2; ++n) acc[a][b][m][n] = (f32x4){0.f, 0.f, 0.f, 0.f};
        cur = nxt; cA = nA; cB = nB; ++ui;
        if constexpr (ALIGN_EPI) { if (wr == 1) PG8_BAR; }
    }
    PG8_WAIT_V(0);
    if constexpr (!ALIGN_EPI) { if (wr == 0) PG8_BAR; }
    PG8_BAR;
    if constexpr (Epi::AFTER_DRAIN) { E.fused(acc, cur, wr, wc, fr, fq, lds, wid, lane); S.done(cur); }
#undef PG8_SA
#undef PG8_SB
#undef PG8_STAGE
#undef PG8_LDA
#undef PG8_LDB
#undef PG8_MMA
#undef PG8_WAIT_V
#undef PG8_WAIT_L
#undef PG8_BAR
#undef PG8_SCHED
}
}

#define LAS __attribute__((address_space(3)))
typedef unsigned short bf16_t;
typedef short bf16x8 __attribute__((ext_vector_type(8)));
typedef short s16x4 __attribute__((ext_vector_type(4)));
typedef float f32x4 __attribute__((ext_vector_type(4)));
typedef float f32x16 __attribute__((ext_vector_type(16)));
typedef unsigned u32x4 __attribute__((ext_vector_type(4)));
typedef unsigned u32x2 __attribute__((ext_vector_type(2)));
typedef float f32x2_t __attribute__((ext_vector_type(2)));
typedef __bf16 bf16x2_t __attribute__((ext_vector_type(2)));

constexpr int TP = 16384, TS = 256, TT = TP + TS, DM = 1024, DFF = 4096;
constexpr int SEQ = 8192, PAST = 4096, LPAD = 4160, NSEQ = 18;
constexpr float LOG2E = 1.4426950408889634f;
constexpr int NTHR = 512, NWV = 8;
constexpr int LDS_RING = 131072, LDS_BYTES = LDS_RING + 1024;

struct Params {
    const float *x_prompt, *x_sample, *c_prompt, *c_sample, *cfk, *cfv, *cfl, *spool, *csk, *csv;
    const float *w_ada, *b_ada, *norm_g, *w_in_ab, *b_forget, *w_pool, *pool_scale, *w_out_ab, *w_in_sb, *w_out_sb, *w_up, *w_down, *final_g;
    float *y_p, *y_s, *fk_p, *fv_p, *fl_p, *pool_p, *sk_p, *sv_p, *fk_s, *fv_s, *fl_s, *pool_s, *sk_s, *sv_s;
    unsigned* ctl; float *mod, *Wf, *Fp, *Fs, *KNp, *KNs;
    bf16_t *Wab, *Woab, *Wsb, *Wosb, *Wup, *Wdn, *XN;
    float* X; bf16_t *Q, *Kp, *Vp; float* U; bf16_t *CAT, *H;
};

#define DI __device__ __forceinline__
DI unsigned cvtpk(float lo, float hi) { f32x2_t v = {lo, hi}; bf16x2_t b = __builtin_convertvector(v, bf16x2_t); return __builtin_bit_cast(unsigned, b); }
DI int seq_of(int t) { return t < TP ? (t >> 13) : 2 + ((t - TP) >> 4); }
DI float wave_sum(float v) {
#pragma unroll
    for (int o = 1; o < 64; o <<= 1) v += __shfl_xor(v, o);
    return v;
}
DI void st_bf4(bf16_t* p, f32x4 v) { u32x2 w; w.x = cvtpk(v[0], v[1]); w.y = cvtpk(v[2], v[3]); *(u32x2*)p = w; }
#define LDS_WAIT() asm volatile("s_waitcnt lgkmcnt(0)" ::: "memory")

DI void tr_item(const float* W, int ldw, int k0, int c0, bf16_t* WT, int ldt, int r0, int kd0, LAS float* scr, int lane) {
#pragma unroll 32
    for (int i = 0; i < 32; ++i) { const int kk = 2 * i + (lane >> 5); scr[kk * 33 + (lane & 31)] = W[(size_t)(k0 + kk) * ldw + c0 + (lane & 31)]; }
    LDS_WAIT();
    const int c = lane & 7;
#pragma unroll
    for (int j = 0; j < 4; ++j) { const int n = (lane >> 3) + 8 * j; const LAS float* s = scr + (8 * c) * 33 + n;
        u32x4 o; o.x = cvtpk(s[0 * 33], s[1 * 33]); o.y = cvtpk(s[2 * 33], s[3 * 33]); o.z = cvtpk(s[4 * 33], s[5 * 33]); o.w = cvtpk(s[6 * 33], s[7 * 33]);
        *(u32x4*)(WT + (size_t)(r0 + n) * ldt + kd0 + 8 * c) = o; }
    LDS_WAIT();
}

DI void phase0(const Params& p, LAS unsigned char* lds) {
    const int tid = tid_l(), lane = tid & 63, wave = tid >> 6;
    if ((int)blockIdx.x < 192) {
        LAS float* cond = (LAS float*)lds;
        LAS float* red = (LAS float*)(lds + 73728);
        for (int i = tid; i < NSEQ * 1024; i += NTHR) { const int s = i >> 10, k = i & 1023; const float c = s < 2 ? p.c_prompt[s * 1024 + k] : p.c_sample[(s - 2) * 1024 + k]; cond[i] = c / (1.0f + expf(-c)); }
        __syncthreads();
        for (int item = blockIdx.x; item < 192; item += gridDim.x) {
            const int layer = item / 96, col0 = (item % 96) * 64, quad = tid & 15, kc = tid >> 4;
            float acc[NSEQ][4];
#pragma unroll
            for (int s = 0; s < NSEQ; ++s) { acc[s][0] = 0.f; acc[s][1] = 0.f; acc[s][2] = 0.f; acc[s][3] = 0.f; }
            const float* wp = p.w_ada + ((size_t)layer * 1024 + kc * 32) * 6144 + col0 + 4 * quad;
#pragma unroll 4
            for (int kk = 0; kk < 32; ++kk) { const f32x4 w = *(const f32x4*)(wp + (size_t)kk * 6144);
#pragma unroll
                for (int s = 0; s < NSEQ; ++s) { const float cs = cond[s * 1024 + kc * 32 + kk]; acc[s][0] += cs * w[0]; acc[s][1] += cs * w[1]; acc[s][2] += cs * w[2]; acc[s][3] += cs * w[3]; } }
#pragma unroll
            for (int s = 0; s < NSEQ; ++s)
#pragma unroll
                for (int j = 0; j < 4; ++j) { float v = acc[s][j]; v += __shfl_xor(v, 16); v += __shfl_xor(v, 32); if (lane < 16) red[((wave * 16 + quad) * NSEQ + s) * 4 + j] = v; }
            __syncthreads();
            for (int o = tid; o < 16 * NSEQ * 4; o += NTHR) { const int qd = o / (NSEQ * 4), rem = o % (NSEQ * 4), s = rem >> 2, j = rem & 3; float sum = 0.f;
#pragma unroll
                for (int w = 0; w < 8; ++w) sum += red[((w * 16 + qd) * NSEQ + s) * 4 + j];
                const int col = col0 + 4 * qd + j; p.mod[((size_t)layer * NSEQ + s) * 6144 + col] = sum + p.b_ada[layer * 6144 + col]; }
            __syncthreads();
        }
    }
    for (int it = (int)gridDim.x - 1 - (int)blockIdx.x; it < 128; it += gridDim.x) {
        const int g = it >> 5, rem = it & 31, cblk = rem >> 1, n = (rem & 1) * 512 + tid;
        LAS float* wps = (LAS float*)lds;
        __syncthreads();
        for (int i = tid; i < 1024; i += NTHR) { const int j = i >> 7, e = i & 127; wps[i] = p.w_pool[((g * 128) + cblk * 8 + j) * 128 + e] * p.pool_scale[128 * g + e]; }
        __syncthreads();
        float acc[8];
#pragma unroll
        for (int j = 0; j < 8; ++j) acc[j] = 0.f;
        const float* wo = p.w_out_ab + (size_t)(512 + 128 * g) * 1024 + n;
#pragma unroll 8
        for (int e = 0; e < 128; ++e) { const float wv = wo[(size_t)e * 1024];
#pragma unroll
            for (int j = 0; j < 8; ++j) acc[j] += wps[j * 128 + e] * wv; }
        u32x4 o; o.x = cvtpk(acc[0], acc[1]); o.y = cvtpk(acc[2], acc[3]); o.z = cvtpk(acc[4], acc[5]); o.w = cvtpk(acc[6], acc[7]);
        *(u32x4*)(p.Woab + (size_t)n * 1024 + 512 + 128 * g + cblk * 8) = o;
    }
    for (int i = blockIdx.x * NTHR + tid; i < 8192; i += gridDim.x * NTHR) { const int h = i >> 10, k = i & 1023; p.Wf[i] = p.w_in_ab[(size_t)k * 2056 + 1536 + h]; }
    __syncthreads();
    LAS float* scr = (LAS float*)(lds + wave * 16384);
    const int gw = blockIdx.x * NWV + wave, NGW = gridDim.x * NWV;
    constexpr int NITEMS = 1024 + 256 + 1536 + 512 + 4096 + 4096;
    for (int it = gw; it < NITEMS; it += NGW) {
        int r = it;
        if (r < 1024) { const int kb = r >> 6, n0 = (r & 63) * 32, c0 = n0 < 1536 ? n0 : n0 + 8; tr_item(p.w_in_ab, 2056, kb * 64, c0, p.Wab, 1024, n0, kb * 64, scr, lane); continue; } r -= 1024;
        if (r < 256) { const int kb = r >> 5, n0 = (r & 31) * 32; tr_item(p.w_out_ab, 1024, kb * 64, n0, p.Woab, 1024, n0, kb * 64, scr, lane); continue; } r -= 256;
        if (r < 1536) { const int kb = r / 96, n0 = (r % 96) * 32; tr_item(p.w_in_sb, 3072, kb * 64, n0, p.Wsb, 1024, n0, kb * 64, scr, lane); continue; } r -= 1536;
        if (r < 512) { const int kb = r >> 5, n0 = (r & 31) * 32; tr_item(p.w_out_sb, 1024, kb * 64, n0, p.Wosb, 1024, n0, kb * 64, scr, lane); continue; } r -= 512;
        if (r < 4096) { const int layer = r >> 11, r2 = r & 2047, kb = r2 >> 7, n0 = (r2 & 127) * 32;
            tr_item(p.w_up + (size_t)layer * 1024 * 4096, 4096, kb * 64, n0, p.Wup + (size_t)layer * 4096 * 1024, 1024, n0, kb * 64, scr, lane); continue; } r -= 4096;
        { const int layer = r >> 11, r2 = r & 2047, kb = r2 >> 5, n0 = (r2 & 31) * 32;
            tr_item(p.w_down + (size_t)layer * 4096 * 1024, 1024, kb * 64, n0, p.Wdn + (size_t)layer * 1024 * 4096, 4096, n0, kb * 64, scr, lane); }
    }
}

template <bool FLOGIT>
DI void norm_phase(const Params& p, int layer, int which, const float* xin_p, const float* xin_s) {
    const int tid = tid_l(), lane = tid & 63, wave = tid >> 6;
    const int gw = blockIdx.x * NWV + wave, NGW = gridDim.x * NWV;
    const float* gptr = p.norm_g + (layer * 2 + which) * 1024;
    constexpr int NR = FLOGIT ? 1 : 4;
    for (int t0 = gw; t0 < TT; t0 += NR * NGW) {
        f32x4 v[NR][4];
#pragma unroll
        for (int r = 0; r < NR; ++r) { const int t = t0 + r * NGW; const int tc = t < TT ? t : t0;
            const float* xr = tc < TP ? xin_p + (size_t)tc * 1024 : xin_s + (size_t)(tc - TP) * 1024;
#pragma unroll
            for (int j = 0; j < 4; ++j) v[r][j] = *(const f32x4*)(xr + 4 * lane + 256 * j); }
#pragma unroll
        for (int r = 0; r < NR; ++r) { const int t = t0 + r * NGW;
            if (t < TT) {
                const float* md = p.mod + ((size_t)layer * NSEQ + seq_of(t)) * 6144 + (which ? 3072 : 0);
                float ss = 0.f;
#pragma unroll
                for (int j = 0; j < 4; ++j) ss += (v[r][j][0] * v[r][j][0] + v[r][j][1] * v[r][j][1]) + (v[r][j][2] * v[r][j][2] + v[r][j][3] * v[r][j][3]);
                const float rstd = 1.0f / sqrtf(wave_sum(ss) * (1.0f / 1024.0f) + 1e-6f);
                float fd[8];
#pragma unroll
                for (int h = 0; h < 8; ++h) fd[h] = 0.f;
#pragma unroll
                for (int j = 0; j < 4; ++j) { const int col = 4 * lane + 256 * j;
                    const f32x4 g = *(const f32x4*)(gptr + col), sh = *(const f32x4*)(md + col), sc = *(const f32x4*)(md + 1024 + col);
                    f32x4 y;
#pragma unroll
                    for (int e = 0; e < 4; ++e) y[e] = (v[r][j][e] * rstd * g[e]) * (1.0f + sc[e]) + sh[e];
                    st_bf4(p.XN + (size_t)t * 1024 + col, y);
                    if (FLOGIT) {
#pragma unroll
                        for (int h = 0; h < 8; ++h) { const f32x4 w = *(const f32x4*)(p.Wf + h * 1024 + col); fd[h] += (y[0] * w[0] + y[1] * w[1]) + (y[2] * w[2] + y[3] * w[3]); } }
                }
                if (FLOGIT) {
                    float mine = 0.f;
#pragma unroll
                    for (int h = 0; h < 8; ++h) { const float s = wave_sum(fd[h]); if (lane == h) mine = s; }
                    if (lane < 8) { const float z = mine + p.b_forget[lane]; const float lf = fminf(z, 0.f) - log1pf(expf(-fabsf(z)));
                        if (t < TP) p.fl_p[(size_t)t * 8 + lane] = lf; else p.fl_s[(size_t)(t - TP) * 8 + lane] = lf; }
                }
            }
        }
    }
}
DI void final_norm_phase(const Params& p) {
    const int tid = tid_l(), lane = tid & 63, wave = tid >> 6;
    const int gw = blockIdx.x * NWV + wave, NGW = gridDim.x * NWV;
    for (int t0 = gw; t0 < TT; t0 += 4 * NGW) {
        f32x4 v[4][4];
#pragma unroll
        for (int r = 0; r < 4; ++r) { const int t = t0 + r * NGW; const int tc = t < TT ? t : t0; const float* xr = p.X + (size_t)tc * 1024;
#pragma unroll
            for (int j = 0; j < 4; ++j) v[r][j] = *(const f32x4*)(xr + 4 * lane + 256 * j); }
#pragma unroll
        for (int r = 0; r < 4; ++r) { const int t = t0 + r * NGW;
            if (t < TT) {
                float* yr = t < TP ? p.y_p + (size_t)t * 1024 : p.y_s + (size_t)(t - TP) * 1024;
                float ss = 0.f;
#pragma unroll
                for (int j = 0; j < 4; ++j) ss += (v[r][j][0] * v[r][j][0] + v[r][j][1] * v[r][j][1]) + (v[r][j][2] * v[r][j][2] + v[r][j][3] * v[r][j][3]);
                const float rstd = 1.0f / sqrtf(wave_sum(ss) * (1.0f / 1024.0f) + 1e-6f);
#pragma unroll
                for (int j = 0; j < 4; ++j) { const int col = 4 * lane + 256 * j; const f32x4 g = *(const f32x4*)(p.final_g + col); f32x4 y;
#pragma unroll
                    for (int e = 0; e < 4; ++e) y[e] = v[r][j][e] * rstd * g[e];
                    *(f32x4*)(yr + col) = y; }
            }
        }
    }
}

struct EmitQkvAB { bf16_t *Q, *Kp, *Vp; float *U, *fk_p, *fv_p, *fk_s, *fv_s;
    DI void emit(int t, int c, f32x4 v) const {
        if (c < 512) { st_bf4(Q + (size_t)t * 512 + c, v * (0.125f * LOG2E)); }
        else if (c < 1024) { const int cc = c - 512; if (t < TP) { st_bf4(Kp + (size_t)t * 512 + cc, v); *(f32x4*)(fk_p + (size_t)t * 512 + cc) = v; } else *(f32x4*)(fk_s + (size_t)(t - TP) * 512 + cc) = v; }
        else if (c < 1536) { const int cc = c - 1024; if (t < TP) { st_bf4(Vp + (size_t)t * 512 + cc, v); *(f32x4*)(fv_p + (size_t)t * 512 + cc) = v; } else *(f32x4*)(fv_s + (size_t)(t - TP) * 512 + cc) = v; }
        else { *(f32x4*)(U + (size_t)t * 512 + (c - 1536)) = v; }
    } };
struct EmitQkvSB { bf16_t *Q, *Kp, *Vp; float *sk_p, *sv_p, *sk_s, *sv_s;
    DI void emit(int t, int c, f32x4 v) const {
        if (c < 1024) { st_bf4(Q + (size_t)t * 1024 + c, v * (0.125f * LOG2E)); }
        else if (c < 2048) { const int cc = c - 1024; if (t < TP) { st_bf4(Kp + (size_t)t * 1024 + cc, v); *(f32x4*)(sk_p + (size_t)t * 1024 + cc) = v; } else *(f32x4*)(sk_s + (size_t)(t - TP) * 1024 + cc) = v; }
        else { const int cc = c - 2048; if (t < TP) { st_bf4(Vp + (size_t)t * 1024 + cc, v); *(f32x4*)(sv_p + (size_t)t * 1024 + cc) = v; } else *(f32x4*)(sv_s + (size_t)(t - TP) * 1024 + cc) = v; }
    } };
struct EmitRes { const float* xin_p; const float* xin_s; const float* modg; float* X;
    DI void emit(int t, int c, f32x4 v) const {
        const float* xr = t < TP ? xin_p + (size_t)t * 1024 : xin_s + (size_t)(t - TP) * 1024;
        const f32x4 x = *(const f32x4*)(xr + c), g = *(const f32x4*)(modg + (size_t)seq_of(t) * 6144 + c);
        *(f32x4*)(X + (size_t)t * 1024 + c) = x + g * v;
    } };
struct EmitUp { bf16_t* H;
    DI void emit(int t, int c, f32x4 v) const { f32x4 r;
#pragma unroll
        for (int e = 0; e < 4; ++e) { const float a = fmaxf(v[e], 0.f); r[e] = a * a; }
        st_bf4(H + (size_t)t * 4096 + c, r); } };

template <class F> struct EpiEmit {
    static constexpr bool PERM = false, AFTER_DRAIN = false;
    F f;
    DI void operator()(const pg8::f32x4 (&acc)[2][2][4][2], const pg8::Unit& u, int wr, int wc, int fr, int fq) const {
        const int row0 = u.pm * 256 + wr * 64 + fr, col0 = u.pn * 256 + wc * 32 + 4 * fq;
#pragma unroll
        for (int ai = 0; ai < 2; ++ai)
#pragma unroll
            for (int m = 0; m < 4; ++m)
#pragma unroll
                for (int bj = 0; bj < 2; ++bj)
#pragma unroll
                    for (int n = 0; n < 2; ++n) f.emit(row0 + ai * 128 + m * 16, col0 + bj * 128 + n * 16, acc[ai][bj][m][n]);
    }
};

template <class F, int KS>
DI void skinny_gemm(LAS unsigned char* lds, const bf16_t* A, const bf16_t* Bt, int N, int K, const F& f) {
    const int tid = tid_l(), lane = tid & 63, wave = tid >> 6, fr = lane & 15, fq = lane >> 4;
    constexpr int WPB = 8 / KS;
    const int wsub = wave % WPB, kh = wave / WPB, Kh = K / KS;
    LAS f32x4* red = (LAS f32x4*)lds;
    for (int item0 = blockIdx.x * WPB; item0 < N; item0 += gridDim.x * WPB) {
        const int item = item0 + wsub, rb = item & 15, cb = item >> 4;
        const bf16_t* ap = A + (size_t)(rb * 16 + fr) * K + kh * Kh + 8 * fq;
        const bf16_t* bp = Bt + (size_t)(cb * 16 + fr) * K + kh * Kh + 8 * fq;
        f32x4 acc = {0.f, 0.f, 0.f, 0.f};
        for (int ks = 0; ks < Kh; ks += 512) {
            bf16x8 a[16], b[16];
#pragma unroll
            for (int i = 0; i < 16; ++i) { a[i] = *(const bf16x8*)(ap + ks + 32 * i); b[i] = *(const bf16x8*)(bp + ks + 32 * i); }
#pragma unroll
            for (int i = 0; i < 16; ++i) acc = __builtin_amdgcn_mfma_f32_16x16x32_bf16(b[i], a[i], acc, 0, 0, 0);
        }
        if (KS == 2) { if (kh == 1) red[wsub * 64 + lane] = acc; __syncthreads(); if (kh == 0) acc = acc + red[wsub * 64 + lane]; }
        if (kh == 0) f.emit(TP + rb * 16 + fr, cb * 16 + 4 * fq, acc);
        if (KS == 2) __syncthreads();
    }
}

struct EpiUpPerm {
    static constexpr bool PERM = true, AFTER_DRAIN = false;
    bf16_t* H;
    DI void operator()(const pg8::f32x4 (&acc)[2][2][4][2], const pg8::Unit& u, int wr, int wc, int fr, int fq) const {
        const int row0 = u.pm * 256 + wr * 64 + fr, col0 = u.pn * 256 + wc * 32 + 8 * fq;
#pragma unroll
        for (int ai = 0; ai < 2; ++ai)
#pragma unroll
            for (int m = 0; m < 4; ++m) { bf16_t* rp = H + (size_t)(row0 + ai * 128 + m * 16) * 4096 + col0;
#pragma unroll
                for (int bj = 0; bj < 2; ++bj) { f32x4 a = acc[ai][bj][m][0], b = acc[ai][bj][m][1];
#pragma unroll
                    for (int e = 0; e < 4; ++e) { const float x = fmaxf(a[e], 0.f), y = fmaxf(b[e], 0.f); a[e] = x * x; b[e] = y * y; }
                    u32x4 w; w.x = cvtpk(a[0], a[1]); w.y = cvtpk(a[2], a[3]); w.z = cvtpk(b[0], b[1]); w.w = cvtpk(b[2], b[3]);
                    *(u32x4*)(rp + bj * 128) = w; } }
    }
};
DI void gemm_up(LAS unsigned char* lds, const bf16_t* A, const bf16_t* Bt, bf16_t* H) {
    { pg8::Gemm g{A, Bt, TP, 4096, 1024}; pg8::StaticOrder S; S.init(TP, 4096, (int)gridDim.x, (int)blockIdx.x);
      EpiUpPerm E{H};
      pg8::gemm_phase<EpiUpPerm, pg8::StaticOrder, true, true>(lds, g, S, E); }
    __syncthreads();
    EmitUp f{H};
    skinny_gemm<EmitUp, 1>(lds, A + (size_t)TP * 1024, Bt, 4096, 1024, f);
}

template <class F>
DI void gemm_all(LAS unsigned char* lds, const bf16_t* A, const bf16_t* Bt, int N, int K, const F& f) {
    { pg8::Gemm g{A, Bt, TP, N, K}; pg8::StaticOrder S; S.init(TP, N, (int)gridDim.x, (int)blockIdx.x);
      EpiEmit<F> E{f};
      pg8::gemm_phase<EpiEmit<F>, pg8::StaticOrder, true, true>(lds, g, S, E); }
    __syncthreads();
    if (K > 1024) skinny_gemm<F, 2>(lds, A + (size_t)TP * K, Bt, N, K, f); else skinny_gemm<F, 1>(lds, A + (size_t)TP * K, Bt, N, K, f);
}

template <int PER>
DI void scan_item(LAS unsigned char* lds, const float* src_a, int na, const float* src_b, int ntot, int stride, float* dst, int ndst) {
    const int tid = tid_l(), lane = tid & 63, wave = tid >> 6;
    LAS float* wt = (LAS float*)lds;
    float v[PER]; float tot = 0.f;
#pragma unroll
    for (int i = 0; i < PER; ++i) { const int pos = tid * PER + i; float x = 0.f; if (pos < na) x = src_a[(size_t)pos * stride]; else if (pos < ntot) x = src_b[(size_t)(pos - na) * stride]; tot += x; v[i] = tot; }
    float inc = tot;
#pragma unroll
    for (int o = 1; o < 64; o <<= 1) { const float t = __shfl_up(inc, o); if (lane >= o) inc += t; }
    __syncthreads();
    if (lane == 63) wt[wave] = inc;
    __syncthreads();
    float base = 0.f, total = 0.f;
#pragma unroll
    for (int w = 0; w < 8; ++w) { if (w < wave) base += wt[w]; total += wt[w]; }
    const float ex = base + inc - tot;
#pragma unroll
    for (int i = 0; i < PER; ++i) { const int pos = tid * PER + i; if (pos < ntot) dst[pos] = ex + v[i]; else if (pos < ndst) dst[pos] = total; }
}
DI float wave_max(float v) {
#pragma unroll
    for (int o = 1; o < 64; o <<= 1) v = fmaxf(v, __shfl_xor(v, o));
    return v;
}
template <bool SAMPLE>
DI void kn_item(const Params& p, LAS unsigned char* lds, int b, int h) {
    const int tid = tid_l(), lane = tid & 63, wave = tid >> 6;
    LAS float* knl = (LAS float*)(lds + 1024);
    constexpr int NT = SAMPLE ? 65 : 128;
    for (int tile = wave; tile < NT; tile += 8) {
        float ss = 0.f;
        if (!SAMPLE) { const u32x4* kp = (const u32x4*)(p.Kp + (size_t)(b * SEQ + 64 * tile + lane) * 512 + h * 64);
#pragma unroll
            for (int i = 0; i < 8; ++i) { const u32x4 w = kp[i];
#pragma unroll
                for (int e = 0; e < 4; ++e) { const float lo = __uint_as_float(w[e] << 16), hi = __uint_as_float(w[e] & 0xffff0000u); ss += lo * lo + hi * hi; } }
        } else { const float* kp = nullptr;
            if (tile < 64) kp = p.cfk + ((size_t)(b * PAST + 64 * tile + lane) * 8 + h) * 64; else if (lane < 16) kp = p.fk_s + ((size_t)(b * 16 + lane) * 8 + h) * 64;
            if (kp) {
#pragma unroll
                for (int i = 0; i < 16; ++i) { const f32x4 w = *(const f32x4*)(kp + 4 * i); ss += (w[0] * w[0] + w[1] * w[1]) + (w[2] * w[2] + w[3] * w[3]); } }
        }
        const float n = wave_max(sqrtf(ss));
        if (lane == 0) knl[tile] = n;
    }
    __syncthreads();
    if (tid < NT) { float m = 0.f; for (int i = 0; i <= tid; ++i) m = fmaxf(m, knl[i]); (SAMPLE ? p.KNs + (b * 8 + h) * 80 : p.KNp + (b * 8 + h) * 128)[tid] = m; }
    __syncthreads();
}
DI void phase3(const Params& p, LAS unsigned char* lds) {
    const int tid = tid_l();
    for (int it = blockIdx.x; it < 144; it += gridDim.x) {
        if (it < 16) { scan_item<16>(lds, p.fl_p + (size_t)(it >> 3) * SEQ * 8 + (it & 7), SEQ, nullptr, SEQ, 8, p.Fp + (size_t)it * SEQ, SEQ); kn_item<false>(p, lds, it >> 3, it & 7); }
        else { const int bh = it - 16, b = bh >> 3, h = bh & 7;
            scan_item<9>(lds, p.cfl + (size_t)b * PAST * 8 + h, PAST, p.fl_s + (size_t)b * 16 * 8 + h, PAST + 16, 8, p.Fs + (size_t)bh * LPAD, LPAD); kn_item<true>(p, lds, b, h); }
    }
    for (int i = blockIdx.x * NTHR + tid; i < TT * 128; i += gridDim.x * NTHR) {
        const int t = i >> 7, c = (i & 127) * 4, g = c >> 7, w = 2 << g;
        const f32x4 u = *(const f32x4*)(p.U + (size_t)t * 512 + c);
        f32x4 sum = u; float cnt;
        if (t < TP) { const int pos = t & (SEQ - 1); const int nw = pos + 1 < w ? pos + 1 : w; cnt = (float)nw;
            for (int k = 1; k < nw; ++k) sum += *(const f32x4*)(p.U + (size_t)(t - k) * 512 + c);
            if (pos >= SEQ - 15) *(f32x4*)(p.pool_p + ((size_t)(t >> 13) * 15 + (pos - (SEQ - 15))) * 512 + c) = u;
        } else { const int b = (t - TP) >> 4, loc = (t - TP) & 15; cnt = (float)w;
            for (int k = 1; k < w; ++k) { const int li = loc - k; sum += li >= 0 ? *(const f32x4*)(p.U + (size_t)(t - k) * 512 + c) : *(const f32x4*)(p.spool + ((size_t)b * 15 + 15 + li) * 512 + c); }
            if (loc >= 1) *(f32x4*)(p.pool_s + ((size_t)b * 15 + loc - 1) * 512 + c) = u;
        }
        f32x4 r;
#pragma unroll
        for (int e = 0; e < 4; ++e) r[e] = sum[e] / cnt - u[e];
        st_bf4(p.CAT + (size_t)t * 1024 + 512 + c, r);
    }
}

constexpr int AKS = 9216;
constexpr int ABUF = 2 * AKS + 272;
#define MFMA32(a, b, c) __builtin_amdgcn_mfma_f32_32x32x16_bf16((a), (b), (c), 0, 0, 0)
DI float max3f(float a, float b, float c) { float r; asm("v_max3_f32 %0, %1, %2, %3" : "=v"(r) : "v"(a), "v"(b), "v"(c)); return r; }
DI bf16x8 pack8(const f32x16& s, int base) { u32x4 w; w.x = cvtpk(s[base], s[base + 1]); w.y = cvtpk(s[base + 2], s[base + 3]); w.z = cvtpk(s[base + 4], s[base + 5]); w.w = cvtpk(s[base + 6], s[base + 7]); return __builtin_bit_cast(bf16x8, w); }
#define TR4(O) "ds_read_b64_tr_b16 %" #O ", %16 offset:"
#define TR16(v, addr) asm volatile( \
    "ds_read_b64_tr_b16 %0, %16\n\tds_read_b64_tr_b16 %1, %16 offset:64\n\tds_read_b64_tr_b16 %2, %16 offset:576\n\tds_read_b64_tr_b16 %3, %16 offset:640\n\t" \
    "ds_read_b64_tr_b16 %4, %16 offset:1152\n\tds_read_b64_tr_b16 %5, %16 offset:1216\n\tds_read_b64_tr_b16 %6, %16 offset:1728\n\tds_read_b64_tr_b16 %7, %16 offset:1792\n\t" \
    "ds_read_b64_tr_b16 %8, %16 offset:2304\n\tds_read_b64_tr_b16 %9, %16 offset:2368\n\tds_read_b64_tr_b16 %10, %16 offset:2880\n\tds_read_b64_tr_b16 %11, %16 offset:2944\n\t" \
    "ds_read_b64_tr_b16 %12, %16 offset:3456\n\tds_read_b64_tr_b16 %13, %16 offset:3520\n\tds_read_b64_tr_b16 %14, %16 offset:4032\n\tds_read_b64_tr_b16 %15, %16 offset:4096" \
    : "=&v"(v[0]), "=&v"(v[1]), "=&v"(v[2]), "=&v"(v[3]), "=&v"(v[4]), "=&v"(v[5]), "=&v"(v[6]), "=&v"(v[7]), "=&v"(v[8]), "=&v"(v[9]), "=&v"(v[10]), "=&v"(v[11]), "=&v"(v[12]), "=&v"(v[13]), "=&v"(v[14]), "=&v"(v[15]) \
    : "v"(addr) : "memory")
#define TRWAIT(v) asm volatile("s_waitcnt lgkmcnt(0)" : "+v"(v[0]), "+v"(v[1]), "+v"(v[2]), "+v"(v[3]), "+v"(v[4]), "+v"(v[5]), "+v"(v[6]), "+v"(v[7]), "+v"(v[8]), "+v"(v[9]), "+v"(v[10]), "+v"(v[11]), "+v"(v[12]), "+v"(v[13]), "+v"(v[14]), "+v"(v[15]) :: "memory")

template <int MODE>
DI void s_tile(LAS unsigned char* lds, unsigned kaddr, unsigned faddr, const bf16x8 (&qf)[4], f32x16& s0, f32x16& s1) {
    if (MODE == 0) {
#pragma unroll
        for (int g = 0; g < 4; ++g) { const f32x4 f0 = *(const LAS f32x4*)(lds + faddr + 16 * g), f1 = *(const LAS f32x4*)(lds + faddr + 64 + 16 * g);
#pragma unroll
            for (int r = 0; r < 4; ++r) { s0[4 * g + r] = f0[r]; s1[4 * g + r] = f1[r]; } }
    } else {
#pragma unroll
        for (int i = 0; i < 16; ++i) { s0[i] = 0.f; s1[i] = 0.f; }
    }
#pragma unroll
    for (int s = 0; s < 4; ++s) { const bf16x8 k0 = *(const LAS bf16x8*)(lds + kaddr + s * 32), k1 = *(const LAS bf16x8*)(lds + kaddr + 16 * 144 + s * 32);
        s0 = MFMA32(k0, qf[s], s0); s1 = MFMA32(k1, qf[s], s1); }
}
DI float fox_max(f32x16& s0, f32x16& s1, bool domask, int kpos0, int qpos) {
    if (domask) {
#pragma unroll
        for (int i = 0; i < 16; ++i) { if (kpos0 + i > qpos) s0[i] = -INFINITY; if (kpos0 + 16 + i > qpos) s1[i] = -INFINITY; }
    }
    float tmax = fmaxf(s0[0], s1[0]);
#pragma unroll
    for (int i = 1; i < 16; ++i) tmax = max3f(tmax, s0[i], s1[i]);
    return fmaxf(tmax, __shfl_xor(tmax, 32));
}
DI void fox_rest(f32x16& s0, f32x16& s1, f32x16& o0, f32x16& o1, float& m_run, float& l_run, float tmax) {
    const float m_new = fmaxf(m_run, tmax);
    if (__builtin_amdgcn_ballot_w64(m_new - m_run > 8.0f) != 0ull) {
        const float alpha = __builtin_amdgcn_exp2f(m_run - m_new);
        m_run = m_new; l_run *= alpha;
#pragma unroll
        for (int i = 0; i < 16; ++i) { o0[i] *= alpha; o1[i] *= alpha; }
    }
    float ls = 0.f;
#pragma unroll
    for (int i = 0; i < 16; ++i) { const float p0 = __builtin_amdgcn_exp2f(s0[i] - m_run), p1 = __builtin_amdgcn_exp2f(s1[i] - m_run); s0[i] = p0; s1[i] = p1; ls += p0 + p1; }
    l_run += ls;
}
DI void sb_weights(f32x16& s0, f32x16& s1, float& R, bool domask, int kpos0, int qpos, int hh) {
#pragma unroll
    for (int i = 0; i < 16; ++i) { s0[i] = __builtin_amdgcn_rcpf(1.0f + __builtin_amdgcn_exp2f(s0[i])); s1[i] = __builtin_amdgcn_rcpf(1.0f + __builtin_amdgcn_exp2f(s1[i])); }
    if (domask) {
#pragma unroll
        for (int i = 0; i < 16; ++i) { if (kpos0 + i >= qpos) s0[i] = 1.0f; if (kpos0 + 16 + i >= qpos) s1[i] = 1.0f; }
    }
    float c = 1.0f;
#pragma unroll
    for (int i = 15; i >= 0; --i) { const float cn = c * s1[i]; s1[i] = c - cn; c = cn; }
#pragma unroll
    for (int i = 15; i >= 0; --i) { const float cn = c * s0[i]; s0[i] = c - cn; c = cn; }
    const float cp = __shfl_xor(c, 32);
    const float scale = hh == 0 ? R * cp : R;
#pragma unroll
    for (int i = 0; i < 16; ++i) { s0[i] *= scale; s1[i] *= scale; }
    R = R * (c * cp);
}
DI void pv_tile(const s16x4 (&v)[16], const f32x16& s0, const f32x16& s1, f32x16& o0, f32x16& o1) {
    bf16x8 pf;
    pf = pack8(s0, 0); o0 = MFMA32(__builtin_shufflevector(v[0], v[2], 0, 1, 2, 3, 4, 5, 6, 7), pf, o0); o1 = MFMA32(__builtin_shufflevector(v[1], v[3], 0, 1, 2, 3, 4, 5, 6, 7), pf, o1);
    pf = pack8(s0, 8); o0 = MFMA32(__builtin_shufflevector(v[4], v[6], 0, 1, 2, 3, 4, 5, 6, 7), pf, o0); o1 = MFMA32(__builtin_shufflevector(v[5], v[7], 0, 1, 2, 3, 4, 5, 6, 7), pf, o1);
    pf = pack8(s1, 0); o0 = MFMA32(__builtin_shufflevector(v[8], v[10], 0, 1, 2, 3, 4, 5, 6, 7), pf, o0); o1 = MFMA32(__builtin_shufflevector(v[9], v[11], 0, 1, 2, 3, 4, 5, 6, 7), pf, o1);
    pf = pack8(s1, 8); o0 = MFMA32(__builtin_shufflevector(v[12], v[14], 0, 1, 2, 3, 4, 5, 6, 7), pf, o0); o1 = MFMA32(__builtin_shufflevector(v[13], v[15], 0, 1, 2, 3, 4, 5, 6, 7), pf, o1);
}
DI void attn_store(bf16_t* op, const f32x16& o0, const f32x16& o1) {
#pragma unroll
    for (int g = 0; g < 4; ++g) { u32x2 w0, w1; w0.x = cvtpk(o0[4 * g], o0[4 * g + 1]); w0.y = cvtpk(o0[4 * g + 2], o0[4 * g + 3]); w1.x = cvtpk(o1[4 * g], o1[4 * g + 1]); w1.y = cvtpk(o1[4 * g + 2], o1[4 * g + 3]);
        *(u32x2*)(op + 8 * g) = w0; *(u32x2*)(op + 32 + 8 * g) = w1; }
}

template <int MODE>
DI void tile_compute(unsigned va, f32x16& c0, f32x16& c1, f32x16& o0, f32x16& o1, float& m_run, float& l_run, float& R, bool domask, int kpos0, int qpos, int hh) {
    if (MODE == 0) {
        const float tmax = fox_max(c0, c1, domask, kpos0, qpos);
        if (__builtin_amdgcn_ballot_w64(tmax - m_run > -126.0f) == 0ull) return;
        s16x4 v[16];
        TR16(v, va);
        fox_rest(c0, c1, o0, o1, m_run, l_run, tmax);
        TRWAIT(v);
        pv_tile(v, c0, c1, o0, o1);
    } else {
        if (__builtin_amdgcn_ballot_w64(R != 0.f) == 0ull) return;
        s16x4 v[16];
        TR16(v, va);
        sb_weights(c0, c1, R, domask, kpos0, qpos, hh);
        TRWAIT(v);
        pv_tile(v, c0, c1, o0, o1);
    }
}
DI void sb_post(LAS unsigned char* lds, int t, int wave, int lane, bool notdone) { const bool any = __builtin_amdgcn_ballot_w64(notdone) != 0ull; if (lane == 0) *(LAS unsigned*)(lds + LDS_RING + 64 + (t & 1) * 32 + wave * 4) = any ? 1u : 0u; }
DI bool fox_notdone(float qn, float kn, float bmax, float m_run) { return qn * kn * 1.01f + bmax + 1.0f > m_run - 126.0f; }
DI bool sb_all_done(LAS unsigned char* lds, int t) { const LAS u32x4* fp = (const LAS u32x4*)(lds + LDS_RING + 64 + (t & 1) * 32); const u32x4 a = fp[0], b = fp[1];
    return __builtin_amdgcn_readfirstlane((a.x | a.y | a.z | a.w) | (b.x | b.y | b.z | b.w)) == 0u; }

template <int MODE, bool DIAG>
DI void prompt_iter(LAS unsigned char* lds, unsigned ldsb, int t, int jt_w, int qpos, int hh, const bf16x8 (&qf)[4], unsigned kofs, unsigned fofs, unsigned vofs,
                    f32x16& c0, f32x16& c1, f32x16& n0, f32x16& n1, f32x16& o0, f32x16& o1, float& m_run, float& l_run, float& R) {
    if (t >= 1 && (!DIAG || t - 1 <= jt_w)) { const unsigned bo = ((t - 1) % 3) * ABUF; s_tile<MODE>(lds, bo + kofs, bo + fofs, qf, n0, n1); }
    if (!DIAG || t <= jt_w) tile_compute<MODE>(ldsb + (t % 3) * ABUF + vofs, c0, c1, o0, o1, m_run, l_run, R, DIAG && (t == jt_w), 64 * t + 32 * hh, qpos, hh);
}
template <int MODE, int H>
DI void attn_prompt(const Params& p, LAS unsigned char* lds, int b, int head, int qb) {
    constexpr int PITCH = H * 64;
    const int tid = tid_l(), lane = tid & 63, wave = tid >> 6, l31 = lane & 31, hh = lane >> 5;
    const int row = tid >> 3, ch = tid & 7;
    const int top = 4 * qb + 3, jt_w = 4 * qb + (wave >> 1), qpos = 256 * qb + 32 * wave + l31, qrow = b * SEQ + qpos;
    bf16x8 qf[4];
    { const bf16_t* qp = p.Q + (size_t)qrow * PITCH + head * 64 + 8 * hh;
#pragma unroll
      for (int s = 0; s < 4; ++s) qf[s] = *(const bf16x8*)(qp + 16 * s); }
    const float* Fh = p.Fp + (size_t)(b * 8 + (MODE == 0 ? head : 0)) * SEQ;
    float fref = 0.f; if (MODE == 0) fref = Fh[256 * qb];
    const float* KNh = p.KNp + (b * 8 + (MODE == 0 ? head : 0)) * 128;
    float qn = 0.f;
    if (MODE == 0) {
#pragma unroll
        for (int s_ = 0; s_ < 4; ++s_)
#pragma unroll
            for (int j = 0; j < 8; ++j) { const float x = __uint_as_float(((unsigned)(unsigned short)qf[s_][j]) << 16); qn += x * x; }
        qn += __shfl_xor(qn, 32); qn = sqrtf(qn); }
    f32x16 o0, o1;
#pragma unroll
    for (int i = 0; i < 16; ++i) { o0[i] = 0.f; o1[i] = 0.f; }
    float m_run = -INFINITY, l_run = 0.f, R = 1.0f;
    u32x4 kA, vA, kB, vB; float fA = 0.f, fB = 0.f;
    const bf16_t* kg = p.Kp + (size_t)(b * SEQ + row) * PITCH + head * 64 + ch * 8;
    const bf16_t* vg = p.Vp + (size_t)(b * SEQ + row) * PITCH + head * 64 + ch * 8;
#define PL_LOAD(JT, KR, VR, FR) do { const int jt_ = (JT); KR = *(const u32x4*)(kg + (size_t)jt_ * 64 * PITCH); VR = *(const u32x4*)(vg + (size_t)jt_ * 64 * PITCH); \
        if (MODE == 0 && tid < 65) FR = tid < 64 ? (fref - Fh[64 * jt_ + tid]) * LOG2E : KNh[jt_]; } while (0)
#define PL_STORE(JT, KR, VR, FR) do { const unsigned bo_ = (unsigned)(((JT) % 3) * ABUF); *(LAS u32x4*)(lds + bo_ + row * 144 + ch * 16) = KR; *(LAS u32x4*)(lds + bo_ + AKS + row * 144 + ch * 16) = VR; \
        if (MODE == 0 && tid < 65) *(LAS float*)(lds + bo_ + 2 * AKS + tid * 4) = FR; } while (0)
#define PL_STAGE(T, KR, VR, FR) do { if ((T) >= 2) PL_STORE((T) - 2, KR, VR, FR); if ((T) >= 4) PL_LOAD((T) - 4, KR, VR, FR); } while (0)
    const unsigned ldsb = (unsigned)(uintptr_t)lds;
    const unsigned krow = 32 * ((l31 >> 2) & 1) + 4 * (l31 >> 3) + (l31 & 3);
    const unsigned kofs = krow * 144 + hh * 16, fofs = 2 * AKS + hh * 128;
    const unsigned vofs = AKS + (32 * hh + ((lane & 15) >> 2)) * 144 + 32 * ((lane >> 4) & 1) + 8 * (lane & 3);
    __syncthreads();
    PL_LOAD(top, kA, vA, fA); PL_LOAD(top - 1, kB, vB, fB);
    PL_STORE(top, kA, vA, fA); PL_STORE(top - 1, kB, vB, fB);
    PL_LOAD(top - 2, kA, vA, fA); PL_LOAD(top - 3, kB, vB, fB);
    __syncthreads();
    f32x16 sa0, sa1, sb0, sb1;
#pragma unroll
    for (int i = 0; i < 16; ++i) { sa0[i] = 0.f; sa1[i] = 0.f; sb0[i] = 0.f; sb1[i] = 0.f; }
    if (top <= jt_w) s_tile<MODE>(lds, (top % 3) * ABUF + kofs, (top % 3) * ABUF + fofs, qf, sa0, sa1);
    bool done = false;
#define PL_ITER(T, DG, KR, VR, FR, C0, C1, N0, N1) do { PL_STAGE(T, KR, VR, FR); \
        prompt_iter<MODE, DG>(lds, ldsb, (T), jt_w, qpos, hh, qf, kofs, fofs, vofs, C0, C1, N0, N1, o0, o1, m_run, l_run, R); \
        if (MODE == 1) sb_post(lds, (T), wave, lane, R != 0.f); \
        else { const unsigned bo_ = (unsigned)(((T) % 3) * ABUF + 2 * AKS); sb_post(lds, (T), wave, lane, fox_notdone(qn, *(const LAS float*)(lds + bo_ + 256), *(const LAS float*)(lds + bo_ + 252), m_run)); } \
        __syncthreads(); \
        done = sb_all_done(lds, (T)); } while (0)
    for (int t = top; t >= 4 * qb && !done; t -= 2) {
        PL_ITER(t, true, kA, vA, fA, sa0, sa1, sb0, sb1);
        if (done) break;
        PL_ITER(t - 1, true, kB, vB, fB, sb0, sb1, sa0, sa1);
    }
    for (int t = 4 * qb - 1; t >= 1 && !done; t -= 2) {
        PL_ITER(t, false, kA, vA, fA, sa0, sa1, sb0, sb1);
        if (done) break;
        PL_ITER(t - 1, false, kB, vB, fB, sb0, sb1, sa0, sa1);
    }
#undef PL_ITER
#undef PL_LOAD
#undef PL_STORE
#undef PL_STAGE
    if (MODE == 0) { const float lt = l_run + __shfl_xor(l_run, 32); const float inv = 1.0f / lt;
#pragma unroll
        for (int i = 0; i < 16; ++i) { o0[i] *= inv; o1[i] *= inv; } }
    attn_store(p.CAT + (size_t)qrow * 1024 + head * 64 + 4 * hh, o0, o1);
}

template <int MODE, int H>
DI void attn_sample(const Params& p, LAS unsigned char* lds, int b, int ub) {
    constexpr int SBUF = 4 * AKS;
    const int tid = tid_l(), lane = tid & 63, wave = tid >> 6, l31 = lane & 31, hh = lane >> 5;
    const int row = tid >> 3, ch = tid & 7;
    const int slot = wave & 3, head = 4 * ub + slot, qpos = PAST + (lane & 15), qrow = TP + 16 * b + (lane & 15);
    const bool active = wave < 4;
    const float* cK = MODE == 0 ? p.cfk : p.csk; const float* cV = MODE == 0 ? p.cfv : p.csv;
    const float* nK = MODE == 0 ? p.fk_s : p.sk_s; const float* nV = MODE == 0 ? p.fv_s : p.sv_s;
    bf16x8 qf[4];
    { const bf16_t* qp = p.Q + (size_t)qrow * (H * 64) + head * 64 + 8 * hh;
#pragma unroll
      for (int s = 0; s < 4; ++s) qf[s] = *(const bf16x8*)(qp + 16 * s); }
    const float* Fl = p.Fs + (size_t)(b * 8 + (MODE == 0 ? 4 * ub + (tid >> 6) : 0)) * LPAD;
    float fref = 0.f; if (MODE == 0 && tid < 256) fref = Fl[PAST];
    const float* KNl = p.KNs + (b * 8 + (MODE == 0 ? 4 * ub + (tid & 3) : 0)) * 80;
    float qn = 0.f;
    if (MODE == 0) {
#pragma unroll
        for (int s_ = 0; s_ < 4; ++s_)
#pragma unroll
            for (int j = 0; j < 8; ++j) { const float x = __uint_as_float(((unsigned)(unsigned short)qf[s_][j]) << 16); qn += x * x; }
        qn += __shfl_xor(qn, 32); qn = sqrtf(qn); }
    f32x16 o0, o1;
#pragma unroll
    for (int i = 0; i < 16; ++i) { o0[i] = 0.f; o1[i] = 0.f; }
    float m_run = -INFINITY, l_run = 0.f, R = 1.0f;
    float freg = 0.f; f32x4 kr[4][2], vr[4][2];
#define SL_LOAD(JT) do { const int jt_ = (JT); \
        _Pragma("unroll") for (int i = 0; i < 4; ++i) { const int hd = 4 * ub + i; \
            if (jt_ < 64) { const size_t off = ((size_t)(b * PAST + 64 * jt_ + row) * H + hd) * 64 + 8 * ch; \
                kr[i][0] = *(const f32x4*)(cK + off); kr[i][1] = *(const f32x4*)(cK + off + 4); vr[i][0] = *(const f32x4*)(cV + off); vr[i][1] = *(const f32x4*)(cV + off + 4); } \
            else if (row < 16) { const size_t off = ((size_t)(b * 16 + row) * H + hd) * 64 + 8 * ch; \
                kr[i][0] = *(const f32x4*)(nK + off); kr[i][1] = *(const f32x4*)(nK + off + 4); vr[i][0] = *(const f32x4*)(nV + off); vr[i][1] = *(const f32x4*)(nV + off + 4); } \
            else { kr[i][0] = (f32x4){0.f, 0.f, 0.f, 0.f}; kr[i][1] = kr[i][0]; vr[i][0] = kr[i][0]; vr[i][1] = kr[i][0]; } } \
        if (MODE == 0 && tid < 260) freg = tid < 256 ? (fref - Fl[64 * jt_ + (tid & 63)]) * LOG2E : KNl[jt_]; } while (0)
#define SL_STORE() do { \
        _Pragma("unroll") for (int i = 0; i < 4; ++i) { u32x4 kk, vv; \
            kk.x = cvtpk(kr[i][0][0], kr[i][0][1]); kk.y = cvtpk(kr[i][0][2], kr[i][0][3]); kk.z = cvtpk(kr[i][1][0], kr[i][1][1]); kk.w = cvtpk(kr[i][1][2], kr[i][1][3]); \
            vv.x = cvtpk(vr[i][0][0], vr[i][0][1]); vv.y = cvtpk(vr[i][0][2], vr[i][0][3]); vv.z = cvtpk(vr[i][1][0], vr[i][1][1]); vv.w = cvtpk(vr[i][1][2], vr[i][1][3]); \
            *(LAS u32x4*)(lds + i * AKS + row * 144 + ch * 16) = kk; *(LAS u32x4*)(lds + SBUF + i * AKS + row * 144 + ch * 16) = vv; } \
        if (MODE == 0 && tid < 260) *(LAS float*)(lds + 2 * SBUF + tid * 4) = freg; } while (0)
    const unsigned ldsb = (unsigned)(uintptr_t)lds;
    const unsigned krow = 32 * ((l31 >> 2) & 1) + 4 * (l31 >> 3) + (l31 & 3);
    const unsigned kofs = slot * AKS + krow * 144 + hh * 16, fofs = 2 * SBUF + slot * 256 + hh * 128;
    const unsigned va = ldsb + SBUF + slot * AKS + (32 * hh + ((lane & 15) >> 2)) * 144 + 32 * ((lane >> 4) & 1) + 8 * (lane & 3);
    SL_LOAD(64);
    if (!active) R = 0.f;
    for (int t = 64; t >= 0; --t) {
        __syncthreads();
        if (t < 64 && sb_all_done(lds, t + 1)) break;
        SL_STORE();
        __syncthreads();
        if (t > 0) SL_LOAD(t - 1);
        if (active) {
            f32x16 s0, s1;
            s_tile<MODE>(lds, kofs, fofs, qf, s0, s1);
            tile_compute<MODE>(va, s0, s1, o0, o1, m_run, l_run, R, t == 64, 64 * t + 32 * hh, qpos, hh);
        }
        if (MODE == 1) sb_post(lds, t, wave, lane, R != 0.f);
        else sb_post(lds, t, wave, lane, active && fox_notdone(qn, *(const LAS float*)(lds + 2 * SBUF + 1024 + slot * 4), *(const LAS float*)(lds + 2 * SBUF + slot * 256 + 252), m_run));
    }
#undef SL_LOAD
#undef SL_STORE
    if (MODE == 0) { const float lt = l_run + __shfl_xor(l_run, 32); const float inv = 1.0f / lt;
#pragma unroll
        for (int i = 0; i < 16; ++i) { o0[i] *= inv; o1[i] *= inv; } }
    if (active && l31 < 16) attn_store(p.CAT + (size_t)qrow * 1024 + head * 64 + 4 * hh, o0, o1);
}

template <int MODE, int H>
DI void attn_phase(const Params& p, LAS unsigned char* lds, unsigned* ctr) {
    constexpr int NS = 16 * (H / 4), NPB = 2 * H, TOTAL = NS + NPB * 32;
    volatile LAS int* slotw = (volatile LAS int*)(lds + LDS_RING);
    for (;;) {
        __syncthreads();
        if (threadIdx.x == 0) *slotw = (int)atomicAdd(ctr, 1u);
        __syncthreads();
        int u = *slotw;
        if (u >= TOTAL) break;
        if (u < NS) attn_sample<MODE, H>(p, lds, u / (H / 4), u % (H / 4));
        else { u -= NS; const int qb = 31 - u / NPB, bh = u % NPB; attn_prompt<MODE, H>(p, lds, bh / H, bh % H, qb); }
    }
}

#define XB_TMO      128
#define XB_XCNT(j)  (256  + 64 * (j))
#define XB_XSUB(j)  (1280 + 64 * (j))
#define XB_XGEN(j)  (2304 + 64 * (j))
#define XB_TOP      3328
#define XB_TOPGEN   3392
#define XCD_BAR_WORDS 3456
#define XB_SPIN_CAP (1u << 18)

__device__ __forceinline__ unsigned xb_ld(unsigned* p)              { return __hip_atomic_load(p, __ATOMIC_RELAXED, __HIP_MEMORY_SCOPE_AGENT); }
__device__ __forceinline__ unsigned xb_add(unsigned* p, unsigned v) { return __hip_atomic_fetch_add(p, v, __ATOMIC_RELAXED, __HIP_MEMORY_SCOPE_AGENT); }
__device__ __forceinline__ unsigned xb_xcc_id() { return (unsigned)__builtin_amdgcn_s_getreg((3 << 11) | 20) & 0xFu; }
#define XB_SPIN(cond, bar) do { unsigned _sp = 0; while (cond) { __builtin_amdgcn_s_sleep(1); \
    if ((++_sp & 255u) == 0u) { if (xb_ld(&(bar)[XB_TMO])) break; if (_sp > XB_SPIN_CAP) { atomicAdd(&(bar)[XB_TMO], 1u); break; } } } } while (0)

struct XcdBarrier {
    unsigned* bar; unsigned x;
    volatile LAS unsigned* st;
};

__device__ __forceinline__ XcdBarrier xcd_barrier_post(unsigned* bar, volatile LAS unsigned* st) {
    XcdBarrier b; b.bar = bar; b.x = xb_xcc_id(); b.st = st;
    if (threadIdx.x == 0) (void)xb_add(&bar[XB_XCNT(b.x)], 1u);
    return b;
}
__device__ __forceinline__ void xcd_barrier_complete(unsigned* bar, unsigned x, unsigned& nloc, unsigned& nx) {
    const unsigned G = gridDim.x * gridDim.y * gridDim.z;
    unsigned sum, cnt, mine, sp = 0u;
    for (;;) {
        sum = 0u; cnt = 0u; mine = 0u;
#pragma unroll
        for (unsigned j = 0; j < 16; ++j) { const unsigned c = xb_ld(&bar[XB_XCNT(j)]); sum += c; cnt += (c > 0u) ? 1u : 0u; mine = (j == x) ? c : mine; }
        if (sum == G) break;
        __builtin_amdgcn_s_sleep(1);
        if ((++sp & 255u) == 0u) { if (xb_ld(&bar[XB_TMO])) break; if (sp > XB_SPIN_CAP) { atomicAdd(&bar[XB_TMO], 1u); break; } }
    }
    nloc = mine > 0u ? mine : 1u; nx = cnt > 0u ? cnt : 1u;
}

__device__ __forceinline__ void xcd_barrier(const XcdBarrier& b) {
    asm volatile("s_waitcnt vmcnt(0)" ::: "memory");
    __syncthreads();
    if (threadIdx.x == 0) {
        unsigned* bar = b.bar;
        __builtin_amdgcn_s_waitcnt(0);
        unsigned nloc = b.st[0], nx = b.st[1];
        if (nloc == 0u) { xcd_barrier_complete(bar, b.x, nloc, nx); b.st[0] = nloc; b.st[1] = nx; }
        const unsigned old = xb_add(&bar[XB_XSUB(b.x)], 1u);
        const unsigned gen = old / nloc;
        if (old + 1u == (gen + 1u) * nloc) {
            __builtin_amdgcn_fence(__ATOMIC_RELEASE, "agent");
            asm volatile("s_waitcnt vmcnt(0)" ::: "memory");
            const unsigned og = xb_add(&bar[XB_TOP], 1u);
            const unsigned tg = og / nx;
            if (og + 1u == (tg + 1u) * nx) xb_add(&bar[XB_TOPGEN], 1u);
            else XB_SPIN(xb_ld(&bar[XB_TOPGEN]) == tg, bar);
            __builtin_amdgcn_fence(__ATOMIC_ACQUIRE, "agent");
            xb_add(&bar[XB_XGEN(b.x)], 1u);
            asm volatile("s_waitcnt vmcnt(0)" ::: "memory");
        } else {
            XB_SPIN(xb_ld(&bar[XB_XGEN(b.x)]) == gen, bar);
            __builtin_amdgcn_fence(__ATOMIC_ACQUIRE, "agent");
            asm volatile("s_waitcnt vmcnt(0)" ::: "memory");
        }
    }
    __syncthreads();
}

typedef const __attribute__((address_space(4))) Params* KParams;
#define LOADP(q) Params q; { KParams k_ = (KParams)__builtin_amdgcn_kernarg_segment_ptr(); asm volatile("" : "+s"(k_)); q = *k_; }
__global__ void __launch_bounds__(NTHR, 2) mega(Params p_unused) {
#if defined(__HIP_DEVICE_COMPILE__)
    extern __shared__ __attribute__((aligned(16))) unsigned char lds_raw[];
    LAS unsigned char* lds = (LAS unsigned char*)lds_raw;
    cg::grid_group grid = cg::this_grid();
    if (threadIdx.x < 2) ((volatile LAS unsigned*)(lds + LDS_RING + 16))[threadIdx.x] = 0u;
    __syncthreads();
    XcdBarrier bar;
    { LOADP(p); bar = xcd_barrier_post(p.ctl + 1024, (volatile LAS unsigned*)(lds + LDS_RING + 16)); }
#define GSYNC() xcd_barrier(bar)
    { LOADP(p); phase0(p, lds); } grid.sync();
    { LOADP(p); norm_phase<true>(p, 0, 0, p.x_prompt, p.x_sample); } GSYNC();
    { LOADP(p); EmitQkvAB e{p.Q, p.Kp, p.Vp, p.U, p.fk_p, p.fv_p, p.fk_s, p.fv_s}; gemm_all(lds, p.XN, p.Wab, 2048, 1024, e); } GSYNC();
    { LOADP(p); phase3(p, lds); } GSYNC();
    { LOADP(p); attn_phase<0, 8>(p, lds, p.ctl); } GSYNC();
    { LOADP(p); EmitRes e{p.x_prompt, p.x_sample, p.mod + 2048, p.X}; gemm_all(lds, p.CAT, p.Woab, 1024, 1024, e); } GSYNC();
    { LOADP(p); norm_phase<false>(p, 0, 1, p.X, p.X + (size_t)TP * 1024); } GSYNC();
    { LOADP(p); gemm_up(lds, p.XN, p.Wup, p.H); } GSYNC();
    { LOADP(p); EmitRes e{p.X, p.X + (size_t)TP * 1024, p.mod + 5120, p.X}; gemm_all(lds, p.H, p.Wdn, 1024, 4096, e); } GSYNC();
    { LOADP(p); norm_phase<false>(p, 1, 0, p.X, p.X + (size_t)TP * 1024); } GSYNC();
    { LOADP(p); EmitQkvSB e{p.Q, p.Kp, p.Vp, p.sk_p, p.sv_p, p.sk_s, p.sv_s}; gemm_all(lds, p.XN, p.Wsb, 3072, 1024, e); } GSYNC();
    { LOADP(p); attn_phase<1, 16>(p, lds, p.ctl + 64); } GSYNC();
    { LOADP(p); EmitRes e{p.X, p.X + (size_t)TP * 1024, p.mod + (size_t)NSEQ * 6144 + 2048, p.X}; gemm_all(lds, p.CAT, p.Wosb, 1024, 1024, e); } GSYNC();
    { LOADP(p); norm_phase<false>(p, 1, 1, p.X, p.X + (size_t)TP * 1024); } GSYNC();
    { LOADP(p); gemm_up(lds, p.XN, p.Wup + (size_t)4096 * 1024, p.H); } GSYNC();
    { LOADP(p); EmitRes e{p.X, p.X + (size_t)TP * 1024, p.mod + (size_t)NSEQ * 6144 + 5120, p.X}; gemm_all(lds, p.H, p.Wdn + (size_t)1024 * 4096, 1024, 4096, e); } GSYNC();
    { LOADP(p); final_norm_phase(p); }
#endif
}

extern "C" void kernel_launch(void* const* d_in, const int* in_sizes, int n_in, void* d_out, int out_size, void* d_ws, size_t ws_size, hipStream_t stream) {
    static int grid = 0;
    if (grid == 0) {
        int dev = 0, cus = 0, per_cu = 0;
        hipGetDevice(&dev);
        hipDeviceGetAttribute(&cus, hipDeviceAttributeMultiprocessorCount, dev);
        if (hipFuncSetAttribute((const void*)mega, hipFuncAttributeMaxDynamicSharedMemorySize, LDS_BYTES) != hipSuccess) fprintf(stderr, "kernel_launch: hipFuncSetAttribute failed\n");
        if (hipOccupancyMaxActiveBlocksPerMultiprocessor(&per_cu, (const void*)mega, NTHR, LDS_BYTES) != hipSuccess || per_cu < 1) { fprintf(stderr, "kernel_launch: occupancy query says %d\n", per_cu); per_cu = 1; }
        (void)hipGetLastError();
        if (per_cu > 1) per_cu = 1;
        grid = cus * per_cu;
        if (n_in != 23 || out_size != 68428800 || ws_size < ((size_t)446 << 20)) fprintf(stderr, "kernel_launch: unexpected sizes n_in %d out %d ws %zu\n", n_in, out_size, ws_size);
    }
    const float* const* in = (const float* const*)d_in;
    Params p{};
    p.x_prompt = in[0]; p.x_sample = in[1]; p.c_prompt = in[2]; p.c_sample = in[3]; p.cfk = in[4]; p.cfv = in[5]; p.cfl = in[6]; p.spool = in[7]; p.csk = in[8]; p.csv = in[9];
    p.w_ada = in[10]; p.b_ada = in[11]; p.norm_g = in[12]; p.w_in_ab = in[13]; p.b_forget = in[14]; p.w_pool = in[15]; p.pool_scale = in[16]; p.w_out_ab = in[17];
    p.w_in_sb = in[18]; p.w_out_sb = in[19]; p.w_up = in[20]; p.w_down = in[21]; p.final_g = in[22];
    float* o = (float*)d_out;
    p.y_p = o; p.y_s = o + 16777216; p.fk_p = o + 17039360; p.fv_p = o + 25427968; p.fl_p = o + 33816576; p.pool_p = o + 33947648; p.sk_p = o + 33963008; p.sv_p = o + 50740224;
    p.fk_s = o + 67517440; p.fv_s = o + 67648512; p.fl_s = o + 67779584; p.pool_s = o + 67781632; p.sk_s = o + 67904512; p.sv_s = o + 68166656;
    unsigned char* ws = (unsigned char*)d_ws; const size_t MB = (size_t)1 << 20;
    p.ctl = (unsigned*)ws; p.mod = (float*)(ws + 1 * MB); p.Wf = (float*)(ws + 2 * MB); p.Fp = (float*)(ws + 3 * MB); p.Fs = (float*)(ws + 4 * MB); p.KNp = (float*)(ws + 7 * MB); p.KNs = (float*)(ws + 7 * MB + 65536);
    p.Wab = (bf16_t*)(ws + 8 * MB); p.Woab = (bf16_t*)(ws + 12 * MB); p.Wsb = (bf16_t*)(ws + 14 * MB); p.Wosb = (bf16_t*)(ws + 20 * MB); p.Wup = (bf16_t*)(ws + 22 * MB); p.Wdn = (bf16_t*)(ws + 38 * MB);
    p.XN = (bf16_t*)(ws + 54 * MB); p.X = (float*)(ws + 87 * MB); p.Q = (bf16_t*)(ws + 152 * MB); p.Kp = (bf16_t*)(ws + 185 * MB); p.Vp = (bf16_t*)(ws + 217 * MB);
    p.U = (float*)(ws + 249 * MB); p.CAT = (bf16_t*)(ws + 282 * MB); p.H = (bf16_t*)(ws + 315 * MB);
    (void)hipMemsetAsync(ws, 0, 32768, stream);
    void* args[] = {&p};
    hipError_t e = hipLaunchCooperativeKernel((const void*)mega, dim3(grid), dim3(NTHR), args, LDS_BYTES, stream);
    if (e != hipSuccess) fprintf(stderr, "kernel_launch: cooperative launch failed: %s (grid %d)\n", hipGetErrorString(e), grid);
}
```

```cpp
#include <hip/hip_runtime.h>
#include <hip/hip_cooperative_groups.h>
#include <cstdio>
#include <cstdint>
namespace cg = cooperative_groups;
__device__ __forceinline__ int tid_l() { int t = threadIdx.x; asm volatile("" : "+v"(t)); return t; }
namespace pg8 {
#define PG8_LAS __attribute__((address_space(3)))
typedef unsigned short bf16_t;
typedef short bf16x8 __attribute__((ext_vector_type(8)));
typedef float f32x4 __attribute__((ext_vector_type(4)));
typedef unsigned u32x4 __attribute__((ext_vector_type(4)));
constexpr int BM = 256, BK = 64, HALF = 128, HTB = HALF * BK * 2  , STAGE_BYTES = 8 * HTB, NXCD = 8, WGM = 8;

__host__ __device__ __forceinline__ int lds_byte(int r, int c) { const int st = (r >> 4) * 2 + (c >> 5), rr = r & 15, cc = c & 31, ob = rr * 64 + cc * 2; return st * 1024 + (ob ^ (((ob >> 9) & 1) << 5)); }
__host__ __device__ __forceinline__ void stage_rc(int b, int& R, int& C) { const int st = b / 1024, sb = b % 1024, swz = sb ^ (((sb >> 9) & 1) << 5); R = (st >> 1) * 16 + swz / 64; C = (st & 1) * 32 + (swz % 64) / 2; }
__host__ __device__ __forceinline__ int perm32(int rho) { const int n = rho >> 4, i = rho & 15; return 8 * (i >> 2) + 4 * n + (i & 3); }

struct Unit { int pm, pn; };
struct Gemm { const bf16_t* A; const bf16_t* Bt; int M, N, K; };

struct StaticOrder {
    int nM, nN, nwg, G, c;
    __host__ __device__ void init(int M, int N, int G_, int c_) { nM = M / BM; nN = N / BM; nwg = nM * nN; G = G_; c = c_; }
    __host__ __device__ bool next(int i, Unit& u) const {
        const long L = (long)i * G + c; if (L >= nwg) return false;
        int wgid = (int)L; { const int q = nwg / NXCD, r = nwg % NXCD, xcd = wgid % NXCD, off = wgid / NXCD; wgid = (xcd < r ? xcd * (q + 1) : r * (q + 1) + (xcd - r) * q) + off; }
        const int nig = WGM * nN, gid = wgid / nig, fm = gid * WGM, gsz = (nM - fm) < WGM ? (nM - fm) : WGM;
        u.pm = fm + ((wgid % nig) % gsz); u.pn = (wgid % nig) / gsz; return true;
    }
    __device__ __forceinline__ void a_ready(const Unit&) const {}
    __device__ __forceinline__ void done(const Unit&) const {}
};

__device__ __forceinline__ unsigned cvt_pk_bf16(float lo, float hi) { unsigned r; asm volatile("v_cvt_pk_bf16_f32 %0, %1, %2" : "=v"(r) : "v"(lo), "v"(hi)); return r; }
template <class Epi, class Sched, bool ALIGN_EPI = false, bool SP2 = false>
__device__ __forceinline__ void gemm_phase(PG8_LAS unsigned char* lds, const Gemm g, const Sched& S, const Epi& E) {
    const int tid = tid_l(), wid = __builtin_amdgcn_readfirstlane(tid >> 6), lane = tid & 63, wr = wid >> 2, wc = wid & 3, fr = lane & 15, fq = lane >> 4;
    const int K = g.K, nt = K / BK;
    unsigned voffA[2], voffB[2];
#pragma unroll
    for (int i = 0; i < 2; ++i) { int R, C; stage_rc(tid * 16 + i * 8192, R, C); const int Rb = Epi::PERM ? ((R & ~31) + perm32(R & 31)) : R;
        voffA[i] = (unsigned)(R * K + C) * 2u; voffB[i] = (unsigned)(Rb * K + C) * 2u; }
    const size_t kstep = (size_t)(BK * 2);
    const size_t hstep = (size_t)HALF * K * 2;
    const size_t tstep = 2 * hstep;
    const unsigned ldsw = (unsigned)wid * 1024u;
    const int aoff = lds_byte(wr * 64 + fr, fq * 8), boff = lds_byte(wc * 32 + fr, fq * 8);
#define PG8_SA(b, h) (((b) * 2 + (h)) * HTB)
#define PG8_SB(b, h) ((4 + (b) * 2 + (h)) * HTB)
#define PG8_STAGE(bufoff, gbase, voff) do { _Pragma("unroll") for (int _i = 0; _i < 2; ++_i) \
        __builtin_amdgcn_global_load_lds((const unsigned*)((const char*)(gbase) + (voff)[_i]), (PG8_LAS unsigned*)(lds + (bufoff) + ldsw + _i * 8192), 16, 0, 0); } while (0)
#define PG8_LDA(dst, b, h) do { _Pragma("unroll") for (int m = 0; m < 4; ++m) _Pragma("unroll") for (int k = 0; k < 2; ++k) dst[m][k] = *(const PG8_LAS bf16x8*)(lds + PG8_SA(b, h) + aoff + m * 2048 + k * 1024); } while (0)
#define PG8_LDB(dst, b, h) do { _Pragma("unroll") for (int n = 0; n < 2; ++n) _Pragma("unroll") for (int k = 0; k < 2; ++k) dst[n][k] = *(const PG8_LAS bf16x8*)(lds + PG8_SB(b, h) + boff + n * 2048 + k * 1024); } while (0)
#define PG8_MMA(ai, bj, At, Bt) do { __builtin_amdgcn_s_setprio(1); _Pragma("unroll") for (int m = 0; m < 4; ++m) _Pragma("unroll") for (int n = 0; n < 2; ++n) _Pragma("unroll") for (int k = 0; k < 2; ++k) \
        acc[ai][bj][m][n] = __builtin_amdgcn_mfma_f32_16x16x32_bf16(Bt[n][k], At[m][k], acc[ai][bj][m][n], 0, 0, 0); __builtin_amdgcn_s_setprio(0); } while (0)
#define PG8_WAIT_V(n) asm volatile("s_waitcnt vmcnt(" #n ")" ::: "memory")
#define PG8_WAIT_L(n) asm volatile("s_waitcnt lgkmcnt(" #n ")" ::: "memory")
#define PG8_BAR __builtin_amdgcn_s_barrier()
#define PG8_SCHED __builtin_amdgcn_sched_barrier(0)
    Unit cur, nxt; int ui = 0;
    if (!S.next(0, cur)) return;
    f32x4 acc[2][2][4][2];
#pragma unroll
    for (int a = 0; a < 2; ++a)
#pragma unroll
        for (int b = 0; b < 2; ++b)
#pragma unroll
            for (int m = 0; m < 4; ++m)
#pragma unroll
                for (int n = 0; n < 2; ++n) acc[a][b][m][n] = (f32x4){0.f, 0.f, 0.f, 0.f};
    bf16x8 At[4][2], B0[2][2], B1[2][2];
    const char* cA = (const char*)g.A + (size_t)cur.pm * tstep; const char* cB = (const char*)g.Bt + (size_t)cur.pn * tstep;
    S.a_ready(cur);
    if constexpr (SP2) {
        PG8_STAGE(PG8_SB(0, 0), cB, voffB); PG8_STAGE(PG8_SB(0, 1), cB + hstep, voffB); PG8_STAGE(PG8_SA(0, 0), cA, voffA); PG8_STAGE(PG8_SA(0, 1), cA + hstep, voffA);
        if (wr == 1) PG8_BAR;
        PG8_WAIT_V(2); PG8_BAR;
        PG8_STAGE(PG8_SB(1, 0), cB + kstep, voffB); PG8_STAGE(PG8_SA(1, 0), cA + kstep, voffA); PG8_STAGE(PG8_SB(1, 1), cB + hstep + kstep, voffB);
        PG8_WAIT_V(6); PG8_BAR;
    } else {
        PG8_STAGE(PG8_SB(0, 0), cB, voffB); PG8_STAGE(PG8_SA(0, 0), cA, voffA); PG8_STAGE(PG8_SB(0, 1), cB + hstep, voffB); PG8_STAGE(PG8_SA(0, 1), cA + hstep, voffA);
        if (wr == 1) PG8_BAR;
        PG8_WAIT_V(4); PG8_BAR;
        PG8_STAGE(PG8_SB(1, 0), cB + kstep, voffB); PG8_STAGE(PG8_SA(1, 0), cA + kstep, voffA); PG8_STAGE(PG8_SB(1, 1), cB + hstep + kstep, voffB);
        PG8_WAIT_V(6); PG8_BAR;
    }
    for (;;) {
        const bool has_next = S.next(ui + 1, nxt);
        const char* nA = has_next ? (const char*)g.A + (size_t)nxt.pm * tstep : cA; const char* nB = has_next ? (const char*)g.Bt + (size_t)nxt.pn * tstep : cB;
        for (int t = 0; t < nt; t += 2) {
            const bool last = (t == nt - 2);
            const char* a1 = cA + (size_t)(t + 1) * kstep;
            const char* a2 = last ? nA : cA + (size_t)(t + 2) * kstep; const char* b2 = last ? nB : cB + (size_t)(t + 2) * kstep;
            const char* a3 = a2 + kstep; const char* b3 = b2 + kstep;
            if (last && has_next) S.a_ready(nxt);
            if constexpr (SP2) {
            PG8_LDB(B0, 0, 0); PG8_LDB(B1, 0, 1); PG8_SCHED; PG8_LDA(At, 0, 0); PG8_STAGE(PG8_SA(1, 1), a1 + hstep, voffA);
            PG8_WAIT_V(8); PG8_WAIT_L(0); PG8_BAR; PG8_MMA(0, 0, At, B0); PG8_MMA(0, 1, At, B1); PG8_BAR; PG8_SCHED;
            PG8_LDA(At, 0, 1); PG8_STAGE(PG8_SB(0, 0), b2, voffB); PG8_STAGE(PG8_SB(0, 1), b2 + hstep, voffB); PG8_STAGE(PG8_SA(0, 0), a2, voffA);
            PG8_WAIT_V(8); PG8_WAIT_L(0); PG8_BAR; PG8_MMA(1, 0, At, B0); PG8_MMA(1, 1, At, B1); PG8_BAR; PG8_SCHED;
            PG8_LDB(B0, 1, 0); PG8_LDB(B1, 1, 1); PG8_SCHED; PG8_LDA(At, 1, 0); PG8_STAGE(PG8_SA(0, 1), a2 + hstep, voffA);
            PG8_WAIT_V(8); PG8_WAIT_L(0); PG8_BAR; PG8_MMA(0, 0, At, B0); PG8_MMA(0, 1, At, B1); PG8_BAR; PG8_SCHED;
            PG8_LDA(At, 1, 1); PG8_STAGE(PG8_SB(1, 0), b3, voffB); PG8_STAGE(PG8_SB(1, 1), b3 + hstep, voffB); PG8_STAGE(PG8_SA(1, 0), a3, voffA);
            PG8_WAIT_V(8); PG8_WAIT_L(0); PG8_BAR; PG8_MMA(1, 0, At, B0); PG8_MMA(1, 1, At, B1); PG8_BAR; PG8_SCHED;
            } else {
            PG8_LDB(B0, 0, 0); PG8_SCHED; PG8_LDA(At, 0, 0); PG8_STAGE(PG8_SA(1, 1), a1 + hstep, voffA);
            PG8_WAIT_L(8); PG8_BAR; PG8_WAIT_L(0); PG8_MMA(0, 0, At, B0); PG8_BAR; PG8_SCHED;
            PG8_LDB(B1, 0, 1); PG8_STAGE(PG8_SB(0, 0), b2, voffB);
            PG8_BAR; PG8_WAIT_L(0); PG8_MMA(0, 1, At, B1); PG8_BAR;
            PG8_LDA(At, 0, 1); PG8_STAGE(PG8_SA(0, 0), a2, voffA);
            PG8_BAR; PG8_WAIT_L(0); PG8_MMA(1, 0, At, B0); PG8_BAR; PG8_SCHED;
            PG8_STAGE(PG8_SB(0, 1), b2 + hstep, voffB);
            PG8_WAIT_V(6); PG8_BAR; PG8_MMA(1, 1, At, B1); PG8_BAR;
            PG8_LDB(B0, 1, 0); PG8_SCHED; PG8_LDA(At, 1, 0); PG8_STAGE(PG8_SA(0, 1), a2 + hstep, voffA);
            PG8_WAIT_L(8); PG8_BAR; PG8_WAIT_L(0); PG8_MMA(0, 0, At, B0); PG8_BAR; PG8_SCHED;
            PG8_LDB(B1, 1, 1); PG8_STAGE(PG8_SB(1, 0), b3, voffB);
            PG8_BAR; PG8_WAIT_L(0); PG8_MMA(0, 1, At, B1); PG8_BAR;
            PG8_LDA(At, 1, 1); PG8_STAGE(PG8_SA(1, 0), a3, voffA);
            PG8_BAR; PG8_WAIT_L(0); PG8_MMA(1, 0, At, B0); PG8_BAR; PG8_SCHED;
            PG8_STAGE(PG8_SB(1, 1), b3 + hstep, voffB);
            PG8_WAIT_V(6); PG8_BAR; PG8_MMA(1, 1, At, B1); PG8_BAR;
            }
        }
        if constexpr (ALIGN_EPI) { if (wr == 0) PG8_BAR; }
        if constexpr (!Epi::AFTER_DRAIN) { E(acc, cur, wr, wc, fr, fq); S.done(cur); }
        if (!has_next) break;
#pragma unroll
        for (int a = 0; a < 2; ++a)
#pragma unroll
            for (int b = 0; b < 2; ++b)
#pragma unroll
                for (int m = 0; m < 4; ++m)
#pragma unroll
                    for (int n = 0; n < 2; ++n) acc[a][b][m][n] = (f32x4){0.f, 0.f, 0.f, 0.f};
        cur = nxt; cA = nA; cB = nB; ++ui;
        if constexpr (ALIGN_EPI) { if (wr == 1) PG8_BAR; }
    }
    PG8_WAIT_V(0);
    if constexpr (!ALIGN_EPI) { if (wr == 0) PG8_BAR; }
    PG8_BAR;
    if constexpr (Epi::AFTER_DRAIN) { E.fused(acc, cur, wr, wc, fr, fq, lds, wid, lane); S.done(cur); }
#undef PG8_SA
#undef PG8_SB
#undef PG8_STAGE
#undef PG8_LDA
#undef PG8_LDB
#undef PG8_MMA
#undef PG8_WAIT_V
#undef PG8_WAIT_L
#undef PG8_BAR
#undef PG8_SCHED
}
}

#define LAS __attribute__((address_space(3)))
typedef unsigned short bf16_t;
typedef short bf16x8 __attribute__((ext_vector_type(8)));
typedef short s16x4 __attribute__((ext_vector_type(4)));
typedef float f32x4 __attribute__((ext_vector_type(4)));
typedef float f32x16 __attribute__((ext_vector_type(16)));
typedef unsigned u32x4 __attribute__((ext_vector_type(4)));
typedef unsigned u32x2 __attribute__((ext_vector_type(2)));
typedef float f32x2_t __attribute__((ext_vector_type(2)));
typedef __bf16 bf16x2_t __attribute__((ext_vector_type(2)));

constexpr int TP = 16384, TS = 256, TT = TP + TS, DM = 1024, DFF = 4096;
constexpr int SEQ = 8192, PAST = 4096, LPAD = 4160, NSEQ = 18;
constexpr float LOG2E = 1.4426950408889634f;
constexpr int NTHR = 512, NWV = 8;
constexpr int LDS_RING = 131072, LDS_BYTES = LDS_RING + 1024;

struct Params {
    const float *x_prompt, *x_sample, *c_prompt, *c_sample, *cfk, *cfv, *cfl, *spool, *csk, *csv;
    const float *w_ada, *b_ada, *norm_g, *w_in_ab, *b_forget, *w_pool, *pool_scale, *w_out_ab, *w_in_sb, *w_out_sb, *w_up, *w_down, *final_g;
    float *y_p, *y_s, *fk_p, *fv_p, *fl_p, *pool_p, *sk_p, *sv_p, *fk_s, *fv_s, *fl_s, *pool_s, *sk_s, *sv_s;
    unsigned* ctl; float *mod, *Wf, *Fp, *Fs, *KNp, *KNs;
    bf16_t *Wab, *Woab, *Wsb, *Wosb, *Wup, *Wdn, *XN;
    float* X; bf16_t *Q, *Kp, *Vp; float* U; bf16_t *CAT, *H;
};

#define DI __device__ __forceinline__
DI unsigned cvtpk(float lo, float hi) { f32x2_t v = {lo, hi}; bf16x2_t b = __builtin_convertvector(v, bf16x2_t); return __builtin_bit_cast(unsigned, b); }
DI int seq_of(int t) { return t < TP ? (t >> 13) : 2 + ((t - TP) >> 4); }
DI float wave_sum(float v) {
#pragma unroll
    for (int o = 1; o < 64; o <<= 1) v += __shfl_xor(v, o);
    return v;
}
DI void st_bf4(bf16_t* p, f32x4 v) { u32x2 w; w.x = cvtpk(v[0], v[1]); w.y = cvtpk(v[2], v[3]); *(u32x2*)p = w; }
#define LDS_WAIT() asm volatile("s_waitcnt lgkmcnt(0)" ::: "memory")

DI void tr_item(const float* W, int ldw, int k0, int c0, bf16_t* WT, int ldt, int r0, int kd0, LAS float* scr, int lane) {
#pragma unroll 32
    for (int i = 0; i < 32; ++i) { const int kk = 2 * i + (lane >> 5); scr[kk * 33 + (lane & 31)] = W[(size_t)(k0 + kk) * ldw + c0 + (lane & 31)]; }
    LDS_WAIT();
    const int c = lane & 7;
#pragma unroll
    for (int j = 0; j < 4; ++j) { const int n = (lane >> 3) + 8 * j; const LAS float* s = scr + (8 * c) * 33 + n;
        u32x4 o; o.x = cvtpk(s[0 * 33], s[1 * 33]); o.y = cvtpk(s[2 * 33], s[3 * 33]); o.z = cvtpk(s[4 * 33], s[5 * 33]); o.w = cvtpk(s[6 * 33], s[7 * 33]);
        *(u32x4*)(WT + (size_t)(r0 + n) * ldt + kd0 + 8 * c) = o; }
    LDS_WAIT();
}

DI void phase0(const Params& p, LAS unsigned char* lds) {
    const int tid = tid_l(), lane = tid & 63, wave = tid >> 6;
    if ((int)blockIdx.x < 192) {
        LAS float* cond = (LAS float*)lds;
        LAS float* red = (LAS float*)(lds + 73728);
        for (int i = tid; i < NSEQ * 1024; i += NTHR) { const int s = i >> 10, k = i & 1023; const float c = s < 2 ? p.c_prompt[s * 1024 + k] : p.c_sample[(s - 2) * 1024 + k]; cond[i] = c / (1.0f + expf(-c)); }
        __syncthreads();
        for (int item = blockIdx.x; item < 192; item += gridDim.x) {
            const int layer = item / 96, col0 = (item % 96) * 64, quad = tid & 15, kc = tid >> 4;
            float acc[NSEQ][4];
#pragma unroll
            for (int s = 0; s < NSEQ; ++s) { acc[s][0] = 0.f; acc[s][1] = 0.f; acc[s][2] = 0.f; acc[s][3] = 0.f; }
            const float* wp = p.w_ada + ((size_t)layer * 1024 + kc * 32) * 6144 + col0 + 4 * quad;
#pragma unroll 4
            for (int kk = 0; kk < 32; ++kk) { const f32x4 w = *(const f32x4*)(wp + (size_t)kk * 6144);
#pragma unroll
                for (int s = 0; s < NSEQ; ++s) { const float cs = cond[s * 1024 + kc * 32 + kk]; acc[s][0] += cs * w[0]; acc[s][1] += cs * w[1]; acc[s][2] += cs * w[2]; acc[s][3] += cs * w[3]; } }
#pragma unroll
            for (int s = 0; s < NSEQ; ++s)
#pragma unroll
                for (int j = 0; j < 4; ++j) { float v = acc[s][j]; v += __shfl_xor(v, 16); v += __shfl_xor(v, 32); if (lane < 16) red[((wave * 16 + quad) * NSEQ + s) * 4 + j] = v; }
            __syncthreads();
            for (int o = tid; o < 16 * NSEQ * 4; o += NTHR) { const int qd = o / (NSEQ * 4), rem = o % (NSEQ * 4), s = rem >> 2, j = rem & 3; float sum = 0.f;
#pragma unroll
                for (int w = 0; w < 8; ++w) sum += red[((w * 16 + qd) * NSEQ + s) * 4 + j];
                const int col = col0 + 4 * qd + j; p.mod[((size_t)layer * NSEQ + s) * 6144 + col] = sum + p.b_ada[layer * 6144 + col]; }
            __syncthreads();
        }
    }
    for (int it = (int)gridDim.x - 1 - (int)blockIdx.x; it < 128; it += gridDim.x) {
        const int g = it >> 5, rem = it & 31, cblk = rem >> 1, n = (rem & 1) * 512 + tid;
        LAS float* wps = (LAS float*)lds;
        __syncthreads();
        for (int i = tid; i < 1024; i += NTHR) { const int j = i >> 7, e = i & 127; wps[i] = p.w_pool[((g * 128) + cblk * 8 + j) * 128 + e] * p.pool_scale[128 * g + e]; }
        __syncthreads();
        float acc[8];
#pragma unroll
        for (int j = 0; j < 8; ++j) acc[j] = 0.f;
        const float* wo = p.w_out_ab + (size_t)(512 + 128 * g) * 1024 + n;
#pragma unroll 8
        for (int e = 0; e < 128; ++e) { const float wv = wo[(size_t)e * 1024];
#pragma unroll
            for (int j = 0; j < 8; ++j) acc[j] += wps[j * 128 + e] * wv; }
        u32x4 o; o.x = cvtpk(acc[0], acc[1]); o.y = cvtpk(acc[2], acc[3]); o.z = cvtpk(acc[4], acc[5]); o.w = cvtpk(acc[6], acc[7]);
        *(u32x4*)(p.Woab + (size_t)n * 1024 + 512 + 128 * g + cblk * 8) = o;
    }
    for (int i = blockIdx.x * NTHR + tid; i < 8192; i += gridDim.x * NTHR) { const int h = i >> 10, k = i & 1023; p.Wf[i] = p.w_in_ab[(size_t)k * 2056 + 1536 + h]; }
    __syncthreads();
    LAS float* scr = (LAS float*)(lds + wave * 16384);
    const int gw = blockIdx.x * NWV + wave, NGW = gridDim.x * NWV;
    constexpr int NITEMS = 1024 + 256 + 1536 + 512 + 4096 + 4096;
    for (int it = gw; it < NITEMS; it += NGW) {
        int r = it;
        if (r < 1024) { const int kb = r >> 6, n0 = (r & 63) * 32, c0 = n0 < 1536 ? n0 : n0 + 8; tr_item(p.w_in_ab, 2056, kb * 64, c0, p.Wab, 1024, n0, kb * 64, scr, lane); continue; } r -= 1024;
        if (r < 256) { const int kb = r >> 5, n0 = (r & 31) * 32; tr_item(p.w_out_ab, 1024, kb * 64, n0, p.Woab, 1024, n0, kb * 64, scr, lane); continue; } r -= 256;
        if (r < 1536) { const int kb = r / 96, n0 = (r % 96) * 32; tr_item(p.w_in_sb, 3072, kb * 64, n0, p.Wsb, 1024, n0, kb * 64, scr, lane); continue; } r -= 1536;
        if (r < 512) { const int kb = r >> 5, n0 = (r & 31) * 32; tr_item(p.w_out_sb, 1024, kb * 64, n0, p.Wosb, 1024, n0, kb * 64, scr, lane); continue; } r -= 512;
        if (r < 4096) { const int layer = r >> 11, r2 = r & 2047, kb = r2 >> 7, n0 = (r2 & 127) * 32;
            tr_item(p.w_up + (size_t)layer * 1024 * 4096, 4096, kb * 64, n0, p.Wup + (size_t)layer * 4096 * 1024, 1024, n0, kb * 64, scr, lane); continue; } r -= 4096;
        { const int layer = r >> 11, r2 = r & 2047, kb = r2 >> 5, n0 = (r2 & 31) * 32;
            tr_item(p.w_down + (size_t)layer * 4096 * 1024, 1024, kb * 64, n0, p.Wdn + (size_t)layer * 1024 * 4096, 4096, n0, kb * 64, scr, lane); }
    }
}

template <bool FLOGIT>
DI void norm_phase(const Params& p, int layer, int which, const float* xin_p, const float* xin_s) {
    const int tid = tid_l(), lane = tid & 63, wave = tid >> 6;
    const int gw = blockIdx.x * NWV + wave, NGW = gridDim.x * NWV;
    const float* gptr = p.norm_g + (layer * 2 + which) * 1024;
    constexpr int NR = FLOGIT ? 1 : 4;
    for (int t0 = gw; t0 < TT; t0 += NR * NGW) {
        f32x4 v[NR][4];
#pragma unroll
        for (int r = 0; r < NR; ++r) { const int t = t0 + r * NGW; const int tc = t < TT ? t : t0;
            const float* xr = tc < TP ? xin_p + (size_t)tc * 1024 : xin_s + (size_t)(tc - TP) * 1024;
#pragma unroll
            for (int j = 0; j < 4; ++j) v[r][j] = *(const f32x4*)(xr + 4 * lane + 256 * j); }
#pragma unroll
        for (int r = 0; r < NR; ++r) { const int t = t0 + r * NGW;
            if (t < TT) {
                const float* md = p.mod + ((size_t)layer * NSEQ + seq_of(t)) * 6144 + (which ? 3072 : 0);
                float ss = 0.f;
#pragma unroll
                for (int j = 0; j < 4; ++j) ss += (v[r][j][0] * v[r][j][0] + v[r][j][1] * v[r][j][1]) + (v[r][j][2] * v[r][j][2] + v[r][j][3] * v[r][j][3]);
                const float rstd = 1.0f / sqrtf(wave_sum(ss) * (1.0f / 1024.0f) + 1e-6f);
                float fd[8];
#pragma unroll
                for (int h = 0; h < 8; ++h) fd[h] = 0.f;
#pragma unroll
                for (int j = 0; j < 4; ++j) { const int col = 4 * lane + 256 * j;
                    const f32x4 g = *(const f32x4*)(gptr + col), sh = *(const f32x4*)(md + col), sc = *(const f32x4*)(md + 1024 + col);
                    f32x4 y;
#pragma unroll
                    for (int e = 0; e < 4; ++e) y[e] = (v[r][j][e] * rstd * g[e]) * (1.0f + sc[e]) + sh[e];
                    st_bf4(p.XN + (size_t)t * 1024 + col, y);
                    if (FLOGIT) {
#pragma unroll
                        for (int h = 0; h < 8; ++h) { const f32x4 w = *(const f32x4*)(p.Wf + h * 1024 + col); fd[h] += (y[0] * w[0] + y[1] * w[1]) + (y[2] * w[2] + y[3] * w[3]); } }
                }
                if (FLOGIT) {
                    float mine = 0.f;
#pragma unroll
                    for (int h = 0; h < 8; ++h) { const float s = wave_sum(fd[h]); if (lane == h) mine = s; }
                    if (lane < 8) { const float z = mine + p.b_forget[lane]; const float lf = fminf(z, 0.f) - log1pf(expf(-fabsf(z)));
                        if (t < TP) p.fl_p[(size_t)t * 8 + lane] = lf; else p.fl_s[(size_t)(t - TP) * 8 + lane] = lf; }
                }
            }
        }
    }
}
DI void final_norm_phase(const Params& p) {
    const int tid = tid_l(), lane = tid & 63, wave = tid >> 6;
    const int gw = blockIdx.x * NWV + wave, NGW = gridDim.x * NWV;
    for (int t0 = gw; t0 < TT; t0 += 4 * NGW) {
        f32x4 v[4][4];
#pragma unroll
        for (int r = 0; r < 4; ++r) { const int t = t0 + r * NGW; const int tc = t < TT ? t : t0; const float* xr = p.X + (size_t)tc * 1024;
#pragma unroll
            for (int j = 0; j < 4; ++j) v[r][j] = *(const f32x4*)(xr + 4 * lane + 256 * j); }
#pragma unroll
        for (int r = 0; r < 4; ++r) { const int t = t0 + r * NGW;
            if (t < TT) {
                float* yr = t < TP ? p.y_p + (size_t)t * 1024 : p.y_s + (size_t)(t - TP) * 1024;
                float ss = 0.f;
#pragma unroll
                for (int j = 0; j < 4; ++j) ss += (v[r][j][0] * v[r][j][0] + v[r][j][1] * v[r][j][1]) + (v[r][j][2] * v[r][j][2] + v[r][j][3] * v[r][j][3]);
                const float rstd = 1.0f / sqrtf(wave_sum(ss) * (1.0f / 1024.0f) + 1e-6f);
#pragma unroll
                for (int j = 0; j < 4; ++j) { const int col = 4 * lane + 256 * j; const f32x4 g = *(const f32x4*)(p.final_g + col); f32x4 y;
#pragma unroll
                    for (int e = 0; e < 4; ++e) y[e] = v[r][j][e] * rstd * g[e];
                    *(f32x4*)(yr + col) = y; }
            }
        }
    }
}

struct EmitQkvAB { bf16_t *Q, *Kp, *Vp; float *U, *fk_p, *fv_p, *fk_s, *fv_s;
    DI void emit(int t, int c, f32x4 v) const {
        if (c < 512) { st_bf4(Q + (size_t)t * 512 + c, v * (0.125f * LOG2E)); }
        else if (c < 1024) { const int cc = c - 512; if (t < TP) { st_bf4(Kp + (size_t)t * 512 + cc, v); *(f32x4*)(fk_p + (size_t)t * 512 + cc) = v; } else *(f32x4*)(fk_s + (size_t)(t - TP) * 512 + cc) = v; }
        else if (c < 1536) { const int cc = c - 1024; if (t < TP) { st_bf4(Vp + (size_t)t * 512 + cc, v); *(f32x4*)(fv_p + (size_t)t * 512 + cc) = v; } else *(f32x4*)(fv_s + (size_t)(t - TP) * 512 + cc) = v; }
        else { *(f32x4*)(U + (size_t)t * 512 + (c - 1536)) = v; }
    } };
struct EmitQkvSB { bf16_t *Q, *Kp, *Vp; float *sk_p, *sv_p, *sk_s, *sv_s;
    DI void emit(int t, int c, f32x4 v) const {
        if (c < 1024) { st_bf4(Q + (size_t)t * 1024 + c, v * (0.125f * LOG2E)); }
        else if (c < 2048) { const int cc = c - 1024; if (t < TP) { st_bf4(Kp + (size_t)t * 1024 + cc, v); *(f32x4*)(sk_p + (size_t)t * 1024 + cc) = v; } else *(f32x4*)(sk_s + (size_t)(t - TP) * 1024 + cc) = v; }
        else { const int cc = c - 2048; if (t < TP) { st_bf4(Vp + (size_t)t * 1024 + cc, v); *(f32x4*)(sv_p + (size_t)t * 1024 + cc) = v; } else *(f32x4*)(sv_s + (size_t)(t - TP) * 1024 + cc) = v; }
    } };
struct EmitRes { const float* xin_p; const float* xin_s; const float* modg; float* X;
    DI void emit(int t, int c, f32x4 v) const {
        const float* xr = t < TP ? xin_p + (size_t)t * 1024 : xin_s + (size_t)(t - TP) * 1024;
        const f32x4 x = *(const f32x4*)(xr + c), g = *(const f32x4*)(modg + (size_t)seq_of(t) * 6144 + c);
        *(f32x4*)(X + (size_t)t * 1024 + c) = x + g * v;
    } };
struct EmitUp { bf16_t* H;
    DI void emit(int t, int c, f32x4 v) const { f32x4 r;
#pragma unroll
        for (int e = 0; e < 4; ++e) { const float a = fmaxf(v[e], 0.f); r[e] = a * a; }
        st_bf4(H + (size_t)t * 4096 + c, r); } };

template <class F> struct EpiEmit {
    static constexpr bool PERM = false, AFTER_DRAIN = false;
    F f;
    DI void operator()(const pg8::f32x4 (&acc)[2][2][4][2], const pg8::Unit& u, int wr, int wc, int fr, int fq) const {
        const int row0 = u.pm * 256 + wr * 64 + fr, col0 = u.pn * 256 + wc * 32 + 4 * fq;
#pragma unroll
        for (int ai = 0; ai < 2; ++ai)
#pragma unroll
            for (int m = 0; m < 4; ++m)
#pragma unroll
                for (int bj = 0; bj < 2; ++bj)
#pragma unroll
                    for (int n = 0; n < 2; ++n) f.emit(row0 + ai * 128 + m * 16, col0 + bj * 128 + n * 16, acc[ai][bj][m][n]);
    }
};

template <class F, int KS>
DI void skinny_gemm(LAS unsigned char* lds, const bf16_t* A, const bf16_t* Bt, int N, int K, const F& f) {
    const int tid = tid_l(), lane = tid & 63, wave = tid >> 6, fr = lane & 15, fq = lane >> 4;
    constexpr int WPB = 8 / KS;
    const int wsub = wave % WPB, kh = wave / WPB, Kh = K / KS;
    LAS f32x4* red = (LAS f32x4*)lds;
    for (int item0 = blockIdx.x * WPB; item0 < N; item0 += gridDim.x * WPB) {
        const int item = item0 + wsub, rb = item & 15, cb = item >> 4;
        const bf16_t* ap = A + (size_t)(rb * 16 + fr) * K + kh * Kh + 8 * fq;
        const bf16_t* bp = Bt + (size_t)(cb * 16 + fr) * K + kh * Kh + 8 * fq;
        f32x4 acc = {0.f, 0.f, 0.f, 0.f};
        for (int ks = 0; ks < Kh; ks += 512) {
            bf16x8 a[16], b[16];
#pragma unroll
            for (int i = 0; i < 16; ++i) { a[i] = *(const bf16x8*)(ap + ks + 32 * i); b[i] = *(const bf16x8*)(bp + ks + 32 * i); }
#pragma unroll
            for (int i = 0; i < 16; ++i) acc = __builtin_amdgcn_mfma_f32_16x16x32_bf16(b[i], a[i], acc, 0, 0, 0);
        }
        if (KS == 2) { if (kh == 1) red[wsub * 64 + lane] = acc; __syncthreads(); if (kh == 0) acc = acc + red[wsub * 64 + lane]; }
        if (kh == 0) f.emit(TP + rb * 16 + fr, cb * 16 + 4 * fq, acc);
        if (KS == 2) __syncthreads();
    }
}

struct EpiUpPerm {
    static constexpr bool PERM = true, AFTER_DRAIN = false;
    bf16_t* H;
    DI void operator()(const pg8::f32x4 (&acc)[2][2][4][2], const pg8::Unit& u, int wr, int wc, int fr, int fq) const {
        const int row0 = u.pm * 256 + wr * 64 + fr, col0 = u.pn * 256 + wc * 32 + 8 * fq;
#pragma unroll
        for (int ai = 0; ai < 2; ++ai)
#pragma unroll
            for (int m = 0; m < 4; ++m) { bf16_t* rp = H + (size_t)(row0 + ai * 128 + m * 16) * 4096 + col0;
#pragma unroll
                for (int bj = 0; bj < 2; ++bj) { f32x4 a = acc[ai][bj][m][0], b = acc[ai][bj][m][1];
#pragma unroll
                    for (int e = 0; e < 4; ++e) { const float x = fmaxf(a[e], 0.f), y = fmaxf(b[e], 0.f); a[e] = x * x; b[e] = y * y; }
                    u32x4 w; w.x = cvtpk(a[0], a[1]); w.y = cvtpk(a[2], a[3]); w.z = cvtpk(b[0], b[1]); w.w = cvtpk(b[2], b[3]);
                    *(u32x4*)(rp + bj * 128) = w; } }
    }
};
DI void gemm_up(LAS unsigned char* lds, const bf16_t* A, const bf16_t* Bt, bf16_t* H) {
    { pg8::Gemm g{A, Bt, TP, 4096, 1024}; pg8::StaticOrder S; S.init(TP, 4096, (int)gridDim.x, (int)blockIdx.x);
      EpiUpPerm E{H};
      pg8::gemm_phase<EpiUpPerm, pg8::StaticOrder, true, true>(lds, g, S, E); }
    __syncthreads();
    EmitUp f{H};
    skinny_gemm<EmitUp, 1>(lds, A + (size_t)TP * 1024, Bt, 4096, 1024, f);
}

template <class F>
DI void gemm_all(LAS unsigned char* lds, const bf16_t* A, const bf16_t* Bt, int N, int K, const F& f) {
    { pg8::Gemm g{A, Bt, TP, N, K}; pg8::StaticOrder S; S.init(TP, N, (int)gridDim.x, (int)blockIdx.x);
      EpiEmit<F> E{f};
      pg8::gemm_phase<EpiEmit<F>, pg8::StaticOrder, true, true>(lds, g, S, E); }
    __syncthreads();
    if (K > 1024) skinny_gemm<F, 2>(lds, A + (size_t)TP * K, Bt, N, K, f); else skinny_gemm<F, 1>(lds, A + (size_t)TP * K, Bt, N, K, f);
}

template <int PER>
DI void scan_item(LAS unsigned char* lds, const float* src_a, int na, const float* src_b, int ntot, int stride, float* dst, int ndst) {
    const int tid = tid_l(), lane = tid & 63, wave = tid >> 6;
    LAS float* wt = (LAS float*)lds;
    float v[PER]; float tot = 0.f;
#pragma unroll
    for (int i = 0; i < PER; ++i) { const int pos = tid * PER + i; float x = 0.f; if (pos < na) x = src_a[(size_t)pos * stride]; else if (pos < ntot) x = src_b[(size_t)(pos - na) * stride]; tot += x; v[i] = tot; }
    float inc = tot;
#pragma unroll
    for (int o = 1; o < 64; o <<= 1) { const float t = __shfl_up(inc, o); if (lane >= o) inc += t; }
    __syncthreads();
    if (lane == 63) wt[wave] = inc;
    __syncthreads();
    float base = 0.f, total = 0.f;
#pragma unroll
    for (int w = 0; w < 8; ++w) { if (w < wave) base += wt[w]; total += wt[w]; }
    const float ex = base + inc - tot;
#pragma unroll
    for (int i = 0; i < PER; ++i) { const int pos = tid * PER + i; if (pos < ntot) dst[pos] = ex + v[i]; else if (pos < ndst) dst[pos] = total; }
}
DI float wave_max(float v) {
#pragma unroll
    for (int o = 1; o < 64; o <<= 1) v = fmaxf(v, __shfl_xor(v, o));
    return v;
}
template <bool SAMPLE>
DI void kn_item(const Params& p, LAS unsigned char* lds, int b, int h) {
    const int tid = tid_l(), lane = tid & 63, wave = tid >> 6;
    LAS float* knl = (LAS float*)(lds + 1024);
    constexpr int NT = SAMPLE ? 65 : 128;
    for (int tile = wave; tile < NT; tile += 8) {
        float ss = 0.f;
        if (!SAMPLE) { const u32x4* kp = (const u32x4*)(p.Kp + (size_t)(b * SEQ + 64 * tile + lane) * 512 + h * 64);
#pragma unroll
            for (int i = 0; i < 8; ++i) { const u32x4 w = kp[i];
#pragma unroll
                for (int e = 0; e < 4; ++e) { const float lo = __uint_as_float(w[e] << 16), hi = __uint_as_float(w[e] & 0xffff0000u); ss += lo * lo + hi * hi; } }
        } else { const float* kp = nullptr;
            if (tile < 64) kp = p.cfk + ((size_t)(b * PAST + 64 * tile + lane) * 8 + h) * 64; else if (lane < 16) kp = p.fk_s + ((size_t)(b * 16 + lane) * 8 + h) * 64;
            if (kp) {
#pragma unroll
                for (int i = 0; i < 16; ++i) { const f32x4 w = *(const f32x4*)(kp + 4 * i); ss += (w[0] * w[0] + w[1] * w[1]) + (w[2] * w[2] + w[3] * w[3]); } }
        }
        const float n = wave_max(sqrtf(ss));
        if (lane == 0) knl[tile] = n;
    }
    __syncthreads();
    if (tid < NT) { float m = 0.f; for (int i = 0; i <= tid; ++i) m = fmaxf(m, knl[i]); (SAMPLE ? p.KNs + (b * 8 + h) * 80 : p.KNp + (b * 8 + h) * 128)[tid] = m; }
    __syncthreads();
}
DI void phase3(const Params& p, LAS unsigned char* lds) {
    const int tid = tid_l();
    for (int it = blockIdx.x; it < 144; it += gridDim.x) {
        if (it < 16) { scan_item<16>(lds, p.fl_p + (size_t)(it >> 3) * SEQ * 8 + (it & 7), SEQ, nullptr, SEQ, 8, p.Fp + (size_t)it * SEQ, SEQ); kn_item<false>(p, lds, it >> 3, it & 7); }
        else { const int bh = it - 16, b = bh >> 3, h = bh & 7;
            scan_item<9>(lds, p.cfl + (size_t)b * PAST * 8 + h, PAST, p.fl_s + (size_t)b * 16 * 8 + h, PAST + 16, 8, p.Fs + (size_t)bh * LPAD, LPAD); kn_item<true>(p, lds, b, h); }
    }
    for (int i = blockIdx.x * NTHR + tid; i < TT * 128; i += gridDim.x * NTHR) {
        const int t = i >> 7, c = (i & 127) * 4, g = c >> 7, w = 2 << g;
        const f32x4 u = *(const f32x4*)(p.U + (size_t)t * 512 + c);
        f32x4 sum = u; float cnt;
        if (t < TP) { const int pos = t & (SEQ - 1); const int nw = pos + 1 < w ? pos + 1 : w; cnt = (float)nw;
            for (int k = 1; k < nw; ++k) sum += *(const f32x4*)(p.U + (size_t)(t - k) * 512 + c);
            if (pos >= SEQ - 15) *(f32x4*)(p.pool_p + ((size_t)(t >> 13) * 15 + (pos - (SEQ - 15))) * 512 + c) = u;
        } else { const int b = (t - TP) >> 4, loc = (t - TP) & 15; cnt = (float)w;
            for (int k = 1; k < w; ++k) { const int li = loc - k; sum += li >= 0 ? *(const f32x4*)(p.U + (size_t)(t - k) * 512 + c) : *(const f32x4*)(p.spool + ((size_t)b * 15 + 15 + li) * 512 + c); }
            if (loc >= 1) *(f32x4*)(p.pool_s + ((size_t)b * 15 + loc - 1) * 512 + c) = u;
        }
        f32x4 r;
#pragma unroll
        for (int e = 0; e < 4; ++e) r[e] = sum[e] / cnt - u[e];
        st_bf4(p.CAT + (size_t)t * 1024 + 512 + c, r);
    }
}

constexpr int AKS = 9216;
constexpr int ABUF = 2 * AKS + 272;
#define MFMA32(a, b, c) __builtin_amdgcn_mfma_f32_32x32x16_bf16((a), (b), (c), 0, 0, 0)
DI float max3f(float a, float b, float c) { float r; asm("v_max3_f32 %0, %1, %2, %3" : "=v"(r) : "v"(a), "v"(b), "v"(c)); return r; }
DI bf16x8 pack8(const f32x16& s, int base) { u32x4 w; w.x = cvtpk(s[base], s[base + 1]); w.y = cvtpk(s[base + 2], s[base + 3]); w.z = cvtpk(s[base + 4], s[base + 5]); w.w = cvtpk(s[base + 6], s[base + 7]); return __builtin_bit_cast(bf16x8, w); }
#define TR4(O) "ds_read_b64_tr_b16 %" #O ", %16 offset:"
#define TR16(v, addr) asm volatile( \
    "ds_read_b64_tr_b16 %0, %16\n\tds_read_b64_tr_b16 %1, %16 offset:64\n\tds_read_b64_tr_b16 %2, %16 offset:576\n\tds_read_b64_tr_b16 %3, %16 offset:640\n\t" \
    "ds_read_b64_tr_b16 %4, %16 offset:1152\n\tds_read_b64_tr_b16 %5, %16 offset:1216\n\tds_read_b64_tr_b16 %6, %16 offset:1728\n\tds_read_b64_tr_b16 %7, %16 offset:1792\n\t" \
    "ds_read_b64_tr_b16 %8, %16 offset:2304\n\tds_read_b64_tr_b16 %9, %16 offset:2368\n\tds_read_b64_tr_b16 %10, %16 offset:2880\n\tds_read_b64_tr_b16 %11, %16 offset:2944\n\t" \
    "ds_read_b64_tr_b16 %12, %16 offset:3456\n\tds_read_b64_tr_b16 %13, %16 offset:3520\n\tds_read_b64_tr_b16 %14, %16 offset:4032\n\tds_read_b64_tr_b16 %15, %16 offset:4096" \
    : "=&v"(v[0]), "=&v"(v[1]), "=&v"(v[2]), "=&v"(v[3]), "=&v"(v[4]), "=&v"(v[5]), "=&v"(v[6]), "=&v"(v[7]), "=&v"(v[8]), "=&v"(v[9]), "=&v"(v[10]), "=&v"(v[11]), "=&v"(v[12]), "=&v"(v[13]), "=&v"(v[14]), "=&v"(v[15]) \
    : "v"(addr) : "memory")
#define TRWAIT(v) asm volatile("s_waitcnt lgkmcnt(0)" : "+v"(v[0]), "+v"(v[1]), "+v"(v[2]), "+v"(v[3]), "+v"(v[4]), "+v"(v[5]), "+v"(v[6]), "+v"(v[7]), "+v"(v[8]), "+v"(v[9]), "+v"(v[10]), "+v"(v[11]), "+v"(v[12]), "+v"(v[13]), "+v"(v[14]), "+v"(v[15]) :: "memory")

template <int MODE>
DI void s_tile(LAS unsigned char* lds, unsigned kaddr, unsigned faddr, const bf16x8 (&qf)[4], f32x16& s0, f32x16& s1) {
    if (MODE == 0) {
#pragma unroll
        for (int g = 0; g < 4; ++g) { const f32x4 f0 = *(const LAS f32x4*)(lds + faddr + 16 * g), f1 = *(const LAS f32x4*)(lds + faddr + 64 + 16 * g);
#pragma unroll
            for (int r = 0; r < 4; ++r) { s0[4 * g + r] = f0[r]; s1[4 * g + r] = f1[r]; } }
    } else {
#pragma unroll
        for (int i = 0; i < 16; ++i) { s0[i] = 0.f; s1[i] = 0.f; }
    }
#pragma unroll
    for (int s = 0; s < 4; ++s) { const bf16x8 k0 = *(const LAS bf16x8*)(lds + kaddr + s * 32), k1 = *(const LAS bf16x8*)(lds + kaddr + 16 * 144 + s * 32);
        s0 = MFMA32(k0, qf[s], s0); s1 = MFMA32(k1, qf[s], s1); }
}
DI float fox_max(f32x16& s0, f32x16& s1, bool domask, int kpos0, int qpos) {
    if (domask) {
#pragma unroll
        for (int i = 0; i < 16; ++i) { if (kpos0 + i > qpos) s0[i] = -INFINITY; if (kpos0 + 16 + i > qpos) s1[i] = -INFINITY; }
    }
    float tmax = fmaxf(s0[0], s1[0]);
#pragma unroll
    for (int i = 1; i < 16; ++i) tmax = max3f(tmax, s0[i], s1[i]);
    return fmaxf(tmax, __shfl_xor(tmax, 32));
}
DI void fox_rest(f32x16& s0, f32x16& s1, f32x16& o0, f32x16& o1, float& m_run, float& l_run, float tmax) {
    const float m_new = fmaxf(m_run, tmax);
    if (__builtin_amdgcn_ballot_w64(m_new - m_run > 8.0f) != 0ull) {
        const float alpha = __builtin_amdgcn_exp2f(m_run - m_new);
        m_run = m_new; l_run *= alpha;
#pragma unroll
        for (int i = 0; i < 16; ++i) { o0[i] *= alpha; o1[i] *= alpha; }
    }
    float ls = 0.f;
#pragma unroll
    for (int i = 0; i < 16; ++i) { const float p0 = __builtin_amdgcn_exp2f(s0[i] - m_run), p1 = __builtin_amdgcn_exp2f(s1[i] - m_run); s0[i] = p0; s1[i] = p1; ls += p0 + p1; }
    l_run += ls;
}
DI void sb_weights(f32x16& s0, f32x16& s1, float& R, bool domask, int kpos0, int qpos, int hh) {
#pragma unroll
    for (int i = 0; i < 16; ++i) { s0[i] = __builtin_amdgcn_rcpf(1.0f + __builtin_amdgcn_exp2f(s0[i])); s1[i] = __builtin_amdgcn_rcpf(1.0f + __builtin_amdgcn_exp2f(s1[i])); }
    if (domask) {
#pragma unroll
        for (int i = 0; i < 16; ++i) { if (kpos0 + i >= qpos) s0[i] = 1.0f; if (kpos0 + 16 + i >= qpos) s1[i] = 1.0f; }
    }
    float c = 1.0f;
#pragma unroll
    for (int i = 15; i >= 0; --i) { const float cn = c * s1[i]; s1[i] = c - cn; c = cn; }
#pragma unroll
    for (int i = 15; i >= 0; --i) { const float cn = c * s0[i]; s0[i] = c - cn; c = cn; }
    const float cp = __shfl_xor(c, 32);
    const float scale = hh == 0 ? R * cp : R;
#pragma unroll
    for (int i = 0; i < 16; ++i) { s0[i] *= scale; s1[i] *= scale; }
    R = R * (c * cp);
}
DI void pv_tile(const s16x4 (&v)[16], const f32x16& s0, const f32x16& s1, f32x16& o0, f32x16& o1) {
    bf16x8 pf;
    pf = pack8(s0, 0); o0 = MFMA32(__builtin_shufflevector(v[0], v[2], 0, 1, 2, 3, 4, 5, 6, 7), pf, o0); o1 = MFMA32(__builtin_shufflevector(v[1], v[3], 0, 1, 2, 3, 4, 5, 6, 7), pf, o1);
    pf = pack8(s0, 8); o0 = MFMA32(__builtin_shufflevector(v[4], v[6], 0, 1, 2, 3, 4, 5, 6, 7), pf, o0); o1 = MFMA32(__builtin_shufflevector(v[5], v[7], 0, 1, 2, 3, 4, 5, 6, 7), pf, o1);
    pf = pack8(s1, 0); o0 = MFMA32(__builtin_shufflevector(v[8], v[10], 0, 1, 2, 3, 4, 5, 6, 7), pf, o0); o1 = MFMA32(__builtin_shufflevector(v[9], v[11], 0, 1, 2, 3, 4, 5, 6, 7), pf, o1);
    pf = pack8(s1, 8); o0 = MFMA32(__builtin_shufflevector(v[12], v[14], 0, 1, 2, 3, 4, 5, 6, 7), pf, o0); o1 = MFMA32(__builtin_shufflevector(v[13], v[15], 0, 1, 2, 3, 4, 5, 6, 7), pf, o1);
}
DI void attn_store(bf16_t* op, const f32x16& o0, const f32x16& o1) {
#pragma unroll
    for (int g = 0; g < 4; ++g) { u32x2 w0, w1; w0.x = cvtpk(o0[4 * g], o0[4 * g + 1]); w0.y = cvtpk(o0[4 * g + 2], o0[4 * g + 3]); w1.x = cvtpk(o1[4 * g], o1[4 * g + 1]); w1.y = cvtpk(o1[4 * g + 2], o1[4 * g + 3]);
        *(u32x2*)(op + 8 * g) = w0; *(u32x2*)(op + 32 + 8 * g) = w1; }
}

template <int MODE>
DI void tile_compute(unsigned va, f32x16& c0, f32x16& c1, f32x16& o0, f32x16& o1, float& m_run, float& l_run, float& R, bool domask, int kpos0, int qpos, int hh) {
    if (MODE == 0) {
        const float tmax = fox_max(c0, c1, domask, kpos0, qpos);
        if (__builtin_amdgcn_ballot_w64(tmax - m_run > -126.0f) == 0ull) return;
        s16x4 v[16];
        TR16(v, va);
        fox_rest(c0, c1, o0, o1, m_run, l_run, tmax);
        TRWAIT(v);
        pv_tile(v, c0, c1, o0, o1);
    } else {
        if (__builtin_amdgcn_ballot_w64(R != 0.f) == 0ull) return;
        s16x4 v[16];
        TR16(v, va);
        sb_weights(c0, c1, R, domask, kpos0, qpos, hh);
        TRWAIT(v);
        pv_tile(v, c0, c1, o0, o1);
    }
}
DI void sb_post(LAS unsigned char* lds, int t, int wave, int lane, bool notdone) { const bool any = __builtin_amdgcn_ballot_w64(notdone) != 0ull; if (lane == 0) *(LAS unsigned*)(lds + LDS_RING + 64 + (t & 1) * 32 + wave * 4) = any ? 1u : 0u; }
DI bool fox_notdone(float qn, float kn, float bmax, float m_run) { return qn * kn * 1.01f + bmax + 1.0f > m_run - 126.0f; }
DI bool sb_all_done(LAS unsigned char* lds, int t) { const LAS u32x4* fp = (const LAS u32x4*)(lds + LDS_RING + 64 + (t & 1) * 32); const u32x4 a = fp[0], b = fp[1];
    return __builtin_amdgcn_readfirstlane((a.x | a.y | a.z | a.w) | (b.x | b.y | b.z | b.w)) == 0u; }

template <int MODE, bool DIAG>
DI void prompt_iter(LAS unsigned char* lds, unsigned ldsb, int t, int jt_w, int qpos, int hh, const bf16x8 (&qf)[4], unsigned kofs, unsigned fofs, unsigned vofs,
                    f32x16& c0, f32x16& c1, f32x16& n0, f32x16& n1, f32x16& o0, f32x16& o1, float& m_run, float& l_run, float& R) {
    if (t >= 1 && (!DIAG || t - 1 <= jt_w)) { const unsigned bo = ((t - 1) % 3) * ABUF; s_tile<MODE>(lds, bo + kofs, bo + fofs, qf, n0, n1); }
    if (!DIAG || t <= jt_w) tile_compute<MODE>(ldsb + (t % 3) * ABUF + vofs, c0, c1, o0, o1, m_run, l_run, R, DIAG && (t == jt_w), 64 * t + 32 * hh, qpos, hh);
}
template <int MODE, int H>
DI void attn_prompt(const Params& p, LAS unsigned char* lds, int b, int head, int qb) {
    constexpr int PITCH = H * 64;
    const int tid = tid_l(), lane = tid & 63, wave = tid >> 6, l31 = lane & 31, hh = lane >> 5;
    const int row = tid >> 3, ch = tid & 7;
    const int top = 4 * qb + 3, jt_w = 4 * qb + (wave >> 1), qpos = 256 * qb + 32 * wave + l31, qrow = b * SEQ + qpos;
    bf16x8 qf[4];
    { const bf16_t* qp = p.Q + (size_t)qrow * PITCH + head * 64 + 8 * hh;
#pragma unroll
      for (int s = 0; s < 4; ++s) qf[s] = *(const bf16x8*)(qp + 16 * s); }
    const float* Fh = p.Fp + (size_t)(b * 8 + (MODE == 0 ? head : 0)) * SEQ;
    float fref = 0.f; if (MODE == 0) fref = Fh[256 * qb];
    const float* KNh = p.KNp + (b * 8 + (MODE == 0 ? head : 0)) * 128;
    float qn = 0.f;
    if (MODE == 0) {
#pragma unroll
        for (int s_ = 0; s_ < 4; ++s_)
#pragma unroll
            for (int j = 0; j < 8; ++j) { const float x = __uint_as_float(((unsigned)(unsigned short)qf[s_][j]) << 16); qn += x * x; }
        qn += __shfl_xor(qn, 32); qn = sqrtf(qn); }
    f32x16 o0, o1;
#pragma unroll
    for (int i = 0; i < 16; ++i) { o0[i] = 0.f; o1[i] = 0.f; }
    float m_run = -INFINITY, l_run = 0.f, R = 1.0f;
    u32x4 kA, vA, kB, vB; float fA = 0.f, fB = 0.f;
    const bf16_t* kg = p.Kp + (size_t)(b * SEQ + row) * PITCH + head * 64 + ch * 8;
    const bf16_t* vg = p.Vp + (size_t)(b * SEQ + row) * PITCH + head * 64 + ch * 8;
#define PL_LOAD(JT, KR, VR, FR) do { const int jt_ = (JT); KR = *(const u32x4*)(kg + (size_t)jt_ * 64 * PITCH); VR = *(const u32x4*)(vg + (size_t)jt_ * 64 * PITCH); \
        if (MODE == 0 && tid < 65) FR = tid < 64 ? (fref - Fh[64 * jt_ + tid]) * LOG2E : KNh[jt_]; } while (0)
#define PL_STORE(JT, KR, VR, FR) do { const unsigned bo_ = (unsigned)(((JT) % 3) * ABUF); *(LAS u32x4*)(lds + bo_ + row * 144 + ch * 16) = KR; *(LAS u32x4*)(lds + bo_ + AKS + row * 144 + ch * 16) = VR; \
        if (MODE == 0 && tid < 65) *(LAS float*)(lds + bo_ + 2 * AKS + tid * 4) = FR; } while (0)
#define PL_STAGE(T, KR, VR, FR) do { if ((T) >= 2) PL_STORE((T) - 2, KR, VR, FR); if ((T) >= 4) PL_LOAD((T) - 4, KR, VR, FR); } while (0)
    const unsigned ldsb = (unsigned)(uintptr_t)lds;
    const unsigned krow = 32 * ((l31 >> 2) & 1) + 4 * (l31 >> 3) + (l31 & 3);
    const unsigned kofs = krow * 144 + hh * 16, fofs = 2 * AKS + hh * 128;
    const unsigned vofs = AKS + (32 * hh + ((lane & 15) >> 2)) * 144 + 32 * ((lane >> 4) & 1) + 8 * (lane & 3);
    __syncthreads();
    PL_LOAD(top, kA, vA, fA); PL_LOAD(top - 1, kB, vB, fB);
    PL_STORE(top, kA, vA, fA); PL_STORE(top - 1, kB, vB, fB);
    PL_LOAD(top - 2, kA, vA, fA); PL_LOAD(top - 3, kB, vB, fB);
    __syncthreads();
    f32x16 sa0, sa1, sb0, sb1;
#pragma unroll
    for (int i = 0; i < 16; ++i) { sa0[i] = 0.f; sa1[i] = 0.f; sb0[i] = 0.f; sb1[i] = 0.f; }
    if (top <= jt_w) s_tile<MODE>(lds, (top % 3) * ABUF + kofs, (top % 3) * ABUF + fofs, qf, sa0, sa1);
    bool done = false;
#define PL_ITER(T, DG, KR, VR, FR, C0, C1, N0, N1) do { PL_STAGE(T, KR, VR, FR); \
        prompt_iter<MODE, DG>(lds, ldsb, (T), jt_w, qpos, hh, qf, kofs, fofs, vofs, C0, C1, N0, N1, o0, o1, m_run, l_run, R); \
        if (MODE == 1) sb_post(lds, (T), wave, lane, R != 0.f); \
        else { const unsigned bo_ = (unsigned)(((T) % 3) * ABUF + 2 * AKS); sb_post(lds, (T), wave, lane, fox_notdone(qn, *(const LAS float*)(lds + bo_ + 256), *(const LAS float*)(lds + bo_ + 252), m_run)); } \
        __syncthreads(); \
        done = sb_all_done(lds, (T)); } while (0)
    for (int t = top; t >= 4 * qb && !done; t -= 2) {
        PL_ITER(t, true, kA, vA, fA, sa0, sa1, sb0, sb1);
        if (done) break;
        PL_ITER(t - 1, true, kB, vB, fB, sb0, sb1, sa0, sa1);
    }
    for (int t = 4 * qb - 1; t >= 1 && !done; t -= 2) {
        PL_ITER(t, false, kA, vA, fA, sa0, sa1, sb0, sb1);
        if (done) break;
        PL_ITER(t - 1, false, kB, vB, fB, sb0, sb1, sa0, sa1);
    }
#undef PL_ITER
#undef PL_LOAD
#undef PL_STORE
#undef PL_STAGE
    if (MODE == 0) { const float lt = l_run + __shfl_xor(l_run, 32); const float inv = 1.0f / lt;
#pragma unroll
        for (int i = 0; i < 16; ++i) { o0[i] *= inv; o1[i] *= inv; } }
    attn_store(p.CAT + (size_t)qrow * 1024 + head * 64 + 4 * hh, o0, o1);
}

template <int MODE, int H>
DI void attn_sample(const Params& p, LAS unsigned char* lds, int b, int ub) {
    constexpr int SBUF = 4 * AKS;
    const int tid = tid_l(), lane = tid & 63, wave = tid >> 6, l31 = lane & 31, hh = lane >> 5;
    const int row = tid >> 3, ch = tid & 7;
    const int slot = wave & 3, head = 4 * ub + slot, qpos = PAST + (lane & 15), qrow = TP + 16 * b + (lane & 15);
    const bool active = wave < 4;
    const float* cK = MODE == 0 ? p.cfk : p.csk; const float* cV = MODE == 0 ? p.cfv : p.csv;
    const float* nK = MODE == 0 ? p.fk_s : p.sk_s; const float* nV = MODE == 0 ? p.fv_s : p.sv_s;
    bf16x8 qf[4];
    { const bf16_t* qp = p.Q + (size_t)qrow * (H * 64) + head * 64 + 8 * hh;
#pragma unroll
      for (int s = 0; s < 4; ++s) qf[s] = *(const bf16x8*)(qp + 16 * s); }
    const float* Fl = p.Fs + (size_t)(b * 8 + (MODE == 0 ? 4 * ub + (tid >> 6) : 0)) * LPAD;
    float fref = 0.f; if (MODE == 0 && tid < 256) fref = Fl[PAST];
    const float* KNl = p.KNs + (b * 8 + (MODE == 0 ? 4 * ub + (tid & 3) : 0)) * 80;
    float qn = 0.f;
    if (MODE == 0) {
#pragma unroll
        for (int s_ = 0; s_ < 4; ++s_)
#pragma unroll
            for (int j = 0; j < 8; ++j) { const float x = __uint_as_float(((unsigned)(unsigned short)qf[s_][j]) << 16); qn += x * x; }
        qn += __shfl_xor(qn, 32); qn = sqrtf(qn); }
    f32x16 o0, o1;
#pragma unroll
    for (int i = 0; i < 16; ++i) { o0[i] = 0.f; o1[i] = 0.f; }
    float m_run = -INFINITY, l_run = 0.f, R = 1.0f;
    float freg = 0.f; f32x4 kr[4][2], vr[4][2];
#define SL_LOAD(JT) do { const int jt_ = (JT); \
        _Pragma("unroll") for (int i = 0; i < 4; ++i) { const int hd = 4 * ub + i; \
            if (jt_ < 64) { const size_t off = ((size_t)(b * PAST + 64 * jt_ + row) * H + hd) * 64 + 8 * ch; \
                kr[i][0] = *(const f32x4*)(cK + off); kr[i][1] = *(const f32x4*)(cK + off + 4); vr[i][0] = *(const f32x4*)(cV + off); vr[i][1] = *(const f32x4*)(cV + off + 4); } \
            else if (row < 16) { const size_t off = ((size_t)(b * 16 + row) * H + hd) * 64 + 8 * ch; \
                kr[i][0] = *(const f32x4*)(nK + off); kr[i][1] = *(const f32x4*)(nK + off + 4); vr[i][0] = *(const f32x4*)(nV + off); vr[i][1] = *(const f32x4*)(nV + off + 4); } \
            else { kr[i][0] = (f32x4){0.f, 0.f, 0.f, 0.f}; kr[i][1] = kr[i][0]; vr[i][0] = kr[i][0]; vr[i][1] = kr[i][0]; } } \
        if (MODE == 0 && tid < 260) freg = tid < 256 ? (fref - Fl[64 * jt_ + (tid & 63)]) * LOG2E : KNl[jt_]; } while (0)
#define SL_STORE() do { \
        _Pragma("unroll") for (int i = 0; i < 4; ++i) { u32x4 kk, vv; \
            kk.x = cvtpk(kr[i][0][0], kr[i][0][1]); kk.y = cvtpk(kr[i][0][2], kr[i][0][3]); kk.z = cvtpk(kr[i][1][0], kr[i][1][1]); kk.w = cvtpk(kr[i][1][2], kr[i][1][3]); \
            vv.x = cvtpk(vr[i][0][0], vr[i][0][1]); vv.y = cvtpk(vr[i][0][2], vr[i][0][3]); vv.z = cvtpk(vr[i][1][0], vr[i][1][1]); vv.w = cvtpk(vr[i][1][2], vr[i][1][3]); \
            *(LAS u32x4*)(lds + i * AKS + row * 144 + ch * 16) = kk; *(LAS u32x4*)(lds + SBUF + i * AKS + row * 144 + ch * 16) = vv; } \
        if (MODE == 0 && tid < 260) *(LAS float*)(lds + 2 * SBUF + tid * 4) = freg; } while (0)
    const unsigned ldsb = (unsigned)(uintptr_t)lds;
    const unsigned krow = 32 * ((l31 >> 2) & 1) + 4 * (l31 >> 3) + (l31 & 3);
    const unsigned kofs = slot * AKS + krow * 144 + hh * 16, fofs = 2 * SBUF + slot * 256 + hh * 128;
    const unsigned va = ldsb + SBUF + slot * AKS + (32 * hh + ((lane & 15) >> 2)) * 144 + 32 * ((lane >> 4) & 1) + 8 * (lane & 3);
    SL_LOAD(64);
    if (!active) R = 0.f;
    for (int t = 64; t >= 0; --t) {
        __syncthreads();
        if (t < 64 && sb_all_done(lds, t + 1)) break;
        SL_STORE();
        __syncthreads();
        if (t > 0) SL_LOAD(t - 1);
        if (active) {
            f32x16 s0, s1;
            s_tile<MODE>(lds, kofs, fofs, qf, s0, s1);
            tile_compute<MODE>(va, s0, s1, o0, o1, m_run, l_run, R, t == 64, 64 * t + 32 * hh, qpos, hh);
        }
        if (MODE == 1) sb_post(lds, t, wave, lane, R != 0.f);
        else sb_post(lds, t, wave, lane, active && fox_notdone(qn, *(const LAS float*)(lds + 2 * SBUF + 1024 + slot * 4), *(const LAS float*)(lds + 2 * SBUF + slot * 256 + 252), m_run));
    }
#undef SL_LOAD
#undef SL_STORE
    if (MODE == 0) { const float lt = l_run + __shfl_xor(l_run, 32); const float inv = 1.0f / lt;
#pragma unroll
        for (int i = 0; i < 16; ++i) { o0[i] *= inv; o1[i] *= inv; } }
    if (active && l31 < 16) attn_store(p.CAT + (size_t)qrow * 1024 + head * 64 + 4 * hh, o0, o1);
}

template <int MODE, int H>
DI void attn_phase(const Params& p, LAS unsigned char* lds, unsigned* ctr) {
    constexpr int NS = 16 * (H / 4), NPB = 2 * H, TOTAL = NS + NPB * 32;
    volatile LAS int* slotw = (volatile LAS int*)(lds + LDS_RING);
    for (;;) {
        __syncthreads();
        if (threadIdx.x == 0) *slotw = (int)atomicAdd(ctr, 1u);
        __syncthreads();
        int u = *slotw;
        if (u >= TOTAL) break;
        if (u < NS) attn_sample<MODE, H>(p, lds, u / (H / 4), u % (H / 4));
        else { u -= NS; const int qb = 31 - u / NPB, bh = u % NPB; attn_prompt<MODE, H>(p, lds, bh / H, bh % H, qb); }
    }
}

#define XB_TMO      128
#define XB_XCNT(j)  (256  + 64 * (j))
#define XB_XSUB(j)  (1280 + 64 * (j))
#define XB_XGEN(j)  (2304 + 64 * (j))
#define XB_TOP      3328
#define XB_TOPGEN   3392
#define XCD_BAR_WORDS 3456
#define XB_SPIN_CAP (1u << 18)

__device__ __forceinline__ unsigned xb_ld(unsigned* p)              { return __hip_atomic_load(p, __ATOMIC_RELAXED, __HIP_MEMORY_SCOPE_AGENT); }
__device__ __forceinline__ unsigned xb_add(unsigned* p, unsigned v) { return __hip_atomic_fetch_add(p, v, __ATOMIC_RELAXED, __HIP_MEMORY_SCOPE_AGENT); }
__device__ __forceinline__ unsigned xb_xcc_id() { return (unsigned)__builtin_amdgcn_s_getreg((3 << 11) | 20) & 0xFu; }
#define XB_SPIN(cond, bar) do { unsigned _sp = 0; while (cond) { __builtin_amdgcn_s_sleep(1); \
    if ((++_sp & 255u) == 0u) { if (xb_ld(&(bar)[XB_TMO])) break; if (_sp > XB_SPIN_CAP) { atomicAdd(&(bar)[XB_TMO], 1u); break; } } } } while (0)

struct XcdBarrier {
    unsigned* bar; unsigned x;
    volatile LAS unsigned* st;
};

__device__ __forceinline__ XcdBarrier xcd_barrier_post(unsigned* bar, volatile LAS unsigned* st) {
    XcdBarrier b; b.bar = bar; b.x = xb_xcc_id(); b.st = st;
    if (threadIdx.x == 0) (void)xb_add(&bar[XB_XCNT(b.x)], 1u);
    return b;
}
__device__ __forceinline__ void xcd_barrier_complete(unsigned* bar, unsigned x, unsigned& nloc, unsigned& nx) {
    const unsigned G = gridDim.x * gridDim.y * gridDim.z;
    unsigned sum, cnt, mine, sp = 0u;
    for (;;) {
        sum = 0u; cnt = 0u; mine = 0u;
#pragma unroll
        for (unsigned j = 0; j < 16; ++j) { const unsigned c = xb_ld(&bar[XB_XCNT(j)]); sum += c; cnt += (c > 0u) ? 1u : 0u; mine = (j == x) ? c : mine; }
        if (sum == G) break;
        __builtin_amdgcn_s_sleep(1);
        if ((++sp & 255u) == 0u) { if (xb_ld(&bar[XB_TMO])) break; if (sp > XB_SPIN_CAP) { atomicAdd(&bar[XB_TMO], 1u); break; } }
    }
    nloc = mine > 0u ? mine : 1u; nx = cnt > 0u ? cnt : 1u;
}

__device__ __forceinline__ void xcd_barrier(const XcdBarrier& b) {
    asm volatile("s_waitcnt vmcnt(0)" ::: "memory");
    __syncthreads();
    if (threadIdx.x == 0) {
        unsigned* bar = b.bar;
        __builtin_amdgcn_s_waitcnt(0);
        unsigned nloc = b.st[0], nx = b.st[1];
        if (nloc == 0u) { xcd_barrier_complete(bar, b.x, nloc, nx); b.st[0] = nloc; b.st[1] = nx; }
        const unsigned old = xb_add(&bar[XB_XSUB(b.x)], 1u);
        const unsigned gen = old / nloc;
        if (old + 1u == (gen + 1u) * nloc) {
            __builtin_amdgcn_fence(__ATOMIC_RELEASE, "agent");
            asm volatile("s_waitcnt vmcnt(0)" ::: "memory");
            const unsigned og = xb_add(&bar[XB_TOP], 1u);
            const unsigned tg = og / nx;
            if (og + 1u == (tg + 1u) * nx) xb_add(&bar[XB_TOPGEN], 1u);
            else XB_SPIN(xb_ld(&bar[XB_TOPGEN]) == tg, bar);
            __builtin_amdgcn_fence(__ATOMIC_ACQUIRE, "agent");
            xb_add(&bar[XB_XGEN(b.x)], 1u);
            asm volatile("s_waitcnt vmcnt(0)" ::: "memory");
        } else {
            XB_SPIN(xb_ld(&bar[XB_XGEN(b.x)]) == gen, bar);
            __builtin_amdgcn_fence(__ATOMIC_ACQUIRE, "agent");
            asm volatile("s_waitcnt vmcnt(0)" ::: "memory");
        }
    }
    __syncthreads();
}

typedef const __attribute__((address_space(4))) Params* KParams;
#define LOADP(q) Params q; { KParams k_ = (KParams)__builtin_amdgcn_kernarg_segment_ptr(); asm volatile("" : "+s"(k_)); q = *k_; }
__global__ void __launch_bounds__(NTHR, 2) mega(Params p_unused) {
#if defined(__HIP_DEVICE_COMPILE__)
    extern __shared__ __attribute__((aligned(16))) unsigned char lds_raw[];
    LAS unsigned char* lds = (LAS unsigned char*)lds_raw;
    cg::grid_group grid = cg::this_grid();
    if (threadIdx.x < 2) ((volatile LAS unsigned*)(lds + LDS_RING + 16))[threadIdx.x] = 0u;
    __syncthreads();
    XcdBarrier bar;
    { LOADP(p); bar = xcd_barrier_post(p.ctl + 1024, (volatile LAS unsigned*)(lds + LDS_RING + 16)); }
#define GSYNC() xcd_barrier(bar)
    { LOADP(p); phase0(p, lds);
      if (p.ctl == nullptr) grid.sync(); }
    GSYNC();
    { LOADP(p); norm_phase<true>(p, 0, 0, p.x_prompt, p.x_sample); } GSYNC();
    { LOADP(p); EmitQkvAB e{p.Q, p.Kp, p.Vp, p.U, p.fk_p, p.fv_p, p.fk_s, p.fv_s}; gemm_all(lds, p.XN, p.Wab, 2048, 1024, e); } GSYNC();
    { LOADP(p); phase3(p, lds); } GSYNC();
    { LOADP(p); attn_phase<0, 8>(p, lds, p.ctl); } GSYNC();
    { LOADP(p); EmitRes e{p.x_prompt, p.x_sample, p.mod + 2048, p.X}; gemm_all(lds, p.CAT, p.Woab, 1024, 1024, e); } GSYNC();
    { LOADP(p); norm_phase<false>(p, 0, 1, p.X, p.X + (size_t)TP * 1024); } GSYNC();
    { LOADP(p); gemm_up(lds, p.XN, p.Wup, p.H); } GSYNC();
    { LOADP(p); EmitRes e{p.X, p.X + (size_t)TP * 1024, p.mod + 5120, p.X}; gemm_all(lds, p.H, p.Wdn, 1024, 4096, e); } GSYNC();
    { LOADP(p); norm_phase<false>(p, 1, 0, p.X, p.X + (size_t)TP * 1024); } GSYNC();
    { LOADP(p); EmitQkvSB e{p.Q, p.Kp, p.Vp, p.sk_p, p.sv_p, p.sk_s, p.sv_s}; gemm_all(lds, p.XN, p.Wsb, 3072, 1024, e); } GSYNC();
    { LOADP(p); attn_phase<1, 16>(p, lds, p.ctl + 64); } GSYNC();
    { LOADP(p); EmitRes e{p.X, p.X + (size_t)TP * 1024, p.mod + (size_t)NSEQ * 6144 + 2048, p.X}; gemm_all(lds, p.CAT, p.Wosb, 1024, 1024, e); } GSYNC();
    { LOADP(p); norm_phase<false>(p, 1, 1, p.X, p.X + (size_t)TP * 1024); } GSYNC();
    { LOADP(p); gemm_up(lds, p.XN, p.Wup + (size_t)4096 * 1024, p.H); } GSYNC();
    { LOADP(p); EmitRes e{p.X, p.X + (size_t)TP * 1024, p.mod + (size_t)NSEQ * 6144 + 5120, p.X}; gemm_all(lds, p.H, p.Wdn + (size_t)1024 * 4096, 1024, 4096, e); } GSYNC();
    { LOADP(p); final_norm_phase(p); }
#endif
}

extern "C" void kernel_launch(void* const* d_in, const int* in_sizes, int n_in, void* d_out, int out_size, void* d_ws, size_t ws_size, hipStream_t stream) {
    static int grid = 0;
    if (grid == 0) {
        int dev = 0, cus = 0, per_cu = 0;
        hipGetDevice(&dev);
        hipDeviceGetAttribute(&cus, hipDeviceAttributeMultiprocessorCount, dev);
        if (hipFuncSetAttribute((const void*)mega, hipFuncAttributeMaxDynamicSharedMemorySize, LDS_BYTES) != hipSuccess) fprintf(stderr, "kernel_launch: hipFuncSetAttribute failed\n");
        if (hipOccupancyMaxActiveBlocksPerMultiprocessor(&per_cu, (const void*)mega, NTHR, LDS_BYTES) != hipSuccess || per_cu < 1) { fprintf(stderr, "kernel_launch: occupancy query says %d\n", per_cu); per_cu = 1; }
        (void)hipGetLastError();
        if (per_cu > 1) per_cu = 1;
        grid = cus * per_cu;
        if (n_in != 23 || out_size != 68428800 || ws_size < ((size_t)446 << 20)) fprintf(stderr, "kernel_launch: unexpected sizes n_in %d out %d ws %zu\n", n_in, out_size, ws_size);
    }
    const float* const* in = (const float* const*)d_in;
    Params p{};
    p.x_prompt = in[0]; p.x_sample = in[1]; p.c_prompt = in[2]; p.c_sample = in[3]; p.cfk = in[4]; p.cfv = in[5]; p.cfl = in[6]; p.spool = in[7]; p.csk = in[8]; p.csv = in[9];
    p.w_ada = in[10]; p.b_ada = in[11]; p.norm_g = in[12]; p.w_in_ab = in[13]; p.b_forget = in[14]; p.w_pool = in[15]; p.pool_scale = in[16]; p.w_out_ab = in[17];
    p.w_in_sb = in[18]; p.w_out_sb = in[19]; p.w_up = in[20]; p.w_down = in[21]; p.final_g = in[22];
    float* o = (float*)d_out;
    p.y_p = o; p.y_s = o + 16777216; p.fk_p = o + 17039360; p.fv_p = o + 25427968; p.fl_p = o + 33816576; p.pool_p = o + 33947648; p.sk_p = o + 33963008; p.sv_p = o + 50740224;
    p.fk_s = o + 67517440; p.fv_s = o + 67648512; p.fl_s = o + 67779584; p.pool_s = o + 67781632; p.sk_s = o + 67904512; p.sv_s = o + 68166656;
    unsigned char* ws = (unsigned char*)d_ws; const size_t MB = (size_t)1 << 20;
    p.ctl = (unsigned*)ws; p.mod = (float*)(ws + 1 * MB); p.Wf = (float*)(ws + 2 * MB); p.Fp = (float*)(ws + 3 * MB); p.Fs = (float*)(ws + 4 * MB); p.KNp = (float*)(ws + 7 * MB); p.KNs = (float*)(ws + 7 * MB + 65536);
    p.Wab = (bf16_t*)(ws + 8 * MB); p.Woab = (bf16_t*)(ws + 12 * MB); p.Wsb = (bf16_t*)(ws + 14 * MB); p.Wosb = (bf16_t*)(ws + 20 * MB); p.Wup = (bf16_t*)(ws + 22 * MB); p.Wdn = (bf16_t*)(ws + 38 * MB);
    p.XN = (bf16_t*)(ws + 54 * MB); p.X = (float*)(ws + 87 * MB); p.Q = (bf16_t*)(ws + 152 * MB); p.Kp = (bf16_t*)(ws + 185 * MB); p.Vp = (bf16_t*)(ws + 217 * MB);
    p.U = (float*)(ws + 249 * MB); p.CAT = (bf16_t*)(ws + 282 * MB); p.H = (bf16_t*)(ws + 315 * MB);
    (void)hipMemsetAsync(ws, 0, 32768, stream);
    void* args[] = {&p};
    hipError_t e = hipLaunchCooperativeKernel((const void*)mega, dim3(grid), dim3(NTHR), args, LDS_BYTES, stream);
    if (e != hipSuccess) fprintf(stderr, "kernel_launch: cooperative launch failed: %s (grid %d)\n", hipGetErrorString(e), grid);
}
```

```cpp
#include <hip/hip_runtime.h>
#include <hip/hip_cooperative_groups.h>
#include <cstdio>
#include <cstdint>
namespace cg = cooperative_groups;
__device__ __forceinline__ int tid_l() { int t = threadIdx.x; asm volatile("" : "+v"(t)); return t; }
namespace pg8 {
#define PG8_LAS __attribute__((address_space(3)))
typedef unsigned short bf16_t;
typedef short bf16x8 __attribute__((ext_vector_type(8)));
typedef float f32x4 __attribute__((ext_vector_type(4)));
typedef unsigned u32x4 __attribute__((ext_vector_type(4)));
constexpr int BM = 256, BK = 64, HALF = 128, HTB = HALF * BK * 2  , STAGE_BYTES = 8 * HTB, NXCD = 8, WGM = 8;

__host__ __device__ __forceinline__ int lds_byte(int r, int c) { const int st = (r >> 4) * 2 + (c >> 5), rr = r & 15, cc = c & 31, ob = rr * 64 + cc * 2; return st * 1024 + (ob ^ (((ob >> 9) & 1) << 5)); }
__host__ __device__ __forceinline__ void stage_rc(int b, int& R, int& C) { const int st = b / 1024, sb = b % 1024, swz = sb ^ (((sb >> 9) & 1) << 5); R = (st >> 1) * 16 + swz / 64; C = (st & 1) * 32 + (swz % 64) / 2; }
__host__ __device__ __forceinline__ int perm32(int rho) { const int n = rho >> 4, i = rho & 15; return 8 * (i >> 2) + 4 * n + (i & 3); }

struct Unit { int pm, pn; };
struct Gemm { const bf16_t* A; const bf16_t* Bt; int M, N, K; };

struct StaticOrder {
    int nM, nN, nwg, G, c;
    __host__ __device__ void init(int M, int N, int G_, int c_) { nM = M / BM; nN = N / BM; nwg = nM * nN; G = G_; c = c_; }
    __host__ __device__ bool next(int i, Unit& u) const {
        const long L = (long)i * G + c; if (L >= nwg) return false;
        int wgid = (int)L; { const int q = nwg / NXCD, r = nwg % NXCD, xcd = wgid % NXCD, off = wgid / NXCD; wgid = (xcd < r ? xcd * (q + 1) : r * (q + 1) + (xcd - r) * q) + off; }
        const int nig = WGM * nN, gid = wgid / nig, fm = gid * WGM, gsz = (nM - fm) < WGM ? (nM - fm) : WGM;
        u.pm = fm + ((wgid % nig) % gsz); u.pn = (wgid % nig) / gsz; return true;
    }
    __device__ __forceinline__ void a_ready(const Unit&) const {}
    __device__ __forceinline__ void done(const Unit&) const {}
};

__device__ __forceinline__ unsigned cvt_pk_bf16(float lo, float hi) { unsigned r; asm volatile("v_cvt_pk_bf16_f32 %0, %1, %2" : "=v"(r) : "v"(lo), "v"(hi)); return r; }
template <class Epi, class Sched, bool ALIGN_EPI = false, bool SP2 = false>
__device__ __forceinline__ void gemm_phase(PG8_LAS unsigned char* lds, const Gemm g, const Sched& S, const Epi& E) {
    const int tid = tid_l(), wid = __builtin_amdgcn_readfirstlane(tid >> 6), lane = tid & 63, wr = wid >> 2, wc = wid & 3, fr = lane & 15, fq = lane >> 4;
    const int K = g.K, nt = K / BK;
    unsigned voffA[2], voffB[2];
#pragma unroll
    for (int i = 0; i < 2; ++i) { int R, C; stage_rc(tid * 16 + i * 8192, R, C); const int Rb = Epi::PERM ? ((R & ~31) + perm32(R & 31)) : R;
        voffA[i] = (unsigned)(R * K + C) * 2u; voffB[i] = (unsigned)(Rb * K + C) * 2u; }
    const size_t kstep = (size_t)(BK * 2);
    const size_t hstep = (size_t)HALF * K * 2;
    const size_t tstep = 2 * hstep;
    const unsigned ldsw = (unsigned)wid * 1024u;
    const int aoff = lds_byte(wr * 64 + fr, fq * 8), boff = lds_byte(wc * 32 + fr, fq * 8);
#define PG8_SA(b, h) (((b) * 2 + (h)) * HTB)
#define PG8_SB(b, h) ((4 + (b) * 2 + (h)) * HTB)
#define PG8_STAGE(bufoff, gbase, voff) do { _Pragma("unroll") for (int _i = 0; _i < 2; ++_i) \
        __builtin_amdgcn_global_load_lds((const unsigned*)((const char*)(gbase) + (voff)[_i]), (PG8_LAS unsigned*)(lds + (bufoff) + ldsw + _i * 8192), 16, 0, 0); } while (0)
#define PG8_LDA(dst, b, h) do { _Pragma("unroll") for (int m = 0; m < 4; ++m) _Pragma("unroll") for (int k = 0; k < 2; ++k) dst[m][k] = *(const PG8_LAS bf16x8*)(lds + PG8_SA(b, h) + aoff + m * 2048 + k * 1024); } while (0)
#define PG8_LDB(dst, b, h) do { _Pragma("unroll") for (int n = 0; n < 2; ++n) _Pragma("unroll") for (int k = 0; k < 2; ++k) dst[n][k] = *(const PG8_LAS bf16x8*)(lds + PG8_SB(b, h) + boff + n * 2048 + k * 1024); } while (0)
#define PG8_MMA(ai, bj, At, Bt) do { __builtin_amdgcn_s_setprio(1); _Pragma("unroll") for (int m = 0; m < 4; ++m) _Pragma("unroll") for (int n = 0; n < 2; ++n) _Pragma("unroll") for (int k = 0; k < 2; ++k) \
        acc[ai][bj][m][n] = __builtin_amdgcn_mfma_f32_16x16x32_bf16(Bt[n][k], At[m][k], acc[ai][bj][m][n], 0, 0, 0); __builtin_amdgcn_s_setprio(0); } while (0)
#define PG8_WAIT_V(n) asm volatile("s_waitcnt vmcnt(" #n ")" ::: "memory")
#define PG8_WAIT_L(n) asm volatile("s_waitcnt lgkmcnt(" #n ")" ::: "memory")
#define PG8_BAR __builtin_amdgcn_s_barrier()
#define PG8_SCHED __builtin_amdgcn_sched_barrier(0)
    Unit cur, nxt; int ui = 0;
    if (!S.next(0, cur)) return;
    f32x4 acc[2][2][4][2];
#pragma unroll
    for (int a = 0; a < 2; ++a)
#pragma unroll
        for (int b = 0; b < 2; ++b)
#pragma unroll
            for (int m = 0; m < 4; ++m)
#pragma unroll
                for (int n = 0; n < 2; ++n) acc[a][b][m][n] = (f32x4){0.f, 0.f, 0.f, 0.f};
    bf16x8 At[4][2], B0[2][2], B1[2][2];
    const char* cA = (const char*)g.A + (size_t)cur.pm * tstep; const char* cB = (const char*)g.Bt + (size_t)cur.pn * tstep;
    S.a_ready(cur);
    if constexpr (SP2) {
        PG8_STAGE(PG8_SB(0, 0), cB, voffB); PG8_STAGE(PG8_SB(0, 1), cB + hstep, voffB); PG8_STAGE(PG8_SA(0, 0), cA, voffA); PG8_STAGE(PG8_SA(0, 1), cA + hstep, voffA);
        if (wr == 1) PG8_BAR;
        PG8_WAIT_V(2); PG8_BAR;
        PG8_STAGE(PG8_SB(1, 0), cB + kstep, voffB); PG8_STAGE(PG8_SA(1, 0), cA + kstep, voffA); PG8_STAGE(PG8_SB(1, 1), cB + hstep + kstep, voffB);
        PG8_WAIT_V(6); PG8_BAR;
    } else {
        PG8_STAGE(PG8_SB(0, 0), cB, voffB); PG8_STAGE(PG8_SA(0, 0), cA, voffA); PG8_STAGE(PG8_SB(0, 1), cB + hstep, voffB); PG8_STAGE(PG8_SA(0, 1), cA + hstep, voffA);
        if (wr == 1) PG8_BAR;
        PG8_WAIT_V(4); PG8_BAR;
        PG8_STAGE(PG8_SB(1, 0), cB + kstep, voffB); PG8_STAGE(PG8_SA(1, 0), cA + kstep, voffA); PG8_STAGE(PG8_SB(1, 1), cB + hstep + kstep, voffB);
        PG8_WAIT_V(6); PG8_BAR;
    }
    for (;;) {
        const bool has_next = S.next(ui + 1, nxt);
        const char* nA = has_next ? (const char*)g.A + (size_t)nxt.pm * tstep : cA; const char* nB = has_next ? (const char*)g.Bt + (size_t)nxt.pn * tstep : cB;
        for (int t = 0; t < nt; t += 2) {
            const bool last = (t == nt - 2);
            const char* a1 = cA + (size_t)(t + 1) * kstep;
            const char* a2 = last ? nA : cA + (size_t)(t + 2) * kstep; const char* b2 = last ? nB : cB + (size_t)(t + 2) * kstep;
            const char* a3 = a2 + kstep; const char* b3 = b2 + kstep;
            if (last && has_next) S.a_ready(nxt);
            if constexpr (SP2) {
            PG8_LDB(B0, 0, 0); PG8_LDB(B1, 0, 1); PG8_SCHED; PG8_LDA(At, 0, 0); PG8_STAGE(PG8_SA(1, 1), a1 + hstep, voffA);
            PG8_WAIT_V(8); PG8_WAIT_L(0); PG8_BAR; PG8_MMA(0, 0, At, B0); PG8_MMA(0, 1, At, B1); PG8_BAR; PG8_SCHED;
            PG8_LDA(At, 0, 1); PG8_STAGE(PG8_SB(0, 0), b2, voffB); PG8_STAGE(PG8_SB(0, 1), b2 + hstep, voffB); PG8_STAGE(PG8_SA(0, 0), a2, voffA);
            PG8_WAIT_V(8); PG8_WAIT_L(0); PG8_BAR; PG8_MMA(1, 0, At, B0); PG8_MMA(1, 1, At, B1); PG8_BAR; PG8_SCHED;
            PG8_LDB(B0, 1, 0); PG8_LDB(B1, 1, 1); PG8_SCHED; PG8_LDA(At, 1, 0); PG8_STAGE(PG8_SA(0, 1), a2 + hstep, voffA);
            PG8_WAIT_V(8); PG8_WAIT_L(0); PG8_BAR; PG8_MMA(0, 0, At, B0); PG8_MMA(0, 1, At, B1); PG8_BAR; PG8_SCHED;
            PG8_LDA(At, 1, 1); PG8_STAGE(PG8_SB(1, 0), b3, voffB); PG8_STAGE(PG8_SB(1, 1), b3 + hstep, voffB); PG8_STAGE(PG8_SA(1, 0), a3, voffA);
            PG8_WAIT_V(8); PG8_WAIT_L(0); PG8_BAR; PG8_MMA(1, 0, At, B0); PG8_MMA(1, 1, At, B1); PG8_BAR; PG8_SCHED;
            } else {
            PG8_LDB(B0, 0, 0); PG8_SCHED; PG8_LDA(At, 0, 0); PG8_STAGE(PG8_SA(1, 1), a1 + hstep, voffA);
            PG8_WAIT_L(8); PG8_BAR; PG8_WAIT_L(0); PG8_MMA(0, 0, At, B0); PG8_BAR; PG8_SCHED;
            PG8_LDB(B1, 0, 1); PG8_STAGE(PG8_SB(0, 0), b2, voffB);
            PG8_BAR; PG8_WAIT_L(0); PG8_MMA(0, 1, At, B1); PG8_BAR;
            PG8_LDA(At, 0, 1); PG8_STAGE(PG8_SA(0, 0), a2, voffA);
            PG8_BAR; PG8_WAIT_L(0); PG8_MMA(1, 0, At, B0); PG8_BAR; PG8_SCHED;
            PG8_STAGE(PG8_SB(0, 1), b2 + hstep, voffB);
            PG8_WAIT_V(6); PG8_BAR; PG8_MMA(1, 1, At, B1); PG8_BAR;
            PG8_LDB(B0, 1, 0); PG8_SCHED; PG8_LDA(At, 1, 0); PG8_STAGE(PG8_SA(0, 1), a2 + hstep, voffA);
            PG8_WAIT_L(8); PG8_BAR; PG8_WAIT_L(0); PG8_MMA(0, 0, At, B0); PG8_BAR; PG8_SCHED;
            PG8_LDB(B1, 1, 1); PG8_STAGE(PG8_SB(1, 0), b3, voffB);
            PG8_BAR; PG8_WAIT_L(0); PG8_MMA(0, 1, At, B1); PG8_BAR;
            PG8_LDA(At, 1, 1); PG8_STAGE(PG8_SA(1, 0), a3, voffA);
            PG8_BAR; PG8_WAIT_L(0); PG8_MMA(1, 0, At, B0); PG8_BAR; PG8_SCHED;
            PG8_STAGE(PG8_SB(1, 1), b3 + hstep, voffB);
            PG8_WAIT_V(6); PG8_BAR; PG8_MMA(1, 1, At, B1); PG8_BAR;
            }
        }
        if constexpr (ALIGN_EPI) { if (wr == 0) PG8_BAR; }
        if constexpr (!Epi::AFTER_DRAIN) { E(acc, cur, wr, wc, fr, fq); S.done(cur); }
        if (!has_next) break;
#pragma unroll
        for (int a = 0; a < 2; ++a)
#pragma unroll
            for (int b = 0; b < 2; ++b)
#pragma unroll
                for (int m = 0; m < 4; ++m)
#pragma unroll
                    for (int n = 0; n < 2; ++n) acc[a][b][m][n] = (f32x4){0.f, 0.f, 0.f, 0.f};
        cur = nxt; cA = nA; cB = nB; ++ui;
        if constexpr (ALIGN_EPI) { if (wr == 1) PG8_BAR; }
    }
    PG8_WAIT_V(0);
    if constexpr (!ALIGN_EPI) { if (wr == 0) PG8_BAR; }
    PG8_BAR;
    if constexpr (Epi::AFTER_DRAIN) { E.fused(acc, cur, wr, wc, fr, fq, lds, wid, lane); S.done(cur); }
#undef PG8_SA
#undef PG8_SB
#undef PG8_STAGE
#undef PG8_LDA
#undef PG8_LDB
#undef PG8_MMA
#undef PG8_WAIT_V
#undef PG8_WAIT_L
#undef PG8_BAR
#undef PG8_SCHED
}
}

#define LAS __attribute__((address_space(3)))
typedef unsigned short bf16_t;
typedef short bf16x8 __attribute__((ext_vector_type(8)));
typedef short s16x4 __attribute__((ext_vector_type(4)));
typedef float f32x4 __attribute__((ext_vector_type(4)));
typedef float f32x16 __attribute__((ext_vector_type(16)));
typedef unsigned u32x4 __attribute__((ext_vector_type(4)));
typedef unsigned u32x2 __attribute__((ext_vector_type(2)));
typedef float f32x2_t __attribute__((ext_vector_type(2)));
typedef __bf16 bf16x2_t __attribute__((ext_vector_type(2)));

constexpr int TP = 16384, TS = 256, TT = TP + TS, DM = 1024, DFF = 4096;
constexpr int SEQ = 8192, PAST = 4096, LPAD = 4160, NSEQ = 18;
constexpr float LOG2E = 1.4426950408889634f;
constexpr int NTHR = 512, NWV = 8;
constexpr int LDS_RING = 131072, LDS_BYTES = LDS_RING + 1024;

struct Params {
    const float *x_prompt, *x_sample, *c_prompt, *c_sample, *cfk, *cfv, *cfl, *spool, *csk, *csv;
    const float *w_ada, *b_ada, *norm_g, *w_in_ab, *b_forget, *w_pool, *pool_scale, *w_out_ab, *w_in_sb, *w_out_sb, *w_up, *w_down, *final_g;
    float *y_p, *y_s, *fk_p, *fv_p, *fl_p, *pool_p, *sk_p, *sv_p, *fk_s, *fv_s, *fl_s, *pool_s, *sk_s, *sv_s;
    unsigned* ctl; float *mod, *Wf, *Fp, *Fs, *KNp, *KNs;
    bf16_t *Wab, *Woab, *Wsb, *Wosb, *Wup, *Wdn, *XN;
    float* X; bf16_t *Q, *Kp, *Vp; float* U; bf16_t *CAT, *H;
};

#define DI __device__ __forceinline__
DI unsigned cvtpk(float lo, float hi) { f32x2_t v = {lo, hi}; bf16x2_t b = __builtin_convertvector(v, bf16x2_t); return __builtin_bit_cast(unsigned, b); }
DI int seq_of(int t) { return t < TP ? (t >> 13) : 2 + ((t - TP) >> 4); }
DI float wave_sum(float v) {
#pragma unroll
    for (int o = 1; o < 64; o <<= 1) v += __shfl_xor(v, o);
    return v;
}
DI void st_bf4(bf16_t* p, f32x4 v) { u32x2 w; w.x = cvtpk(v[0], v[1]); w.y = cvtpk(v[2], v[3]); *(u32x2*)p = w; }
#define LDS_WAIT() asm volatile("s_waitcnt lgkmcnt(0)" ::: "memory")

DI void tr_item(const float* W, int ldw, int k0, int c0, bf16_t* WT, int ldt, int r0, int kd0, LAS float* scr, int lane) {
#pragma unroll 32
    for (int i = 0; i < 32; ++i) { const int kk = 2 * i + (lane >> 5); scr[kk * 33 + (lane & 31)] = W[(size_t)(k0 + kk) * ldw + c0 + (lane & 31)]; }
    LDS_WAIT();
    const int c = lane & 7;
#pragma unroll
    for (int j = 0; j < 4; ++j) { const int n = (lane >> 3) + 8 * j; const LAS float* s = scr + (8 * c) * 33 + n;
        u32x4 o; o.x = cvtpk(s[0 * 33], s[1 * 33]); o.y = cvtpk(s[2 * 33], s[3 * 33]); o.z = cvtpk(s[4 * 33], s[5 * 33]); o.w = cvtpk(s[6 * 33], s[7 * 33]);
        *(u32x4*)(WT + (size_t)(r0 + n) * ldt + kd0 + 8 * c) = o; }
    LDS_WAIT();
}

DI void phase0(const Params& p, LAS unsigned char* lds) {
    const int tid = tid_l(), lane = tid & 63, wave = tid >> 6;
    if ((int)blockIdx.x < 192) {
        LAS float* cond = (LAS float*)lds;
        LAS float* red = (LAS float*)(lds + 73728);
        for (int i = tid; i < NSEQ * 1024; i += NTHR) { const int s = i >> 10, k = i & 1023; const float c = s < 2 ? p.c_prompt[s * 1024 + k] : p.c_sample[(s - 2) * 1024 + k]; cond[i] = c / (1.0f + expf(-c)); }
        __syncthreads();
        for (int item = blockIdx.x; item < 192; item += gridDim.x) {
            const int layer = item / 96, col0 = (item % 96) * 64, quad = tid & 15, kc = tid >> 4;
            float acc[NSEQ][4];
#pragma unroll
            for (int s = 0; s < NSEQ; ++s) { acc[s][0] = 0.f; acc[s][1] = 0.f; acc[s][2] = 0.f; acc[s][3] = 0.f; }
            const float* wp = p.w_ada + ((size_t)layer * 1024 + kc * 32) * 6144 + col0 + 4 * quad;
#pragma unroll 4
            for (int kk = 0; kk < 32; ++kk) { const f32x4 w = *(const f32x4*)(wp + (size_t)kk * 6144);
#pragma unroll
                for (int s = 0; s < NSEQ; ++s) { const float cs = cond[s * 1024 + kc * 32 + kk]; acc[s][0] += cs * w[0]; acc[s][1] += cs * w[1]; acc[s][2] += cs * w[2]; acc[s][3] += cs * w[3]; } }
#pragma unroll
            for (int s = 0; s < NSEQ; ++s)
#pragma unroll
                for (int j = 0; j < 4; ++j) { float v = acc[s][j]; v += __shfl_xor(v, 16); v += __shfl_xor(v, 32); if (lane < 16) red[((wave * 16 + quad) * NSEQ + s) * 4 + j] = v; }
            __syncthreads();
            for (int o = tid; o < 16 * NSEQ * 4; o += NTHR) { const int qd = o / (NSEQ * 4), rem = o % (NSEQ * 4), s = rem >> 2, j = rem & 3; float sum = 0.f;
#pragma unroll
                for (int w = 0; w < 8; ++w) sum += red[((w * 16 + qd) * NSEQ + s) * 4 + j];
                const int col = col0 + 4 * qd + j; p.mod[((size_t)layer * NSEQ + s) * 6144 + col] = sum + p.b_ada[layer * 6144 + col]; }
            __syncthreads();
        }
    }
    for (int it = (int)gridDim.x - 1 - (int)blockIdx.x; it < 128; it += gridDim.x) {
        const int g = it >> 5, rem = it & 31, cblk = rem >> 1, n = (rem & 1) * 512 + tid;
        LAS float* wps = (LAS float*)lds;
        __syncthreads();
        for (int i = tid; i < 1024; i += NTHR) { const int j = i >> 7, e = i & 127; wps[i] = p.w_pool[((g * 128) + cblk * 8 + j) * 128 + e] * p.pool_scale[128 * g + e]; }
        __syncthreads();
        float acc[8];
#pragma unroll
        for (int j = 0; j < 8; ++j) acc[j] = 0.f;
        const float* wo = p.w_out_ab + (size_t)(512 + 128 * g) * 1024 + n;
#pragma unroll 8
        for (int e = 0; e < 128; ++e) { const float wv = wo[(size_t)e * 1024];
#pragma unroll
            for (int j = 0; j < 8; ++j) acc[j] += wps[j * 128 + e] * wv; }
        u32x4 o; o.x = cvtpk(acc[0], acc[1]); o.y = cvtpk(acc[2], acc[3]); o.z = cvtpk(acc[4], acc[5]); o.w = cvtpk(acc[6], acc[7]);
        *(u32x4*)(p.Woab + (size_t)n * 1024 + 512 + 128 * g + cblk * 8) = o;
    }
    for (int i = blockIdx.x * NTHR + tid; i < 8192; i += gridDim.x * NTHR) { const int h = i >> 10, k = i & 1023; p.Wf[i] = p.w_in_ab[(size_t)k * 2056 + 1536 + h]; }
    __syncthreads();
    LAS float* scr = (LAS float*)(lds + wave * 16384);
    const int gw = blockIdx.x * NWV + wave, NGW = gridDim.x * NWV;
    constexpr int NITEMS = 1024 + 256 + 1536 + 512 + 4096 + 4096;
    for (int it = gw; it < NITEMS; it += NGW) {
        int r = it;
        if (r < 1024) { const int kb = r >> 6, n0 = (r & 63) * 32, c0 = n0 < 1536 ? n0 : n0 + 8; tr_item(p.w_in_ab, 2056, kb * 64, c0, p.Wab, 1024, n0, kb * 64, scr, lane); continue; } r -= 1024;
        if (r < 256) { const int kb = r >> 5, n0 = (r & 31) * 32; tr_item(p.w_out_ab, 1024, kb * 64, n0, p.Woab, 1024, n0, kb * 64, scr, lane); continue; } r -= 256;
        if (r < 1536) { const int kb = r / 96, n0 = (r % 96) * 32; tr_item(p.w_in_sb, 3072, kb * 64, n0, p.Wsb, 1024, n0, kb * 64, scr, lane); continue; } r -= 1536;
        if (r < 512) { const int kb = r >> 5, n0 = (r & 31) * 32; tr_item(p.w_out_sb, 1024, kb * 64, n0, p.Wosb, 1024, n0, kb * 64, scr, lane); continue; } r -= 512;
        if (r < 4096) { const int layer = r >> 11, r2 = r & 2047, kb = r2 >> 7, n0 = (r2 & 127) * 32;
            tr_item(p.w_up + (size_t)layer * 1024 * 4096, 4096, kb * 64, n0, p.Wup + (size_t)layer * 4096 * 1024, 1024, n0, kb * 64, scr, lane); continue; } r -= 4096;
        { const int layer = r >> 11, r2 = r & 2047, kb = r2 >> 5, n0 = (r2 & 31) * 32;
            tr_item(p.w_down + (size_t)layer * 4096 * 1024, 1024, kb * 64, n0, p.Wdn + (size_t)layer * 1024 * 4096, 4096, n0, kb * 64, scr, lane); }
    }
}

template <bool FLOGIT>
DI void norm_phase(const Params& p, int layer, int which, const float* xin_p, const float* xin_s) {
    const int tid = tid_l(), lane = tid & 63, wave = tid >> 6;
    const int gw = blockIdx.x * NWV + wave, NGW = gridDim.x * NWV;
    const float* gptr = p.norm_g + (layer * 2 + which) * 1024;
    constexpr int NR = FLOGIT ? 1 : 4;
    for (int t0 = gw; t0 < TT; t0 += NR * NGW) {
        f32x4 v[NR][4];
#pragma unroll
        for (int r = 0; r < NR; ++r) { const int t = t0 + r * NGW; const int tc = t < TT ? t : t0;
            const float* xr = tc < TP ? xin_p + (size_t)tc * 1024 : xin_s + (size_t)(tc - TP) * 1024;
#pragma unroll
            for (int j = 0; j < 4; ++j) v[r][j] = *(const f32x4*)(xr + 4 * lane + 256 * j); }
#pragma unroll
        for (int r = 0; r < NR; ++r) { const int t = t0 + r * NGW;
            if (t < TT) {
                const float* md = p.mod + ((size_t)layer * NSEQ + seq_of(t)) * 6144 + (which ? 3072 : 0);
                float ss = 0.f;
#pragma unroll
                for (int j = 0; j < 4; ++j) ss += (v[r][j][0] * v[r][j][0] + v[r][j][1] * v[r][j][1]) + (v[r][j][2] * v[r][j][2] + v[r][j][3] * v[r][j][3]);
                const float rstd = 1.0f / sqrtf(wave_sum(ss) * (1.0f / 1024.0f) + 1e-6f);
                float fd[8];
#pragma unroll
                for (int h = 0; h < 8; ++h) fd[h] = 0.f;
#pragma unroll
                for (int j = 0; j < 4; ++j) { const int col = 4 * lane + 256 * j;
                    const f32x4 g = *(const f32x4*)(gptr + col), sh = *(const f32x4*)(md + col), sc = *(const f32x4*)(md + 1024 + col);
                    f32x4 y;
#pragma unroll
                    for (int e = 0; e < 4; ++e) y[e] = (v[r][j][e] * rstd * g[e]) * (1.0f + sc[e]) + sh[e];
                    st_bf4(p.XN + (size_t)t * 1024 + col, y);
                    if (FLOGIT) {
#pragma unroll
                        for (int h = 0; h < 8; ++h) { const f32x4 w = *(const f32x4*)(p.Wf + h * 1024 + col); fd[h] += (y[0] * w[0] + y[1] * w[1]) + (y[2] * w[2] + y[3] * w[3]); } }
                }
                if (FLOGIT) {
                    float mine = 0.f;
#pragma unroll
                    for (int h = 0; h < 8; ++h) { const float s = wave_sum(fd[h]); if (lane == h) mine = s; }
                    if (lane < 8) { const float z = mine + p.b_forget[lane]; const float lf = fminf(z, 0.f) - log1pf(expf(-fabsf(z)));
                        if (t < TP) p.fl_p[(size_t)t * 8 + lane] = lf; else p.fl_s[(size_t)(t - TP) * 8 + lane] = lf; }
                }
            }
        }
    }
}
DI void final_norm_phase(const Params& p) {
    const int tid = tid_l(), lane = tid & 63, wave = tid >> 6;
    const int gw = blockIdx.x * NWV + wave, NGW = gridDim.x * NWV;
    for (int t0 = gw; t0 < TT; t0 += 4 * NGW) {
        f32x4 v[4][4];
#pragma unroll
        for (int r = 0; r < 4; ++r) { const int t = t0 + r * NGW; const int tc = t < TT ? t : t0; const float* xr = p.X + (size_t)tc * 1024;
#pragma unroll
            for (int j = 0; j < 4; ++j) v[r][j] = *(const f32x4*)(xr + 4 * lane + 256 * j); }
#pragma unroll
        for (int r = 0; r < 4; ++r) { const int t = t0 + r * NGW;
            if (t < TT) {
                float* yr = t < TP ? p.y_p + (size_t)t * 1024 : p.y_s + (size_t)(t - TP) * 1024;
                float ss = 0.f;
#pragma unroll
                for (int j = 0; j < 4; ++j) ss += (v[r][j][0] * v[r][j][0] + v[r][j][1] * v[r][j][1]) + (v[r][j][2] * v[r][j][2] + v[r][j][3] * v[r][j][3]);
                const float rstd = 1.0f / sqrtf(wave_sum(ss) * (1.0f / 1024.0f) + 1e-6f);
#pragma unroll
                for (int j = 0; j < 4; ++j) { const int col = 4 * lane + 256 * j; const f32x4 g = *(const f32x4*)(p.final_g + col); f32x4 y;
#pragma unroll
                    for (int e = 0; e < 4; ++e) y[e] = v[r][j][e] * rstd * g[e];
                    *(f32x4*)(yr + col) = y; }
            }
        }
    }
}

struct EmitQkvAB { bf16_t *Q, *Kp, *Vp; float *U, *fk_p, *fv_p, *fk_s, *fv_s;
    DI void emit(int t, int c, f32x4 v) const {
        if (c < 512) { st_bf4(Q + (size_t)t * 512 + c, v * (0.125f * LOG2E)); }
        else if (c < 1024) { const int cc = c - 512; if (t < TP) { st_bf4(Kp + (size_t)t * 512 + cc, v); *(f32x4*)(fk_p + (size_t)t * 512 + cc) = v; } else *(f32x4*)(fk_s + (size_t)(t - TP) * 512 + cc) = v; }
        else if (c < 1536) { const int cc = c - 1024; if (t < TP) { st_bf4(Vp + (size_t)t * 512 + cc, v); *(f32x4*)(fv_p + (size_t)t * 512 + cc) = v; } else *(f32x4*)(fv_s + (size_t)(t - TP) * 512 + cc) = v; }
        else { *(f32x4*)(U + (size_t)t * 512 + (c - 1536)) = v; }
    } };
struct EmitQkvSB { bf16_t *Q, *Kp, *Vp; float *sk_p, *sv_p, *sk_s, *sv_s;
    DI void emit(int t, int c, f32x4 v) const {
        if (c < 1024) { st_bf4(Q + (size_t)t * 1024 + c, v * (0.125f * LOG2E)); }
        else if (c < 2048) { const int cc = c - 1024; if (t < TP) { st_bf4(Kp + (size_t)t * 1024 + cc, v); *(f32x4*)(sk_p + (size_t)t * 1024 + cc) = v; } else *(f32x4*)(sk_s + (size_t)(t - TP) * 1024 + cc) = v; }
        else { const int cc = c - 2048; if (t < TP) { st_bf4(Vp + (size_t)t * 1024 + cc, v); *(f32x4*)(sv_p + (size_t)t * 1024 + cc) = v; } else *(f32x4*)(sv_s + (size_t)(t - TP) * 1024 + cc) = v; }
    } };
struct EmitRes { const float* xin_p; const float* xin_s; const float* modg; float* X;
    DI void emit(int t, int c, f32x4 v) const {
        const float* xr = t < TP ? xin_p + (size_t)t * 1024 : xin_s + (size_t)(t - TP) * 1024;
        const f32x4 x = *(const f32x4*)(xr + c), g = *(const f32x4*)(modg + (size_t)seq_of(t) * 6144 + c);
        *(f32x4*)(X + (size_t)t * 1024 + c) = x + g * v;
    } };
struct EmitUp { bf16_t* H;
    DI void emit(int t, int c, f32x4 v) const { f32x4 r;
#pragma unroll
        for (int e = 0; e < 4; ++e) { const float a = fmaxf(v[e], 0.f); r[e] = a * a; }
        st_bf4(H + (size_t)t * 4096 + c, r); } };

template <class F> struct EpiEmit {
    static constexpr bool PERM = false, AFTER_DRAIN = false;
    F f;
    DI void operator()(const pg8::f32x4 (&acc)[2][2][4][2], const pg8::Unit& u, int wr, int wc, int fr, int fq) const {
        const int row0 = u.pm * 256 + wr * 64 + fr, col0 = u.pn * 256 + wc * 32 + 4 * fq;
#pragma unroll
        for (int ai = 0; ai < 2; ++ai)
#pragma unroll
            for (int m = 0; m < 4; ++m)
#pragma unroll
                for (int bj = 0; bj < 2; ++bj)
#pragma unroll
                    for (int n = 0; n < 2; ++n) f.emit(row0 + ai * 128 + m * 16, col0 + bj * 128 + n * 16, acc[ai][bj][m][n]);
    }
};

template <class F, int KS>
DI void skinny_gemm(LAS unsigned char* lds, const bf16_t* A, const bf16_t* Bt, int N, int K, const F& f) {
    const int tid = tid_l(), lane = tid & 63, wave = tid >> 6, fr = lane & 15, fq = lane >> 4;
    constexpr int WPB = 8 / KS;
    const int wsub = wave % WPB, kh = wave / WPB, Kh = K / KS;
    LAS f32x4* red = (LAS f32x4*)lds;
    for (int item0 = blockIdx.x * WPB; item0 < N; item0 += gridDim.x * WPB) {
        const int item = item0 + wsub, rb = item & 15, cb = item >> 4;
        const bf16_t* ap = A + (size_t)(rb * 16 + fr) * K + kh * Kh + 8 * fq;
        const bf16_t* bp = Bt + (size_t)(cb * 16 + fr) * K + kh * Kh + 8 * fq;
        f32x4 acc = {0.f, 0.f, 0.f, 0.f};
        for (int ks = 0; ks < Kh; ks += 512) {
            bf16x8 a[16], b[16];
#pragma unroll
            for (int i = 0; i < 16; ++i) { a[i] = *(const bf16x8*)(ap + ks + 32 * i); b[i] = *(const bf16x8*)(bp + ks + 32 * i); }
#pragma unroll
            for (int i = 0; i < 16; ++i) acc = __builtin_amdgcn_mfma_f32_16x16x32_bf16(b[i], a[i], acc, 0, 0, 0);
        }
        if (KS == 2) { if (kh == 1) red[wsub * 64 + lane] = acc; __syncthreads(); if (kh == 0) acc = acc + red[wsub * 64 + lane]; }
        if (kh == 0) f.emit(TP + rb * 16 + fr, cb * 16 + 4 * fq, acc);
        if (KS == 2) __syncthreads();
    }
}

struct EpiUpPerm {
    static constexpr bool PERM = true, AFTER_DRAIN = false;
    bf16_t* H;
    DI void operator()(const pg8::f32x4 (&acc)[2][2][4][2], const pg8::Unit& u, int wr, int wc, int fr, int fq) const {
        const int row0 = u.pm * 256 + wr * 64 + fr, col0 = u.pn * 256 + wc * 32 + 8 * fq;
#pragma unroll
        for (int ai = 0; ai < 2; ++ai)
#pragma unroll
            for (int m = 0; m < 4; ++m) { bf16_t* rp = H + (size_t)(row0 + ai * 128 + m * 16) * 4096 + col0;
#pragma unroll
                for (int bj = 0; bj < 2; ++bj) { f32x4 a = acc[ai][bj][m][0], b = acc[ai][bj][m][1];
#pragma unroll
                    for (int e = 0; e < 4; ++e) { const float x = fmaxf(a[e], 0.f), y = fmaxf(b[e], 0.f); a[e] = x * x; b[e] = y * y; }
                    u32x4 w; w.x = cvtpk(a[0], a[1]); w.y = cvtpk(a[2], a[3]); w.z = cvtpk(b[0], b[1]); w.w = cvtpk(b[2], b[3]);
                    *(u32x4*)(rp + bj * 128) = w; } }
    }
};
DI void gemm_up(LAS unsigned char* lds, const bf16_t* A, const bf16_t* Bt, bf16_t* H) {
    { pg8::Gemm g{A, Bt, TP, 4096, 1024}; pg8::StaticOrder S; S.init(TP, 4096, (int)gridDim.x, (int)blockIdx.x);
      EpiUpPerm E{H};
      pg8::gemm_phase<EpiUpPerm, pg8::StaticOrder, true, true>(lds, g, S, E); }
    __syncthreads();
    EmitUp f{H};
    skinny_gemm<EmitUp, 1>(lds, A + (size_t)TP * 1024, Bt, 4096, 1024, f);
}

template <class F>
DI void gemm_all(LAS unsigned char* lds, const bf16_t* A, const bf16_t* Bt, int N, int K, const F& f) {
    { pg8::Gemm g{A, Bt, TP, N, K}; pg8::StaticOrder S; S.init(TP, N, (int)gridDim.x, (int)blockIdx.x);
      EpiEmit<F> E{f};
      pg8::gemm_phase<EpiEmit<F>, pg8::StaticOrder, true, true>(lds, g, S, E); }
    __syncthreads();
    if (K > 1024) skinny_gemm<F, 2>(lds, A + (size_t)TP * K, Bt, N, K, f); else skinny_gemm<F, 1>(lds, A + (size_t)TP * K, Bt, N, K, f);
}

template <int PER>
DI void scan_item(LAS unsigned char* lds, const float* src_a, int na, const float* src_b, int ntot, int stride, float* dst, int ndst) {
    const int tid = tid_l(), lane = tid & 63, wave = tid >> 6;
    LAS float* wt = (LAS float*)lds;
    float v[PER]; float tot = 0.f;
#pragma unroll
    for (int i = 0; i < PER; ++i) { const int pos = tid * PER + i; float x = 0.f; if (pos < na) x = src_a[(size_t)pos * stride]; else if (pos < ntot) x = src_b[(size_t)(pos - na) * stride]; tot += x; v[i] = tot; }
    float inc = tot;
#pragma unroll
    for (int o = 1; o < 64; o <<= 1) { const float t = __shfl_up(inc, o); if (lane >= o) inc += t; }
    __syncthreads();
    if (lane == 63) wt[wave] = inc;
    __syncthreads();
    float base = 0.f, total = 0.f;
#pragma unroll
    for (int w = 0; w < 8; ++w) { if (w < wave) base += wt[w]; total += wt[w]; }
    const float ex = base + inc - tot;
#pragma unroll
    for (int i = 0; i < PER; ++i) { const int pos = tid * PER + i; if (pos < ntot) dst[pos] = ex + v[i]; else if (pos < ndst) dst[pos] = total; }
}
template <bool SAMPLE>
DI void kn_item(const Params& p, LAS unsigned char* lds, int b, int h) {
    const int tid = tid_l(), lane = tid & 63, wave = tid >> 6;
    LAS float* knl = (LAS float*)(lds + 1024);
    constexpr int NT = SAMPLE ? 65 : 128;
    for (int tile = wave; tile < NT; tile += 8) {
        float mx = 0.f;
        if (!SAMPLE) { const int sub = lane & 7, r8 = lane >> 3;
            const bf16_t* kp = p.Kp + (size_t)(b * SEQ + 64 * tile + r8) * 512 + h * 64 + 8 * sub;
            u32x4 w[8];
#pragma unroll
            for (int i = 0; i < 8; ++i) w[i] = *(const u32x4*)(kp + (size_t)(8 * i) * 512);
#pragma unroll
            for (int i = 0; i < 8; ++i) { float ss = 0.f;
#pragma unroll
                for (int e = 0; e < 4; ++e) { const float lo = __uint_as_float(w[i][e] << 16), hi = __uint_as_float(w[i][e] & 0xffff0000u); ss += lo * lo + hi * hi; }
                ss += __shfl_xor(ss, 1); ss += __shfl_xor(ss, 2); ss += __shfl_xor(ss, 4); mx = fmaxf(mx, ss); }
            mx = fmaxf(mx, __shfl_xor(mx, 8)); mx = fmaxf(mx, __shfl_xor(mx, 16)); mx = fmaxf(mx, __shfl_xor(mx, 32));
        } else { const int sub = lane & 15, r4 = lane >> 4;
            f32x4 w[16];
            if (tile < 64) { const float* kp = p.cfk + ((size_t)(b * PAST + 64 * tile + r4) * 8 + h) * 64 + 4 * sub;
#pragma unroll
                for (int i = 0; i < 16; ++i) w[i] = *(const f32x4*)(kp + (size_t)(4 * i) * 512);
            } else { const float* kp = p.fk_s + ((size_t)(b * 16 + r4) * 8 + h) * 64 + 4 * sub;
#pragma unroll
                for (int i = 0; i < 16; ++i) w[i] = i < 4 ? *(const f32x4*)(kp + (size_t)(4 * i) * 512) : (f32x4){0.f, 0.f, 0.f, 0.f}; }
#pragma unroll
            for (int i = 0; i < 16; ++i) { float ss = (w[i][0] * w[i][0] + w[i][1] * w[i][1]) + (w[i][2] * w[i][2] + w[i][3] * w[i][3]);
                ss += __shfl_xor(ss, 1); ss += __shfl_xor(ss, 2); ss += __shfl_xor(ss, 4); ss += __shfl_xor(ss, 8); mx = fmaxf(mx, ss); }
            mx = fmaxf(mx, __shfl_xor(mx, 16)); mx = fmaxf(mx, __shfl_xor(mx, 32));
        }
        if (lane == 0) knl[tile] = sqrtf(mx);
    }
    __syncthreads();
    if (tid < NT) { float m = 0.f; for (int i = 0; i <= tid; ++i) m = fmaxf(m, knl[i]); (SAMPLE ? p.KNs + (b * 8 + h) * 80 : p.KNp + (b * 8 + h) * 128)[tid] = m; }
    __syncthreads();
}
template <int W>
DI void pool_task(const Params& p, int t, int c) {
    const f32x4 u = *(const f32x4*)(p.U + (size_t)t * 512 + c);
    f32x4 r[W - 1]; f32x4 sum = u; float cnt;
    if (t < TP) { const int pos = t & (SEQ - 1);
#pragma unroll
        for (int k = 1; k < W; ++k) r[k - 1] = *(const f32x4*)(p.U + (size_t)(pos >= k ? t - k : t) * 512 + c);
#pragma unroll
        for (int k = 1; k < W; ++k) if (pos >= k) sum += r[k - 1];
        cnt = (float)(pos + 1 < W ? pos + 1 : W);
        if (pos >= SEQ - 15) *(f32x4*)(p.pool_p + ((size_t)(t >> 13) * 15 + (pos - (SEQ - 15))) * 512 + c) = u;
    } else { const int b = (t - TP) >> 4, loc = (t - TP) & 15;
#pragma unroll
        for (int k = 1; k < W; ++k) { const int li = loc - k; r[k - 1] = li >= 0 ? *(const f32x4*)(p.U + (size_t)(t - k) * 512 + c) : *(const f32x4*)(p.spool + ((size_t)b * 15 + 15 + li) * 512 + c); }
#pragma unroll
        for (int k = 1; k < W; ++k) sum += r[k - 1];
        cnt = (float)W;
        if (loc >= 1) *(f32x4*)(p.pool_s + ((size_t)b * 15 + loc - 1) * 512 + c) = u;
    }
    f32x4 o;
#pragma unroll
    for (int e = 0; e < 4; ++e) o[e] = sum[e] / cnt - u[e];
    st_bf4(p.CAT + (size_t)t * 1024 + 512 + c, o);
}
DI void phase3(const Params& p, LAS unsigned char* lds) {
    const int tid = tid_l();
    for (int it = blockIdx.x; it < 144; it += gridDim.x) {
        if (it < 16) { scan_item<16>(lds, p.fl_p + (size_t)(it >> 3) * SEQ * 8 + (it & 7), SEQ, nullptr, SEQ, 8, p.Fp + (size_t)it * SEQ, SEQ); kn_item<false>(p, lds, it >> 3, it & 7); }
        else { const int bh = it - 16, b = bh >> 3, h = bh & 7;
            scan_item<9>(lds, p.cfl + (size_t)b * PAST * 8 + h, PAST, p.fl_s + (size_t)b * 16 * 8 + h, PAST + 16, 8, p.Fs + (size_t)bh * LPAD, LPAD); kn_item<true>(p, lds, b, h); }
    }
    volatile LAS int* slotw = (volatile LAS int*)(lds + LDS_RING);
    for (;;) {
        __syncthreads();
        if (threadIdx.x == 0) *slotw = (int)atomicAdd(p.ctl + 320, 1u);
        __syncthreads();
        const int chunk = *slotw;
        if (chunk >= (TT * 128) / 4096) break;
#pragma unroll 1
        for (int j = 0; j < 8; ++j) { const int i = chunk * 4096 + j * NTHR + tid;
            const int g = (i >> 6) & 3, t = 2 * (i >> 8) + ((i >> 5) & 1), c = (g * 32 + (i & 31)) * 4;
            if (g == 0) pool_task<2>(p, t, c); else if (g == 1) pool_task<4>(p, t, c); else if (g == 2) pool_task<8>(p, t, c); else pool_task<16>(p, t, c); }
    }
}

constexpr int AKS = 9216;
constexpr int ABUF = 2 * AKS + 272;
#define MFMA32(a, b, c) __builtin_amdgcn_mfma_f32_32x32x16_bf16((a), (b), (c), 0, 0, 0)
DI float max3f(float a, float b, float c) { float r; asm("v_max3_f32 %0, %1, %2, %3" : "=v"(r) : "v"(a), "v"(b), "v"(c)); return r; }
DI bf16x8 pack8(const f32x16& s, int base) { u32x4 w; w.x = cvtpk(s[base], s[base + 1]); w.y = cvtpk(s[base + 2], s[base + 3]); w.z = cvtpk(s[base + 4], s[base + 5]); w.w = cvtpk(s[base + 6], s[base + 7]); return __builtin_bit_cast(bf16x8, w); }
#define TR4(O) "ds_read_b64_tr_b16 %" #O ", %16 offset:"
#define TR16(v, addr) asm volatile( \
    "ds_read_b64_tr_b16 %0, %16\n\tds_read_b64_tr_b16 %1, %16 offset:64\n\tds_read_b64_tr_b16 %2, %16 offset:576\n\tds_read_b64_tr_b16 %3, %16 offset:640\n\t" \
    "ds_read_b64_tr_b16 %4, %16 offset:1152\n\tds_read_b64_tr_b16 %5, %16 offset:1216\n\tds_read_b64_tr_b16 %6, %16 offset:1728\n\tds_read_b64_tr_b16 %7, %16 offset:1792\n\t" \
    "ds_read_b64_tr_b16 %8, %16 offset:2304\n\tds_read_b64_tr_b16 %9, %16 offset:2368\n\tds_read_b64_tr_b16 %10, %16 offset:2880\n\tds_read_b64_tr_b16 %11, %16 offset:2944\n\t" \
    "ds_read_b64_tr_b16 %12, %16 offset:3456\n\tds_read_b64_tr_b16 %13, %16 offset:3520\n\tds_read_b64_tr_b16 %14, %16 offset:4032\n\tds_read_b64_tr_b16 %15, %16 offset:4096" \
    : "=&v"(v[0]), "=&v"(v[1]), "=&v"(v[2]), "=&v"(v[3]), "=&v"(v[4]), "=&v"(v[5]), "=&v"(v[6]), "=&v"(v[7]), "=&v"(v[8]), "=&v"(v[9]), "=&v"(v[10]), "=&v"(v[11]), "=&v"(v[12]), "=&v"(v[13]), "=&v"(v[14]), "=&v"(v[15]) \
    : "v"(addr) : "memory")
#define TRWAIT(v) asm volatile("s_waitcnt lgkmcnt(0)" : "+v"(v[0]), "+v"(v[1]), "+v"(v[2]), "+v"(v[3]), "+v"(v[4]), "+v"(v[5]), "+v"(v[6]), "+v"(v[7]), "+v"(v[8]), "+v"(v[9]), "+v"(v[10]), "+v"(v[11]), "+v"(v[12]), "+v"(v[13]), "+v"(v[14]), "+v"(v[15]) :: "memory")

template <int MODE>
DI void s_tile(LAS unsigned char* lds, unsigned kaddr, unsigned faddr, const bf16x8 (&qf)[4], f32x16& s0, f32x16& s1) {
    if (MODE == 0) {
#pragma unroll
        for (int g = 0; g < 4; ++g) { const f32x4 f0 = *(const LAS f32x4*)(lds + faddr + 16 * g), f1 = *(const LAS f32x4*)(lds + faddr + 64 + 16 * g);
#pragma unroll
            for (int r = 0; r < 4; ++r) { s0[4 * g + r] = f0[r]; s1[4 * g + r] = f1[r]; } }
    } else {
#pragma unroll
        for (int i = 0; i < 16; ++i) { s0[i] = 0.f; s1[i] = 0.f; }
    }
#pragma unroll
    for (int s = 0; s < 4; ++s) { const bf16x8 k0 = *(const LAS bf16x8*)(lds + kaddr + s * 32), k1 = *(const LAS bf16x8*)(lds + kaddr + 16 * 144 + s * 32);
        s0 = MFMA32(k0, qf[s], s0); s1 = MFMA32(k1, qf[s], s1); }
}
DI float fox_max(f32x16& s0, f32x16& s1, bool domask, int kpos0, int qpos) {
    if (domask) {
#pragma unroll
        for (int i = 0; i < 16; ++i) { if (kpos0 + i > qpos) s0[i] = -INFINITY; if (kpos0 + 16 + i > qpos) s1[i] = -INFINITY; }
    }
    float tmax = fmaxf(s0[0], s1[0]);
#pragma unroll
    for (int i = 1; i < 16; ++i) tmax = max3f(tmax, s0[i], s1[i]);
    return fmaxf(tmax, __shfl_xor(tmax, 32));
}
DI void fox_rest(f32x16& s0, f32x16& s1, f32x16& o0, f32x16& o1, float& m_run, float& l_run, float tmax) {
    const float m_new = fmaxf(m_run, tmax);
    if (__builtin_amdgcn_ballot_w64(m_new - m_run > 8.0f) != 0ull) {
        const float alpha = __builtin_amdgcn_exp2f(m_run - m_new);
        m_run = m_new; l_run *= alpha;
#pragma unroll
        for (int i = 0; i < 16; ++i) { o0[i] *= alpha; o1[i] *= alpha; }
    }
    float ls = 0.f;
#pragma unroll
    for (int i = 0; i < 16; ++i) { const float p0 = __builtin_amdgcn_exp2f(s0[i] - m_run), p1 = __builtin_amdgcn_exp2f(s1[i] - m_run); s0[i] = p0; s1[i] = p1; ls += p0 + p1; }
    l_run += ls;
}
DI void sb_weights(f32x16& s0, f32x16& s1, float& R, bool domask, int kpos0, int qpos, int hh) {
#pragma unroll
    for (int i = 0; i < 16; ++i) { s0[i] = __builtin_amdgcn_rcpf(1.0f + __builtin_amdgcn_exp2f(s0[i])); s1[i] = __builtin_amdgcn_rcpf(1.0f + __builtin_amdgcn_exp2f(s1[i])); }
    if (domask) {
#pragma unroll
        for (int i = 0; i < 16; ++i) { if (kpos0 + i >= qpos) s0[i] = 1.0f; if (kpos0 + 16 + i >= qpos) s1[i] = 1.0f; }
    }
    float c = 1.0f;
#pragma unroll
    for (int i = 15; i >= 0; --i) { const float cn = c * s1[i]; s1[i] = c - cn; c = cn; }
#pragma unroll
    for (int i = 15; i >= 0; --i) { const float cn = c * s0[i]; s0[i] = c - cn; c = cn; }
    const float cp = __shfl_xor(c, 32);
    const float scale = hh == 0 ? R * cp : R;
#pragma unroll
    for (int i = 0; i < 16; ++i) { s0[i] *= scale; s1[i] *= scale; }
    R = R * (c * cp);
}
DI void pv_tile(const s16x4 (&v)[16], const f32x16& s0, const f32x16& s1, f32x16& o0, f32x16& o1) {
    bf16x8 pf;
    pf = pack8(s0, 0); o0 = MFMA32(__builtin_shufflevector(v[0], v[2], 0, 1, 2, 3, 4, 5, 6, 7), pf, o0); o1 = MFMA32(__builtin_shufflevector(v[1], v[3], 0, 1, 2, 3, 4, 5, 6, 7), pf, o1);
    pf = pack8(s0, 8); o0 = MFMA32(__builtin_shufflevector(v[4], v[6], 0, 1, 2, 3, 4, 5, 6, 7), pf, o0); o1 = MFMA32(__builtin_shufflevector(v[5], v[7], 0, 1, 2, 3, 4, 5, 6, 7), pf, o1);
    pf = pack8(s1, 0); o0 = MFMA32(__builtin_shufflevector(v[8], v[10], 0, 1, 2, 3, 4, 5, 6, 7), pf, o0); o1 = MFMA32(__builtin_shufflevector(v[9], v[11], 0, 1, 2, 3, 4, 5, 6, 7), pf, o1);
    pf = pack8(s1, 8); o0 = MFMA32(__builtin_shufflevector(v[12], v[14], 0, 1, 2, 3, 4, 5, 6, 7), pf, o0); o1 = MFMA32(__builtin_shufflevector(v[13], v[15], 0, 1, 2, 3, 4, 5, 6, 7), pf, o1);
}
DI void attn_store(bf16_t* op, const f32x16& o0, const f32x16& o1) {
#pragma unroll
    for (int g = 0; g < 4; ++g) { u32x2 w0, w1; w0.x = cvtpk(o0[4 * g], o0[4 * g + 1]); w0.y = cvtpk(o0[4 * g + 2], o0[4 * g + 3]); w1.x = cvtpk(o1[4 * g], o1[4 * g + 1]); w1.y = cvtpk(o1[4 * g + 2], o1[4 * g + 3]);
        *(u32x2*)(op + 8 * g) = w0; *(u32x2*)(op + 32 + 8 * g) = w1; }
}

template <int MODE>
DI void tile_compute(unsigned va, f32x16& c0, f32x16& c1, f32x16& o0, f32x16& o1, float& m_run, float& l_run, float& R, bool domask, int kpos0, int qpos, int hh) {
    if (MODE == 0) {
        const float tmax = fox_max(c0, c1, domask, kpos0, qpos);
        if (__builtin_amdgcn_ballot_w64(tmax - m_run > -126.0f) == 0ull) return;
        s16x4 v[16];
        TR16(v, va);
        fox_rest(c0, c1, o0, o1, m_run, l_run, tmax);
        TRWAIT(v);
        pv_tile(v, c0, c1, o0, o1);
    } else {
        if (__builtin_amdgcn_ballot_w64(R != 0.f) == 0ull) return;
        s16x4 v[16];
        TR16(v, va);
        sb_weights(c0, c1, R, domask, kpos0, qpos, hh);
        TRWAIT(v);
        pv_tile(v, c0, c1, o0, o1);
    }
}
DI void sb_post(LAS unsigned char* lds, int t, int wave, int lane, bool notdone) { const bool any = __builtin_amdgcn_ballot_w64(notdone) != 0ull; if (lane == 0) *(LAS unsigned*)(lds + LDS_RING + 64 + (t & 1) * 32 + wave * 4) = any ? 1u : 0u; }
DI bool fox_notdone(float qn, float kn, float bmax, float m_run) { return qn * kn * 1.01f + bmax + 1.0f > m_run - 126.0f; }
DI bool sb_all_done(LAS unsigned char* lds, int t) { const LAS u32x4* fp = (const LAS u32x4*)(lds + LDS_RING + 64 + (t & 1) * 32); const u32x4 a = fp[0], b = fp[1];
    return __builtin_amdgcn_readfirstlane((a.x | a.y | a.z | a.w) | (b.x | b.y | b.z | b.w)) == 0u; }

template <int MODE, bool DIAG>
DI void prompt_iter(LAS unsigned char* lds, unsigned ldsb, int t, int jt_w, int qpos, int hh, const bf16x8 (&qf)[4], unsigned kofs, unsigned fofs, unsigned vofs,
                    f32x16& c0, f32x16& c1, f32x16& n0, f32x16& n1, f32x16& o0, f32x16& o1, float& m_run, float& l_run, float& R) {
    if (t >= 1 && (!DIAG || t - 1 <= jt_w)) { const unsigned bo = ((t - 1) % 3) * ABUF; s_tile<MODE>(lds, bo + kofs, bo + fofs, qf, n0, n1); }
    if (!DIAG || t <= jt_w) tile_compute<MODE>(ldsb + (t % 3) * ABUF + vofs, c0, c1, o0, o1, m_run, l_run, R, DIAG && (t == jt_w), 64 * t + 32 * hh, qpos, hh);
}
template <int MODE, int H>
DI void attn_prompt(const Params& p, LAS unsigned char* lds, int b, int head, int qb) {
    constexpr int PITCH = H * 64;
    const int tid = tid_l(), lane = tid & 63, wave = tid >> 6, l31 = lane & 31, hh = lane >> 5;
    const int row = tid >> 3, ch = tid & 7;
    const int top = 4 * qb + 3, jt_w = 4 * qb + (wave >> 1), qpos = 256 * qb + 32 * wave + l31, qrow = b * SEQ + qpos;
    bf16x8 qf[4];
    { const bf16_t* qp = p.Q + (size_t)qrow * PITCH + head * 64 + 8 * hh;
#pragma unroll
      for (int s = 0; s < 4; ++s) qf[s] = *(const bf16x8*)(qp + 16 * s); }
    const float* Fh = p.Fp + (size_t)(b * 8 + (MODE == 0 ? head : 0)) * SEQ;
    float fref = 0.f; if (MODE == 0) fref = Fh[256 * qb];
    const float* KNh = p.KNp + (b * 8 + (MODE == 0 ? head : 0)) * 128;
    float qn = 0.f;
    if (MODE == 0) {
#pragma unroll
        for (int s_ = 0; s_ < 4; ++s_)
#pragma unroll
            for (int j = 0; j < 8; ++j) { const float x = __uint_as_float(((unsigned)(unsigned short)qf[s_][j]) << 16); qn += x * x; }
        qn += __shfl_xor(qn, 32); qn = sqrtf(qn); }
    f32x16 o0, o1;
#pragma unroll
    for (int i = 0; i < 16; ++i) { o0[i] = 0.f; o1[i] = 0.f; }
    float m_run = -INFINITY, l_run = 0.f, R = 1.0f;
    u32x4 kA, vA, kB, vB; float fA = 0.f, fB = 0.f;
    const bf16_t* kg = p.Kp + (size_t)(b * SEQ + row) * PITCH + head * 64 + ch * 8;
    const bf16_t* vg = p.Vp + (size_t)(b * SEQ + row) * PITCH + head * 64 + ch * 8;
#define PL_LOAD(JT, KR, VR, FR) do { const int jt_ = (JT); KR = *(const u32x4*)(kg + (size_t)jt_ * 64 * PITCH); VR = *(const u32x4*)(vg + (size_t)jt_ * 64 * PITCH); \
        if (MODE == 0 && tid < 65) FR = tid < 64 ? (fref - Fh[64 * jt_ + tid]) * LOG2E : KNh[jt_]; } while (0)
#define PL_STORE(JT, KR, VR, FR) do { const unsigned bo_ = (unsigned)(((JT) % 3) * ABUF); *(LAS u32x4*)(lds + bo_ + row * 144 + ch * 16) = KR; *(LAS u32x4*)(lds + bo_ + AKS + row * 144 + ch * 16) = VR; \
        if (MODE == 0 && tid < 65) *(LAS float*)(lds + bo_ + 2 * AKS + tid * 4) = FR; } while (0)
#define PL_STAGE(T, KR, VR, FR) do { if ((T) >= 2) PL_STORE((T) - 2, KR, VR, FR); if ((T) >= 4) PL_LOAD((T) - 4, KR, VR, FR); } while (0)
    const unsigned ldsb = (unsigned)(uintptr_t)lds;
    const unsigned krow = 32 * ((l31 >> 2) & 1) + 4 * (l31 >> 3) + (l31 & 3);
    const unsigned kofs = krow * 144 + hh * 16, fofs = 2 * AKS + hh * 128;
    const unsigned vofs = AKS + (32 * hh + ((lane & 15) >> 2)) * 144 + 32 * ((lane >> 4) & 1) + 8 * (lane & 3);
    __syncthreads();
    PL_LOAD(top, kA, vA, fA); PL_LOAD(top - 1, kB, vB, fB);
    PL_STORE(top, kA, vA, fA); PL_STORE(top - 1, kB, vB, fB);
    PL_LOAD(top - 2, kA, vA, fA); PL_LOAD(top - 3, kB, vB, fB);
    __syncthreads();
    f32x16 sa0, sa1, sb0, sb1;
#pragma unroll
    for (int i = 0; i < 16; ++i) { sa0[i] = 0.f; sa1[i] = 0.f; sb0[i] = 0.f; sb1[i] = 0.f; }
    if (top <= jt_w) s_tile<MODE>(lds, (top % 3) * ABUF + kofs, (top % 3) * ABUF + fofs, qf, sa0, sa1);
    bool done = false;
#define PL_ITER(T, DG, KR, VR, FR, C0, C1, N0, N1) do { PL_STAGE(T, KR, VR, FR); \
        prompt_iter<MODE, DG>(lds, ldsb, (T), jt_w, qpos, hh, qf, kofs, fofs, vofs, C0, C1, N0, N1, o0, o1, m_run, l_run, R); \
        if (MODE == 1) sb_post(lds, (T), wave, lane, R != 0.f); \
        else { const unsigned bo_ = (unsigned)(((T) % 3) * ABUF + 2 * AKS); sb_post(lds, (T), wave, lane, fox_notdone(qn, *(const LAS float*)(lds + bo_ + 256), *(const LAS float*)(lds + bo_ + 252), m_run)); } \
        __syncthreads(); \
        done = sb_all_done(lds, (T)); } while (0)
    for (int t = top; t >= 4 * qb && !done; t -= 2) {
        PL_ITER(t, true, kA, vA, fA, sa0, sa1, sb0, sb1);
        if (done) break;
        PL_ITER(t - 1, true, kB, vB, fB, sb0, sb1, sa0, sa1);
    }
    for (int t = 4 * qb - 1; t >= 1 && !done; t -= 2) {
        PL_ITER(t, false, kA, vA, fA, sa0, sa1, sb0, sb1);
        if (done) break;
        PL_ITER(t - 1, false, kB, vB, fB, sb0, sb1, sa0, sa1);
    }
#undef PL_ITER
#undef PL_LOAD
#undef PL_STORE
#undef PL_STAGE
    if (MODE == 0) { const float lt = l_run + __shfl_xor(l_run, 32); const float inv = 1.0f / lt;
#pragma unroll
        for (int i = 0; i < 16; ++i) { o0[i] *= inv; o1[i] *= inv; } }
    attn_store(p.CAT + (size_t)qrow * 1024 + head * 64 + 4 * hh, o0, o1);
}

template <int MODE, int H>
DI void attn_sample(const Params& p, LAS unsigned char* lds, int b, int ub) {
    constexpr int SBUF = 4 * AKS;
    const int tid = tid_l(), lane = tid & 63, wave = tid >> 6, l31 = lane & 31, hh = lane >> 5;
    const int row = tid >> 3, ch = tid & 7;
    const int slot = wave & 3, head = 4 * ub + slot, qpos = PAST + (lane & 15), qrow = TP + 16 * b + (lane & 15);
    const bool active = wave < 4;
    const float* cK = MODE == 0 ? p.cfk : p.csk; const float* cV = MODE == 0 ? p.cfv : p.csv;
    const float* nK = MODE == 0 ? p.fk_s : p.sk_s; const float* nV = MODE == 0 ? p.fv_s : p.sv_s;
    bf16x8 qf[4];
    { const bf16_t* qp = p.Q + (size_t)qrow * (H * 64) + head * 64 + 8 * hh;
#pragma unroll
      for (int s = 0; s < 4; ++s) qf[s] = *(const bf16x8*)(qp + 16 * s); }
    const float* Fl = p.Fs + (size_t)(b * 8 + (MODE == 0 ? 4 * ub + (tid >> 6) : 0)) * LPAD;
    float fref = 0.f; if (MODE == 0 && tid < 256) fref = Fl[PAST];
    const float* KNl = p.KNs + (b * 8 + (MODE == 0 ? 4 * ub + (tid & 3) : 0)) * 80;
    float qn = 0.f;
    if (MODE == 0) {
#pragma unroll
        for (int s_ = 0; s_ < 4; ++s_)
#pragma unroll
            for (int j = 0; j < 8; ++j) { const float x = __uint_as_float(((unsigned)(unsigned short)qf[s_][j]) << 16); qn += x * x; }
        qn += __shfl_xor(qn, 32); qn = sqrtf(qn); }
    f32x16 o0, o1;
#pragma unroll
    for (int i = 0; i < 16; ++i) { o0[i] = 0.f; o1[i] = 0.f; }
    float m_run = -INFINITY, l_run = 0.f, R = 1.0f;
    float freg = 0.f; f32x4 kr[4][2], vr[4][2];
#define SL_LOAD(JT) do { const int jt_ = (JT); \
        _Pragma("unroll") for (int i = 0; i < 4; ++i) { const int hd = 4 * ub + i; \
            if (jt_ < 64) { const size_t off = ((size_t)(b * PAST + 64 * jt_ + row) * H + hd) * 64 + 8 * ch; \
                kr[i][0] = *(const f32x4*)(cK + off); kr[i][1] = *(const f32x4*)(cK + off + 4); vr[i][0] = *(const f32x4*)(cV + off); vr[i][1] = *(const f32x4*)(cV + off + 4); } \
            else if (row < 16) { const size_t off = ((size_t)(b * 16 + row) * H + hd) * 64 + 8 * ch; \
                kr[i][0] = *(const f32x4*)(nK + off); kr[i][1] = *(const f32x4*)(nK + off + 4); vr[i][0] = *(const f32x4*)(nV + off); vr[i][1] = *(const f32x4*)(nV + off + 4); } \
            else { kr[i][0] = (f32x4){0.f, 0.f, 0.f, 0.f}; kr[i][1] = kr[i][0]; vr[i][0] = kr[i][0]; vr[i][1] = kr[i][0]; } } \
        if (MODE == 0 && tid < 260) freg = tid < 256 ? (fref - Fl[64 * jt_ + (tid & 63)]) * LOG2E : KNl[jt_]; } while (0)
#define SL_STORE() do { \
        _Pragma("unroll") for (int i = 0; i < 4; ++i) { u32x4 kk, vv; \
            kk.x = cvtpk(kr[i][0][0], kr[i][0][1]); kk.y = cvtpk(kr[i][0][2], kr[i][0][3]); kk.z = cvtpk(kr[i][1][0], kr[i][1][1]); kk.w = cvtpk(kr[i][1][2], kr[i][1][3]); \
            vv.x = cvtpk(vr[i][0][0], vr[i][0][1]); vv.y = cvtpk(vr[i][0][2], vr[i][0][3]); vv.z = cvtpk(vr[i][1][0], vr[i][1][1]); vv.w = cvtpk(vr[i][1][2], vr[i][1][3]); \
            *(LAS u32x4*)(lds + i * AKS + row * 144 + ch * 16) = kk; *(LAS u32x4*)(lds + SBUF + i * AKS + row * 144 + ch * 16) = vv; } \
        if (MODE == 0 && tid < 260) *(LAS float*)(lds + 2 * SBUF + tid * 4) = freg; } while (0)
    const unsigned ldsb = (unsigned)(uintptr_t)lds;
    const unsigned krow = 32 * ((l31 >> 2) & 1) + 4 * (l31 >> 3) + (l31 & 3);
    const unsigned kofs = slot * AKS + krow * 144 + hh * 16, fofs = 2 * SBUF + slot * 256 + hh * 128;
    const unsigned va = ldsb + SBUF + slot * AKS + (32 * hh + ((lane & 15) >> 2)) * 144 + 32 * ((lane >> 4) & 1) + 8 * (lane & 3);
    SL_LOAD(64);
    if (!active) R = 0.f;
    for (int t = 64; t >= 0; --t) {
        __syncthreads();
        if (t < 64 && sb_all_done(lds, t + 1)) break;
        SL_STORE();
        __syncthreads();
        if (t > 0) SL_LOAD(t - 1);
        if (active) {
            f32x16 s0, s1;
            s_tile<MODE>(lds, kofs, fofs, qf, s0, s1);
            tile_compute<MODE>(va, s0, s1, o0, o1, m_run, l_run, R, t == 64, 64 * t + 32 * hh, qpos, hh);
        }
        if (MODE == 1) sb_post(lds, t, wave, lane, R != 0.f);
        else sb_post(lds, t, wave, lane, active && fox_notdone(qn, *(const LAS float*)(lds + 2 * SBUF + 1024 + slot * 4), *(const LAS float*)(lds + 2 * SBUF + slot * 256 + 252), m_run));
    }
#undef SL_LOAD
#undef SL_STORE
    if (MODE == 0) { const float lt = l_run + __shfl_xor(l_run, 32); const float inv = 1.0f / lt;
#pragma unroll
        for (int i = 0; i < 16; ++i) { o0[i] *= inv; o1[i] *= inv; } }
    if (active && l31 < 16) attn_store(p.CAT + (size_t)qrow * 1024 + head * 64 + 4 * hh, o0, o1);
}

template <int MODE, int H>
DI void attn_phase(const Params& p, LAS unsigned char* lds, unsigned* ctr) {
    constexpr int NS = 16 * (H / 4), NPB = 2 * H, TOTAL = NS + NPB * 32;
    volatile LAS int* slotw = (volatile LAS int*)(lds + LDS_RING);
    for (;;) {
        __syncthreads();
        if (threadIdx.x == 0) *slotw = (int)atomicAdd(ctr, 1u);
        __syncthreads();
        int u = *slotw;
        if (u >= TOTAL) break;
        if (u < NS) attn_sample<MODE, H>(p, lds, u / (H / 4), u % (H / 4));
        else { u -= NS; const int qb = 31 - u / NPB, bh = u % NPB; attn_prompt<MODE, H>(p, lds, bh / H, bh % H, qb); }
    }
}

#define XB_TMO      128
#define XB_XCNT(j)  (256  + 64 * (j))
#define XB_XSUB(j)  (1280 + 64 * (j))
#define XB_XGEN(j)  (2304 + 64 * (j))
#define XB_TOP      3328
#define XB_TOPGEN   3392
#define XCD_BAR_WORDS 3456
#define XB_SPIN_CAP (1u << 18)

__device__ __forceinline__ unsigned xb_ld(unsigned* p)              { return __hip_atomic_load(p, __ATOMIC_RELAXED, __HIP_MEMORY_SCOPE_AGENT); }
__device__ __forceinline__ unsigned xb_add(unsigned* p, unsigned v) { return __hip_atomic_fetch_add(p, v, __ATOMIC_RELAXED, __HIP_MEMORY_SCOPE_AGENT); }
__device__ __forceinline__ unsigned xb_xcc_id() { return (unsigned)__builtin_amdgcn_s_getreg((3 << 11) | 20) & 0xFu; }
#define XB_SPIN(cond, bar) do { unsigned _sp = 0; while (cond) { __builtin_amdgcn_s_sleep(1); \
    if ((++_sp & 255u) == 0u) { if (xb_ld(&(bar)[XB_TMO])) break; if (_sp > XB_SPIN_CAP) { atomicAdd(&(bar)[XB_TMO], 1u); break; } } } } while (0)

struct XcdBarrier {
    unsigned* bar; unsigned x;
    volatile LAS unsigned* st;
};

__device__ __forceinline__ XcdBarrier xcd_barrier_post(unsigned* bar, volatile LAS unsigned* st) {
    XcdBarrier b; b.bar = bar; b.x = xb_xcc_id(); b.st = st;
    if (threadIdx.x == 0) (void)xb_add(&bar[XB_XCNT(b.x)], 1u);
    return b;
}
__device__ __forceinline__ void xcd_barrier_complete(unsigned* bar, unsigned x, unsigned& nloc, unsigned& nx) {
    const unsigned G = gridDim.x * gridDim.y * gridDim.z;
    unsigned sum, cnt, mine, sp = 0u;
    for (;;) {
        sum = 0u; cnt = 0u; mine = 0u;
#pragma unroll
        for (unsigned j = 0; j < 16; ++j) { const unsigned c = xb_ld(&bar[XB_XCNT(j)]); sum += c; cnt += (c > 0u) ? 1u : 0u; mine = (j == x) ? c : mine; }
        if (sum == G) break;
        __builtin_amdgcn_s_sleep(1);
        if ((++sp & 255u) == 0u) { if (xb_ld(&bar[XB_TMO])) break; if (sp > XB_SPIN_CAP) { atomicAdd(&bar[XB_TMO], 1u); break; } }
    }
    nloc = mine > 0u ? mine : 1u; nx = cnt > 0u ? cnt : 1u;
}

__device__ __forceinline__ void xcd_barrier(const XcdBarrier& b) {
    asm volatile("s_waitcnt vmcnt(0)" ::: "memory");
    __syncthreads();
    if (threadIdx.x == 0) {
        unsigned* bar = b.bar;
        __builtin_amdgcn_s_waitcnt(0);
        unsigned nloc = b.st[0], nx = b.st[1];
        if (nloc == 0u) { xcd_barrier_complete(bar, b.x, nloc, nx); b.st[0] = nloc; b.st[1] = nx; }
        const unsigned old = xb_add(&bar[XB_XSUB(b.x)], 1u);
        const unsigned gen = old / nloc;
        if (old + 1u == (gen + 1u) * nloc) {
            __builtin_amdgcn_fence(__ATOMIC_RELEASE, "agent");
            asm volatile("s_waitcnt vmcnt(0)" ::: "memory");
            const unsigned og = xb_add(&bar[XB_TOP], 1u);
            const unsigned tg = og / nx;
            if (og + 1u == (tg + 1u) * nx) xb_add(&bar[XB_TOPGEN], 1u);
            else XB_SPIN(xb_ld(&bar[XB_TOPGEN]) == tg, bar);
            __builtin_amdgcn_fence(__ATOMIC_ACQUIRE, "agent");
            xb_add(&bar[XB_XGEN(b.x)], 1u);
            asm volatile("s_waitcnt vmcnt(0)" ::: "memory");
        } else {
            XB_SPIN(xb_ld(&bar[XB_XGEN(b.x)]) == gen, bar);
            __builtin_amdgcn_fence(__ATOMIC_ACQUIRE, "agent");
            asm volatile("s_waitcnt vmcnt(0)" ::: "memory");
        }
    }
    __syncthreads();
}

typedef const __attribute__((address_space(4))) Params* KParams;
#define LOADP(q) Params q; { KParams k_ = (KParams)__builtin_amdgcn_kernarg_segment_ptr(); asm volatile("" : "+s"(k_)); q = *k_; }
__global__ void __launch_bounds__(NTHR, 2) mega(Params p_unused) {
#if defined(__HIP_DEVICE_COMPILE__)
    extern __shared__ __attribute__((aligned(16))) unsigned char lds_raw[];
    LAS unsigned char* lds = (LAS unsigned char*)lds_raw;
    cg::grid_group grid = cg::this_grid();
    if (threadIdx.x < 2) ((volatile LAS unsigned*)(lds + LDS_RING + 16))[threadIdx.x] = 0u;
    __syncthreads();
    XcdBarrier bar;
    { LOADP(p); bar = xcd_barrier_post(p.ctl + 1024, (volatile LAS unsigned*)(lds + LDS_RING + 16)); }
#define GSYNC() xcd_barrier(bar)
    { LOADP(p); phase0(p, lds);
      if (p.ctl == nullptr) grid.sync(); }
    GSYNC();
    { LOADP(p); norm_phase<true>(p, 0, 0, p.x_prompt, p.x_sample); } GSYNC();
    { LOADP(p); EmitQkvAB e{p.Q, p.Kp, p.Vp, p.U, p.fk_p, p.fv_p, p.fk_s, p.fv_s}; gemm_all(lds, p.XN, p.Wab, 2048, 1024, e); } GSYNC();
    { LOADP(p); phase3(p, lds); } GSYNC();
    { LOADP(p); attn_phase<0, 8>(p, lds, p.ctl); } GSYNC();
    { LOADP(p); EmitRes e{p.x_prompt, p.x_sample, p.mod + 2048, p.X}; gemm_all(lds, p.CAT, p.Woab, 1024, 1024, e); } GSYNC();
    { LOADP(p); norm_phase<false>(p, 0, 1, p.X, p.X + (size_t)TP * 1024); } GSYNC();
    { LOADP(p); gemm_up(lds, p.XN, p.Wup, p.H); } GSYNC();
    { LOADP(p); EmitRes e{p.X, p.X + (size_t)TP * 1024, p.mod + 5120, p.X}; gemm_all(lds, p.H, p.Wdn, 1024, 4096, e); } GSYNC();
    { LOADP(p); norm_phase<false>(p, 1, 0, p.X, p.X + (size_t)TP * 1024); } GSYNC();
    { LOADP(p); EmitQkvSB e{p.Q, p.Kp, p.Vp, p.sk_p, p.sv_p, p.sk_s, p.sv_s}; gemm_all(lds, p.XN, p.Wsb, 3072, 1024, e); } GSYNC();
    { LOADP(p); attn_phase<1, 16>(p, lds, p.ctl + 64); } GSYNC();
    { LOADP(p); EmitRes e{p.X, p.X + (size_t)TP * 1024, p.mod + (size_t)NSEQ * 6144 + 2048, p.X}; gemm_all(lds, p.CAT, p.Wosb, 1024, 1024, e); } GSYNC();
    { LOADP(p); norm_phase<false>(p, 1, 1, p.X, p.X + (size_t)TP * 1024); } GSYNC();
    { LOADP(p); gemm_up(lds, p.XN, p.Wup + (size_t)4096 * 1024, p.H); } GSYNC();
    { LOADP(p); EmitRes e{p.X, p.X + (size_t)TP * 1024, p.mod + (size_t)NSEQ * 6144 + 5120, p.X}; gemm_all(lds, p.H, p.Wdn + (size_t)1024 * 4096, 1024, 4096, e); } GSYNC();
    { LOADP(p); final_norm_phase(p); }
#endif
}

extern "C" void kernel_launch(void* const* d_in, const int* in_sizes, int n_in, void* d_out, int out_size, void* d_ws, size_t ws_size, hipStream_t stream) {
    static int grid = 0;
    if (grid == 0) {
        int dev = 0, cus = 0, per_cu = 0;
        hipGetDevice(&dev);
        hipDeviceGetAttribute(&cus, hipDeviceAttributeMultiprocessorCount, dev);
        if (hipFuncSetAttribute((const void*)mega, hipFuncAttributeMaxDynamicSharedMemorySize, LDS_BYTES) != hipSuccess) fprintf(stderr, "kernel_launch: hipFuncSetAttribute failed\n");
        if (hipOccupancyMaxActiveBlocksPerMultiprocessor(&per_cu, (const void*)mega, NTHR, LDS_BYTES) != hipSuccess || per_cu < 1) { fprintf(stderr, "kernel_launch: occupancy query says %d\n", per_cu); per_cu = 1; }
        (void)hipGetLastError();
        if (per_cu > 1) per_cu = 1;
        grid = cus * per_cu;
        if (n_in != 23 || out_size != 68428800 || ws_size < ((size_t)446 << 20)) fprintf(stderr, "kernel_launch: unexpected sizes n_in %d out %d ws %zu\n", n_in, out_size, ws_size);
    }
    const float* const* in = (const float* const*)d_in;
    Params p{};
    p.x_prompt = in[0]; p.x_sample = in[1]; p.c_prompt = in[2]; p.c_sample = in[3]; p.cfk = in[4]; p.cfv = in[5]; p.cfl = in[6]; p.spool = in[7]; p.csk = in[8]; p.csv = in[9];
    p.w_ada = in[10]; p.b_ada = in[11]; p.norm_g = in[12]; p.w_in_ab = in[13]; p.b_forget = in[14]; p.w_pool = in[15]; p.pool_scale = in[16]; p.w_out_ab = in[17];
    p.w_in_sb = in[18]; p.w_out_sb = in[19]; p.w_up = in[20]; p.w_down = in[21]; p.final_g = in[22];
    float* o = (float*)d_out;
    p.y_p = o; p.y_s = o + 16777216; p.fk_p = o + 17039360; p.fv_p = o + 25427968; p.fl_p = o + 33816576; p.pool_p = o + 33947648; p.sk_p = o + 33963008; p.sv_p = o + 50740224;
    p.fk_s = o + 67517440; p.fv_s = o + 67648512; p.fl_s = o + 67779584; p.pool_s = o + 67781632; p.sk_s = o + 67904512; p.sv_s = o + 68166656;
    unsigned char* ws = (unsigned char*)d_ws; const size_t MB = (size_t)1 << 20;
    p.ctl = (unsigned*)ws; p.mod = (float*)(ws + 1 * MB); p.Wf = (float*)(ws + 2 * MB); p.Fp = (float*)(ws + 3 * MB); p.Fs = (float*)(ws + 4 * MB); p.KNp = (float*)(ws + 7 * MB); p.KNs = (float*)(ws + 7 * MB + 65536);
    p.Wab = (bf16_t*)(ws + 8 * MB); p.Woab = (bf16_t*)(ws + 12 * MB); p.Wsb = (bf16_t*)(ws + 14 * MB); p.Wosb = (bf16_t*)(ws + 20 * MB); p.Wup = (bf16_t*)(ws + 22 * MB); p.Wdn = (bf16_t*)(ws + 38 * MB);
    p.XN = (bf16_t*)(ws + 54 * MB); p.X = (float*)(ws + 87 * MB); p.Q = (bf16_t*)(ws + 152 * MB); p.Kp = (bf16_t*)(ws + 185 * MB); p.Vp = (bf16_t*)(ws + 217 * MB);
    p.U = (float*)(ws + 249 * MB); p.CAT = (bf16_t*)(ws + 282 * MB); p.H = (bf16_t*)(ws + 315 * MB);
    (void)hipMemsetAsync(ws, 0, 32768, stream);
    void* args[] = {&p};
    hipError_t e = hipLaunchCooperativeKernel((const void*)mega, dim3(grid), dim3(NTHR), args, LDS_BYTES, stream);
    if (e != hipSuccess) fprintf(stderr, "kernel_launch: cooperative launch failed: %s (grid %d)\n", hipGetErrorString(e), grid);
}
```
